# Optimizing an MI355X kernel written in HIP

```python
import jax, jax.numpy as jnp
from jax import lax
import numpy as np

D_MODEL = 2048
BATCH = 8
SEQ = 2048
DEPTH = 2

MOBA_HEADS = 8
MOBA_HEAD_DIM = 128
MOBA_BLOCK = 256
MOBA_TOPK = 3
MOBA_Q_CHUNK = 64
RET_HEADS = 4
RET_KEY_DIM = 256
RET_VALUE_DIM = 512
RET_CHUNK = 128
ROPE_BASE = 10000.0
MEM_LEN = 256
MEM_HEADS = 4
MEM_HEAD_DIM = 256
N_BRANCHES = 3
MOBA_WIDTH = MOBA_HEADS * MOBA_HEAD_DIM
RET_QK_WIDTH = RET_HEADS * RET_KEY_DIM
RET_V_WIDTH = RET_HEADS * RET_VALUE_DIM
MEM_WIDTH = MEM_HEADS * MEM_HEAD_DIM
IN_WIDTH = 3 * MOBA_WIDTH + 2 * RET_QK_WIDTH + 2 * RET_V_WIDTH + MEM_WIDTH + N_BRANCHES * D_MODEL
N_GROUPS = 4
EXPERTS_PER_GROUP = 8
N_EXPERTS = N_GROUPS * EXPERTS_PER_GROUP
EXPERT_TOPK = 2
EXPERT_FF = 512
EXPERT_BLOCK = 128
DEEPNORM_ALPHA = (2 * DEPTH) ** 0.25
DEEPNORM_BETA = (8 * DEPTH) ** -0.25
LN_EPS = 1e-5
GN_EPS = 1e-6
NEG_INF = -1e30

kernel_name = "hybrid_moba_retention_memory_hmoe_deepnorm"

F32 = jnp.float32


def layer_norm(x, g, b):
    xf = x.astype(F32)
    mu = xf.mean(-1, keepdims=True)
    var = jnp.mean(jnp.square(xf - mu), -1, keepdims=True)
    return ((xf - mu) * lax.rsqrt(var + LN_EPS) * g.astype(F32) + b.astype(F32)).astype(x.dtype)


def rotary(x, pos):
    half = x.shape[-1] // 2
    inv = ROPE_BASE ** (-jnp.linspace(0.0, 1.0, half, dtype=F32))
    ang = pos.astype(F32)[:, None] * inv[None, :]
    cos = jnp.cos(ang)[None, :, None, :]
    sin = jnp.sin(ang)[None, :, None, :]
    x1 = x[..., :half].astype(F32)
    x2 = x[..., half:].astype(F32)
    return jnp.concatenate([x1 * cos - x2 * sin, x1 * sin + x2 * cos], -1).astype(x.dtype)


def moba_attention(q, k, v):
    bsz, seq, nh, dh = q.shape
    n_blk = -(-seq // MOBA_BLOCK)
    s_pad = n_blk * MOBA_BLOCK
    top_n = min(MOBA_TOPK, n_blk)
    padw = ((0, 0), (0, s_pad - seq), (0, 0), (0, 0))
    qh = jnp.pad(q, padw).transpose(0, 2, 1, 3)
    kb = jnp.pad(k, padw).transpose(0, 2, 1, 3).reshape(bsz, nh, n_blk, MOBA_BLOCK, dh)
    vb = jnp.pad(v, padw).transpose(0, 2, 1, 3).reshape(bsz, nh, n_blk, MOBA_BLOCK, dh)
    k_mean = kb.astype(F32).mean(axis=3)
    q_blk = jnp.arange(s_pad) // MOBA_BLOCK
    past = jnp.arange(n_blk)[None, :] < q_blk[:, None]
    gate = jnp.einsum('bhsd,bhnd->bhsn', qh.astype(F32), k_mean)
    gate = jnp.where(past, gate, NEG_INF)
    _, sel = lax.top_k(gate, top_n)
    valid = sel < q_blk[:, None]
    scale = dh ** -0.5
    n_qc = s_pad // MOBA_Q_CHUNK

    def chunk_major(t):
        t = t.reshape(bsz, nh, n_qc, MOBA_Q_CHUNK, *t.shape[3:])
        return jnp.moveaxis(t, 2, 1)

    qc, selc, validc = chunk_major(qh), chunk_major(sel), chunk_major(valid)

    def one_batch(args):
        q_b, sel_b, valid_b, k_b, v_b = args

        def one_chunk(cargs):
            c, q_c, sel_c, valid_c = cargs
            k_sel = jax.vmap(lambda kh, sh: kh[sh])(k_b, sel_c)
            v_sel = jax.vmap(lambda vh, sh: vh[sh])(v_b, sel_c)
            s_sel = jnp.einsum('hqd,hqnkd->hqnk', q_c, k_sel, preferred_element_type=F32) * scale
            s_sel = jnp.where(valid_c[..., None], s_sel, NEG_INF)
            s_sel = s_sel.reshape(nh, MOBA_Q_CHUNK, top_n * MOBA_BLOCK)
            q_pos = c * MOBA_Q_CHUNK + jnp.arange(MOBA_Q_CHUNK)
            own = (c * MOBA_Q_CHUNK) // MOBA_BLOCK
            k_own = lax.dynamic_index_in_dim(k_b, own, axis=1, keepdims=False)
            v_own = lax.dynamic_index_in_dim(v_b, own, axis=1, keepdims=False)
            k_pos = own * MOBA_BLOCK + jnp.arange(MOBA_BLOCK)
            s_own = jnp.einsum('hqd,hkd->hqk', q_c, k_own, preferred_element_type=F32) * scale
            s_own = jnp.where(k_pos[None, :] <= q_pos[:, None], s_own, NEG_INF)
            p = jax.nn.softmax(jnp.concatenate([s_sel, s_own], -1), axis=-1)
            p_sel = p[..., :top_n * MOBA_BLOCK].reshape(nh, MOBA_Q_CHUNK, top_n, MOBA_BLOCK).astype(v_b.dtype)
            p_own = p[..., top_n * MOBA_BLOCK:].astype(v_b.dtype)
            return (jnp.einsum('hqnk,hqnkd->hqd', p_sel, v_sel)
                    + jnp.einsum('hqk,hkd->hqd', p_own, v_own))

        return lax.map(one_chunk, (jnp.arange(n_qc), q_b, sel_b, valid_b))

    out = lax.map(one_batch, (qc, selc, validc, kb, vb))
    out = jnp.moveaxis(out, 2, 1).reshape(bsz, nh, s_pad, dh)[:, :, :seq]
    return out.transpose(0, 2, 1, 3).reshape(bsz, seq, nh * dh)


def retention(q, k, v, g):
    bsz, seq, nh, dk = q.shape
    dv = v.shape[-1]
    pos = jnp.arange(seq)
    q = rotary(q, pos)
    k = rotary(k, pos) * (dk ** -0.5)
    n_c = seq // RET_CHUNK
    log_g = jnp.log1p(-jnp.power(2.0, -5.0 - jnp.arange(nh, dtype=F32)))
    idx = jnp.arange(RET_CHUNK, dtype=F32)
    diff = idx[:, None] - idx[None, :]
    decay = jnp.where(diff >= 0, jnp.exp(log_g[:, None, None] * jnp.maximum(diff, 0.0)), 0.0)

    def to_chunks(t):
        return t.reshape(bsz, n_c, RET_CHUNK, nh, t.shape[-1]).transpose(0, 3, 1, 2, 4).astype(F32)

    qc, kc, vc = to_chunks(q), to_chunks(k), to_chunks(v)
    scores = jnp.einsum('bhnid,bhnjd->bhnij', qc, kc) * decay[None, :, None]
    inner = jnp.einsum('bhnij,bhnje->bhnie', scores, vc)
    zeta = jnp.exp(log_g[:, None] * (RET_CHUNK - 1 - idx)[None, :])
    kv = jnp.einsum('bhnjd,bhnje->nbhde', kc * zeta[None, :, None, :, None], vc)
    chunk_decay = jnp.exp(log_g * RET_CHUNK)[None, :, None, None]

    def step(state, kv_n):
        return chunk_decay * state + kv_n, state

    _, states = lax.scan(step, jnp.zeros((bsz, nh, dk, dv), F32), kv)
    xi = jnp.exp(log_g[:, None] * (idx + 1.0)[None, :])
    cross = jnp.einsum('bhnid,nbhde->bhnie', qc * xi[None, :, None, :, None], states)
    o = (inner + cross).transpose(0, 2, 3, 1, 4).reshape(bsz, seq, nh, dv)
    mu = o.mean(-1, keepdims=True)
    var = jnp.mean(jnp.square(o - mu), -1, keepdims=True)
    o = ((o - mu) * lax.rsqrt(var + GN_EPS)).reshape(bsz, seq, nh * dv)
    return (jax.nn.silu(g.astype(F32)) * o).astype(v.dtype)


def memory_attention(qm, mem, w_mem_kv):
    bsz, seq, _ = qm.shape
    kv = mem @ w_mem_kv
    km, vm = jnp.split(kv, 2, axis=-1)
    q = qm.reshape(bsz, seq, MEM_HEADS, MEM_HEAD_DIM)
    km = km.reshape(bsz, -1, MEM_HEADS, MEM_HEAD_DIM)
    vm = vm.reshape(bsz, -1, MEM_HEADS, MEM_HEAD_DIM)
    s = jnp.einsum('bshd,bmhd->bhsm', q, km, preferred_element_type=F32) * (MEM_HEAD_DIM ** -0.5)
    p = jax.nn.softmax(s, axis=-1).astype(vm.dtype)
    return jnp.einsum('bhsm,bmhd->bshd', p, vm).reshape(bsz, seq, MEM_WIDTH)


def hybrid_mixer(u, mem, w_in, p_moba, p_ret, p_mem, w_mem_kv, w_o):
    bsz, seq, _ = u.shape
    proj = u @ w_in
    sizes = ((MOBA_WIDTH,) * 3 + (RET_QK_WIDTH,) * 2 + (RET_V_WIDTH,) * 2
             + (MEM_WIDTH,) + (D_MODEL,) * N_BRANCHES)
    cuts = [int(c) for c in np.cumsum(sizes)[:-1]]
    aq, ak, av, rq, rk, rv, rg, mq, ga, gr, gm = jnp.split(proj, cuts, axis=-1)

    def heads(t, h):
        return t.reshape(bsz, seq, h, -1)

    y_a = moba_attention(heads(aq, MOBA_HEADS), heads(ak, MOBA_HEADS), heads(av, MOBA_HEADS))
    y_r = retention(heads(rq, RET_HEADS), heads(rk, RET_HEADS), heads(rv, RET_HEADS), rg)
    y_m = memory_attention(mq, mem, w_mem_kv)
    merged = (jax.nn.sigmoid(ga) * (y_a @ p_moba)
              + jax.nn.sigmoid(gr) * (y_r @ p_ret)
              + jax.nn.sigmoid(gm) * (y_m @ p_mem))
    return merged @ w_o


def hier_moe(x, w_group, b_group, w_expert, b_expert, w_gate_up, w_down):
    bsz, seq, d = x.shape
    n_tok = bsz * seq
    xt = x.reshape(n_tok, d)
    g_logits = (xt @ w_group).astype(F32) + b_group.astype(F32)
    g_prob = jax.nn.softmax(g_logits, axis=-1)
    _, g_sel = lax.top_k(g_logits, 1)
    p_g = jnp.take_along_axis(g_prob, g_sel, axis=1)
    e_logits = ((xt @ w_expert).astype(F32) + b_expert.astype(F32)).reshape(n_tok, N_GROUPS, EXPERTS_PER_GROUP)
    e_in = jnp.take_along_axis(e_logits, g_sel[:, :, None], axis=1)[:, 0]
    top_v, top_i = lax.top_k(e_in, EXPERT_TOPK)
    weights = p_g * jax.nn.softmax(top_v, axis=-1)
    expert_id = g_sel * EXPERTS_PER_GROUP + top_i

    n_asg = n_tok * EXPERT_TOPK
    flat_e = expert_id.reshape(n_asg)
    flat_t = jnp.repeat(jnp.arange(n_tok, dtype=jnp.int32), EXPERT_TOPK)
    flat_w = weights.reshape(n_asg)
    order = jnp.argsort(flat_e)
    e_s, t_s, w_s = flat_e[order], flat_t[order], flat_w[order]
    counts = jnp.bincount(flat_e, length=N_EXPERTS)
    starts = jnp.cumsum(counts) - counts
    padded = ((counts + EXPERT_BLOCK - 1) // EXPERT_BLOCK) * EXPERT_BLOCK
    pad_ends = jnp.cumsum(padded)
    pad_starts = pad_ends - padded
    dest = pad_starts[e_s] + (jnp.arange(n_asg) - starts[e_s])
    n_pad = (-(-n_asg // EXPERT_BLOCK) + N_EXPERTS) * EXPERT_BLOCK
    row_tok = jnp.zeros((n_pad,), jnp.int32).at[dest].set(t_s)
    row_w = jnp.zeros((n_pad,), F32).at[dest].set(w_s)
    n_blocks = n_pad // EXPERT_BLOCK
    block_e = jnp.clip(jnp.searchsorted(pad_ends, jnp.arange(n_blocks) * EXPERT_BLOCK, side='right'),
                       0, N_EXPERTS - 1)
    x_rows = xt[row_tok].reshape(n_blocks, EXPERT_BLOCK, d)

    def run_block(args):
        xb, e = args
        gate, up = jnp.split(xb @ w_gate_up[e], 2, axis=-1)
        return (jax.nn.silu(gate) * up) @ w_down[e]

    y_rows = lax.map(run_block, (x_rows, block_e)).reshape(n_pad, d)
    out = jax.ops.segment_sum(y_rows * row_w[:, None].astype(y_rows.dtype), row_tok, num_segments=n_tok)
    return out.reshape(bsz, seq, d)


def setup_inputs(seed: int = 0) -> dict:
    key = jax.random.key(seed)
    ks = jax.random.split(key, 18)

    def nrm(k, shape, scale):
        return jax.random.normal(k, shape, F32) * scale

    L = DEPTH
    return {
        "x": nrm(ks[0], (BATCH, SEQ, D_MODEL), 1.0),
        "mem": nrm(ks[1], (BATCH, MEM_LEN, D_MODEL), 1.0),
        "w_in": nrm(ks[2], (L, D_MODEL, IN_WIDTH), D_MODEL ** -0.5),
        "p_moba": nrm(ks[3], (L, MOBA_WIDTH, D_MODEL), MOBA_WIDTH ** -0.5),
        "p_ret": nrm(ks[4], (L, RET_V_WIDTH, D_MODEL), RET_V_WIDTH ** -0.5),
        "p_mem": nrm(ks[5], (L, MEM_WIDTH, D_MODEL), MEM_WIDTH ** -0.5),
        "w_mem_kv": nrm(ks[6], (L, D_MODEL, 2 * MEM_WIDTH), D_MODEL ** -0.5),
        "w_o": nrm(ks[7], (L, D_MODEL, D_MODEL), D_MODEL ** -0.5 * DEEPNORM_BETA),
        "ln1_g": 1.0 + nrm(ks[8], (L, D_MODEL), 0.02),
        "ln1_b": nrm(ks[9], (L, D_MODEL), 0.02),
        "w_group": nrm(ks[10], (L, D_MODEL, N_GROUPS), D_MODEL ** -0.5),
        "b_group": nrm(ks[11], (L, N_GROUPS), 0.01),
        "w_expert": nrm(ks[12], (L, D_MODEL, N_EXPERTS), D_MODEL ** -0.5),
        "b_expert": nrm(ks[13], (L, N_EXPERTS), 0.01),
        "w_gate_up": nrm(ks[14], (L, N_EXPERTS, D_MODEL, 2 * EXPERT_FF), D_MODEL ** -0.5),
        "w_down": nrm(ks[15], (L, N_EXPERTS, EXPERT_FF, D_MODEL), EXPERT_FF ** -0.5 * DEEPNORM_BETA),
        "ln2_g": 1.0 + nrm(ks[16], (L, D_MODEL), 0.02),
        "ln2_b": nrm(ks[17], (L, D_MODEL), 0.02),
    }


def reference(x, mem, w_in, p_moba, p_ret, p_mem, w_mem_kv, w_o, ln1_g, ln1_b,
              w_group, b_group, w_expert, b_expert, w_gate_up, w_down, ln2_g, ln2_b):
    for l in range(DEPTH):
        mix = hybrid_mixer(x, mem, w_in[l], p_moba[l], p_ret[l], p_mem[l], w_mem_kv[l], w_o[l])
        x = layer_norm(DEEPNORM_ALPHA * x + mix, ln1_g[l], ln1_b[l])
        ffn = hier_moe(x, w_group[l], b_group[l], w_expert[l], b_expert[l], w_gate_up[l], w_down[l])
        x = layer_norm(DEEPNORM_ALPHA * x + ffn, ln2_g[l], ln2_b[l])
    return x
```

```cpp
#include <hip/hip_runtime.h>
#include <cstdio>
#include <cstdint>
#include <cstddef>

#ifndef MK_PER_PHASE
#define MK_PER_PHASE 0
#endif

#define LAS __attribute__((address_space(3)))
#define GAS __attribute__((address_space(1)))
typedef unsigned short bf16_t;
typedef short bf16x8 __attribute__((ext_vector_type(8)));
typedef short s16x4 __attribute__((ext_vector_type(4)));
typedef float f32x2 __attribute__((ext_vector_type(2)));
typedef float f32x4 __attribute__((ext_vector_type(4)));
typedef float f32x16 __attribute__((ext_vector_type(16)));
typedef unsigned u32x2 __attribute__((ext_vector_type(2)));
typedef unsigned u32x4 __attribute__((ext_vector_type(4)));
typedef int v4i32 __attribute__((ext_vector_type(4)));
typedef int v8i32 __attribute__((ext_vector_type(8)));
typedef __bf16 bf16x2_t __attribute__((ext_vector_type(2)));
typedef GAS unsigned gu32;

constexpr int D = 2048, BATCH = 8, SEQ = 2048, T = BATCH * SEQ, DEPTH = 2;
constexpr int INW = 16384;
constexpr int NEXP = 32, EFF = 512;
constexpr float DN_ALPHA = 1.41421356237309515f;
constexpr float LN_EPS = 1e-5f, GN_EPS = 1e-6f;
constexpr float LOG2E = 1.44269504088896341f;

constexpr size_t MiB = 1u << 20;
constexpr size_t WS_CTL = 0, CTL_ZERO_BYTES = 1 * MiB;
constexpr size_t WS_ROPE = 1 * MiB;
constexpr size_t WS_WRT = 3 * MiB;
constexpr size_t WRT_GL = 196608, WRT_CS = 393216, WRT_C0 = WRT_CS + 256;
constexpr size_t WS_WIN = 4 * MiB;
constexpr size_t WS_WPM = 68 * MiB;
constexpr size_t WS_WPR = 72 * MiB;
constexpr size_t WS_WPE = 80 * MiB;
constexpr size_t WS_WO = 84 * MiB;
constexpr size_t WS_WKV = 372 * MiB;
constexpr size_t WS_WGU = 100 * MiB;
constexpr size_t WS_WDN = 228 * MiB;
constexpr size_t WS_MEMB = 292 * MiB;
constexpr size_t WS_KM = 300 * MiB;
constexpr size_t WS_VMT = 304 * MiB;
constexpr size_t WS_XB = 308 * MiB;
constexpr size_t WS_X1 = 372 * MiB;
constexpr size_t WS_X1B = 500 * MiB;
constexpr size_t WS_XN = 564 * MiB;
constexpr size_t WS_XB8 = WS_XN, WS_WIN8 = WS_XN + 32 * MiB, WS_XS = WS_XN + 96 * MiB;
constexpr float WQ_RANGE = 1.0f;
constexpr int CW_WMAX = 49152;
#ifndef F8_QK
#define F8_QK 1
#endif
constexpr int NF8X = F8_QK ? 12 : 4;
constexpr float GATE_WSCALE = 64.0f;
constexpr float Y8_SCALE = 4.0f;
constexpr size_t WS_HPRE = 692 * MiB;
constexpr size_t WS_MACC = 820 * MiB;
constexpr size_t WS_MERGED = 948 * MiB;
constexpr size_t WS_YA = 1012 * MiB;
constexpr size_t WS_YR = 1044 * MiB;
constexpr size_t WS_YM = 1108 * MiB;
constexpr size_t WS_RO = 1140 * MiB;
constexpr size_t WS_RSTAT = 1204 * MiB;
constexpr size_t WS_PROJ = 1208 * MiB;
constexpr size_t WS_AQ = WS_PROJ, WS_AK = WS_AQ + 32 * MiB, WS_AVT = WS_AK + 32 * MiB, WS_RQ = WS_AVT + 32 * MiB, WS_RK = WS_RQ + 32 * MiB;
constexpr size_t WS_RVT = WS_RK + 32 * MiB, WS_RGS = WS_RVT + 64 * MiB, WS_MQ = WS_RGS + 64 * MiB, WS_SGA = WS_MQ + 32 * MiB, WS_SGR = WS_SGA + 64 * MiB, WS_SGM = WS_SGR + 64 * MiB;
constexpr size_t WS_PROJ_END = WS_SGM + 64 * MiB;
constexpr size_t WS_LIST = WS_PROJ;
constexpr size_t WS_TOKW = WS_PROJ + 2 * MiB;
constexpr size_t WS_HBUF = WS_PROJ + 4 * MiB;
constexpr size_t WS_YASG = WS_PROJ + 44 * MiB;
constexpr size_t WS_END = WS_PROJ_END;
static_assert(WS_PROJ_END == (1208 + 512) * MiB && WS_YASG + 128 * MiB <= WS_PROJ_END, "ws map");
constexpr int CW_BAR = 4096;
constexpr int CW_CNT = 16384;
constexpr int CW_FLAG = 32768;

constexpr int RING_BYTES = 131072;
constexpr int LDS_TAB = 158720;
constexpr int LDSCTL_OFF = LDS_TAB + 4096, MISC_OFF = LDSCTL_OFF + 320;
constexpr int LDS_BYTES = 163840;
constexpr int NWAVES = 8;

__device__ __forceinline__ unsigned pk2(float lo, float hi) { f32x2 v = {lo, hi}; bf16x2_t b = __builtin_convertvector(v, bf16x2_t); return __builtin_bit_cast(unsigned, b); }
__device__ __forceinline__ float bf_lo(unsigned w) { return __uint_as_float(w << 16); }
__device__ __forceinline__ float bf_hi(unsigned w) { return __uint_as_float(w & 0xffff0000u); }
__device__ __forceinline__ float wave_sum(float v) {
#pragma unroll
    for (int o = 1; o < 64; o <<= 1) v += __shfl_xor(v, o);
    return v;
}
__device__ __forceinline__ float wave_max(float v) {
#pragma unroll
    for (int o = 1; o < 64; o <<= 1) v = fmaxf(v, __shfl_xor(v, o));
    return v;
}
__device__ __forceinline__ unsigned pk_i8(float a, float b, float c, float d, float q) {
    unsigned w = 0;
    w = __builtin_amdgcn_cvt_pk_u8_f32(fminf(fmaxf(__builtin_rintf(a * q), -127.0f), 127.0f) + 128.0f, 0, w); w = __builtin_amdgcn_cvt_pk_u8_f32(fminf(fmaxf(__builtin_rintf(b * q), -127.0f), 127.0f) + 128.0f, 1, w);
    w = __builtin_amdgcn_cvt_pk_u8_f32(fminf(fmaxf(__builtin_rintf(c * q), -127.0f), 127.0f) + 128.0f, 2, w); w = __builtin_amdgcn_cvt_pk_u8_f32(fminf(fmaxf(__builtin_rintf(d * q), -127.0f), 127.0f) + 128.0f, 3, w);
    return w ^ 0x80808080u;
}
__device__ __forceinline__ float f8c(float x) { return __builtin_amdgcn_fmed3f(x, -440.0f, 440.0f); }
__device__ __forceinline__ float fast_exp2(float x) { return __builtin_amdgcn_exp2f(x); }
__device__ __forceinline__ float max3f(float a, float b, float c) { float r; asm("v_max3_f32 %0, %1, %2, %3" : "=v"(r) : "v"(a), "v"(b), "v"(c)); return r; }
__device__ __forceinline__ float sigmoidf_(float x) { return __builtin_amdgcn_rcpf(1.0f + __builtin_amdgcn_exp2f(-LOG2E * x)); }
#define LDS_WAIT() asm volatile("s_waitcnt lgkmcnt(0)" ::: "memory")
#define VM_WAIT() asm volatile("s_waitcnt vmcnt(0)" ::: "memory")

#define XB_TMO      128
#define XB_XCNT(j)  (256  + 64 * (j))
#define XB_XSUB(j)  (1280 + 64 * (j))
#define XB_XGEN(j)  (2304 + 64 * (j))
#define XB_TOP      3328
#define XB_TOPGEN   3392
#define XCD_BAR_WORDS 3456
#define XB_SPIN_CAP (1u << 18)
__device__ __forceinline__ unsigned xb_ld(GAS unsigned* p)              { return __hip_atomic_load(p, __ATOMIC_RELAXED, __HIP_MEMORY_SCOPE_AGENT); }
__device__ __forceinline__ unsigned xb_add(GAS unsigned* p, unsigned v) { return __hip_atomic_fetch_add(p, v, __ATOMIC_RELAXED, __HIP_MEMORY_SCOPE_AGENT); }
__device__ __forceinline__ unsigned xb_xcc_id() { return (unsigned)__builtin_amdgcn_s_getreg((3 << 11) | 20) & 0xFu; }
#define XB_SPIN(cond, bar) do { unsigned _sp = 0; while (cond) { __builtin_amdgcn_s_sleep(1); \
    if ((++_sp & 255u) == 0u) { if (xb_ld(&(bar)[XB_TMO])) break; if (_sp > XB_SPIN_CAP) { (void)xb_add(&(bar)[XB_TMO], 1u); break; } } } } while (0)
struct XcdBarrier { GAS unsigned* bar; unsigned x; volatile LAS unsigned* st; };
__device__ __forceinline__ XcdBarrier xcd_barrier_post(GAS unsigned* bar, volatile LAS unsigned* st) {
    XcdBarrier b; b.bar = bar; b.x = xb_xcc_id(); b.st = st;
    if (threadIdx.x == 0) (void)xb_add(&bar[XB_XCNT(b.x)], 1u);
    return b;
}
__device__ __forceinline__ void xcd_barrier_complete(GAS unsigned* bar, unsigned x, unsigned& nloc, unsigned& nx) {
    const unsigned G = gridDim.x * gridDim.y * gridDim.z;
    unsigned sum, cnt, mine, sp = 0u;
    for (;;) {
        sum = 0u; cnt = 0u; mine = 0u;
#pragma unroll
        for (unsigned j = 0; j < 16; ++j) { const unsigned c = xb_ld(&bar[XB_XCNT(j)]); sum += c; cnt += (c > 0u) ? 1u : 0u; mine = (j == x) ? c : mine; }
        if (sum == G) break;
        __builtin_amdgcn_s_sleep(1);
        if ((++sp & 255u) == 0u) { if (xb_ld(&bar[XB_TMO])) break; if (sp > XB_SPIN_CAP) { (void)xb_add(&bar[XB_TMO], 1u); break; } }
    }
    nloc = mine > 0u ? mine : 1u; nx = cnt > 0u ? cnt : 1u;
}
__device__ __forceinline__ void xcd_barrier(const XcdBarrier& b) {
    asm volatile("s_waitcnt vmcnt(0)" ::: "memory");
    __syncthreads();
    if (threadIdx.x == 0) {
        GAS unsigned* bar = b.bar; asm volatile("" : "+s"(bar));
        __builtin_amdgcn_s_waitcnt(0);
        unsigned nloc = b.st[0], nx = b.st[1];
        if (nloc == 0u) { xcd_barrier_complete(bar, b.x, nloc, nx); b.st[0] = nloc; b.st[1] = nx; }
        const unsigned old = xb_add(&bar[XB_XSUB(b.x)], 1u);
        const unsigned gen = old / nloc;
        if (old + 1u == (gen + 1u) * nloc) {
            __builtin_amdgcn_fence(__ATOMIC_RELEASE, "agent");
            asm volatile("s_waitcnt vmcnt(0)" ::: "memory");
            const unsigned og = xb_add(&bar[XB_TOP], 1u);
            const unsigned tg = og / nx;
            if (og + 1u == (tg + 1u) * nx) xb_add(&bar[XB_TOPGEN], 1u);
            else XB_SPIN(xb_ld(&bar[XB_TOPGEN]) == tg, bar);
            __builtin_amdgcn_fence(__ATOMIC_ACQUIRE, "agent");
            xb_add(&bar[XB_XGEN(b.x)], 1u);
            asm volatile("s_waitcnt vmcnt(0)" ::: "memory");
        } else {
            XB_SPIN(xb_ld(&bar[XB_XGEN(b.x)]) == gen, bar);
            __builtin_amdgcn_fence(__ATOMIC_ACQUIRE, "agent");
            asm volatile("s_waitcnt vmcnt(0)" ::: "memory");
        }
    }
    __syncthreads();
}

namespace pg8 {
constexpr int BM = 256, BK = 64, HALF = 128, HTB = HALF * BK * 2, STAGE_BYTES = 8 * HTB, NXCD = 8, WGM = 8;
__host__ __device__ __forceinline__ int lds_byte(int r, int c) { const int st = (r >> 4) * 2 + (c >> 5), rr = r & 15, cc = c & 31, ob = rr * 64 + cc * 2; return st * 1024 + (ob ^ (((ob >> 9) & 1) << 5)); }
__host__ __device__ __forceinline__ void stage_rc(int b, int& R, int& C) { const int st = b / 1024, sb = b % 1024, swz = sb ^ (((sb >> 9) & 1) << 5); R = (st >> 1) * 16 + swz / 64; C = (st & 1) * 32 + (swz % 64) / 2; }
__host__ __device__ __forceinline__ int perm32(int rho) { const int n = rho >> 4, i = rho & 15; return 8 * (i >> 2) + 4 * n + (i & 3); }

struct Unit {
    const GAS char* A; const GAS char* B; int pm, pn; int aux, nvalid; const GAS int* gather;
    unsigned lda, ldb; int K;
};
__device__ __forceinline__ void static_tile(int L, int nM, int nN, int& pm, int& pn) {
    const int nwg = nM * nN; int wgid = L;
    { const int q = nwg / NXCD, r = nwg % NXCD, xcd = wgid % NXCD, off = wgid / NXCD; wgid = (xcd < r ? xcd * (q + 1) : r * (q + 1) + (xcd - r) * q) + off; }
    const int nig = WGM * nN, gid = wgid / nig, fm = gid * WGM, gsz = (nM - fm) < WGM ? (nM - fm) : WGM;
    pm = fm + ((wgid % nig) % gsz); pn = (wgid % nig) / gsz;
}

template <int QM_> struct Frag { using T = bf16x8; static constexpr int NK = 2;
    static __device__ __forceinline__ T ld(const LAS unsigned char* p, int k) { return *(const LAS bf16x8*)(p + k * 1024); } };
template <> struct Frag<2> { using T = v4i32; static constexpr int NK = 2;
    static __device__ __forceinline__ T ld(const LAS unsigned char* p, int k) { return *(const LAS v4i32*)(p + k * 1024); } };
__device__ __forceinline__ f32x4 mma_frag(v4i32 a, v4i32 b, f32x4 c) { return __builtin_bit_cast(f32x4, __builtin_amdgcn_mfma_i32_16x16x64_i8(a, b, __builtin_bit_cast(v4i32, c), 0, 0, 0)); }
template <> struct Frag<1> { using T = v8i32; static constexpr int NK = 1;
    static __device__ __forceinline__ T ld(const LAS unsigned char* p, int) { return __builtin_shufflevector(*(const LAS v4i32*)(p), *(const LAS v4i32*)(p + 1024), 0, 1, 2, 3, 4, 5, 6, 7); } };
__device__ __forceinline__ f32x4 mma_frag(bf16x8 a, bf16x8 b, f32x4 c) { return __builtin_amdgcn_mfma_f32_16x16x32_bf16(a, b, c, 0, 0, 0); }
__device__ __forceinline__ f32x4 mma_frag(v8i32 a, v8i32 b, f32x4 c) { const unsigned sc_ = 0x7F7F7F7Fu;
    asm volatile("v_mfma_scale_f32_16x16x128_f8f6f4 %0, %1, %2, %0, %3, %3 op_sel_hi:[0,0,0]" : "+v"(c) : "v"(a), "v"(b), "v"(sc_)); return c; }
template <class S, bool Dp = S::DEP> struct DepWait { static __device__ __forceinline__ void go(const S&, const Unit&) {} };
template <class S> struct DepWait<S, true> { static __device__ __forceinline__ void go(const S& s, const Unit& u) { s.acquire(u); } };
template <class E_, bool Kp = E_::KEEP> struct EpiCall { static __device__ __forceinline__ bool go(const E_& e, f32x4 (&acc)[2][2][4][2], const Unit& u, int wr, int wc, int fr, int fq) { e(acc, u, wr, wc, fr, fq); return false; } };
template <class E_> struct EpiCall<E_, true> { static __device__ __forceinline__ bool go(const E_& e, f32x4 (&acc)[2][2][4][2], const Unit& u, int wr, int wc, int fr, int fq) { return e.merge(acc, u, wr, wc, fr, fq); } };
template <class Epi, class Sched, bool SWAP>
__device__ __forceinline__ void gemm_phase(LAS unsigned char* lds, const Sched& S, const Epi& E) {
    constexpr bool VARLD = Sched::VARLD, GATHER = Sched::GATHER, DYN = VARLD || GATHER;
    int tid = threadIdx.x; asm volatile("" : "+v"(tid));
    const int wid = __builtin_amdgcn_readfirstlane(tid >> 6), lane = tid & 63, wr = wid >> 2, wc = wid & 3, fr = lane & 15, fq = lane >> 4;
    int RA[2], CA[2], RB[2];
#pragma unroll
    for (int i = 0; i < 2; ++i) { int R, C; stage_rc(tid * 16 + i * 8192, R, C); RA[i] = R; CA[i] = C * 2; RB[i] = Epi::PERM ? ((R & ~31) + perm32(R & 31)) : R; }
    const unsigned ldsw = (unsigned)wid * 1024u;
    const int aoff = lds_byte(wr * 64 + fr, fq * 8), boff = lds_byte(wc * 32 + fr, fq * 8);
    constexpr size_t kstep = (size_t)(BK * 2);
#define PG8_SA(b, h) (((b) * 2 + (h)) * HTB)
#define PG8_SB(b, h) ((4 + (b) * 2 + (h)) * HTB)
#define PG8_GL(bufoff, gptr, i) __builtin_amdgcn_global_load_lds((const GAS unsigned*)(gptr), (LAS unsigned*)(lds + (bufoff) + ldsw + (i) * 8192), 16, 0, 0)
#define PG8_STAGE2(bufoff, p, oa, ob) do { PG8_GL(bufoff, (p) + (oa), 0); PG8_GL(bufoff, (p) + (ob), 1); } while (0)
#define PG8_LDA(dst, b, h) do { _Pragma("unroll") for (int m = 0; m < 4; ++m) _Pragma("unroll") for (int k = 0; k < NK; ++k) dst[m][k] = FR::ld(lds + PG8_SA(b, h) + aoff + m * 2048, k); } while (0)
#define PG8_LDB(dst, b, h) do { _Pragma("unroll") for (int n = 0; n < 2; ++n) _Pragma("unroll") for (int k = 0; k < NK; ++k) dst[n][k] = FR::ld(lds + PG8_SB(b, h) + boff + n * 2048, k); } while (0)
#define PG8_MM(ai, bj, At, Bt) do { __builtin_amdgcn_s_setprio(1); _Pragma("unroll") for (int m = 0; m < 4; ++m) _Pragma("unroll") for (int n = 0; n < 2; ++n) _Pragma("unroll") for (int k = 0; k < NK; ++k) \
        acc[ai][bj][m][n] = SWAP ? mma_frag(At[m][k], Bt[n][k], acc[ai][bj][m][n]) : mma_frag(Bt[n][k], At[m][k], acc[ai][bj][m][n]); __builtin_amdgcn_s_setprio(0); } while (0)
#define PG8_WAIT_V(n) asm volatile("s_waitcnt vmcnt(" #n ")" ::: "memory")
#define PG8_WAIT_L(n) asm volatile("s_waitcnt lgkmcnt(" #n ")" ::: "memory")
#define PG8_BAR __builtin_amdgcn_s_barrier()
#define PG8_SCHED __builtin_amdgcn_sched_barrier(0)
#define PG8_UCOPY(d, s_) do { (d).A = (s_).A; (d).B = (s_).B; (d).pm = (s_).pm; (d).pn = (s_).pn; (d).aux = (s_).aux; (d).nvalid = (s_).nvalid; (d).gather = (s_).gather; (d).lda = (s_).lda; (d).ldb = (s_).ldb; (d).K = (s_).K; } while (0)
#define PG8_UINIT(d) do { (d).A = nullptr; (d).B = nullptr; (d).pm = 0; (d).pn = 0; (d).aux = 0; (d).nvalid = 256; (d).gather = nullptr; (d).lda = 0; (d).ldb = 0; (d).K = 256; } while (0)
    Unit cur, nxt, tmp; int ui = 0;
    PG8_UINIT(cur); PG8_UINIT(nxt);
    if (!S.next(0, cur)) return;
    f32x4 acc[2][2][4][2];
#pragma unroll
    for (int a = 0; a < 2; ++a)
#pragma unroll
        for (int b = 0; b < 2; ++b)
#pragma unroll
            for (int m = 0; m < 4; ++m)
#pragma unroll
                for (int n = 0; n < 2; ++n) acc[a][b][m][n] = (f32x4){0.f, 0.f, 0.f, 0.f};
    using FR = Frag<Sched::F8 ? 1 : (Sched::I8 ? 2 : 0)>; constexpr int NK = FR::NK;
    typename FR::T At[4][NK], B0[2][NK], B1[2][NK];
    unsigned cA0, cA1, cA2 = 0, cA3 = 0, cB0, cB1, nA0 = 0, nA1 = 0, nA2 = 0, nA3 = 0, nB0 = 0, nB1 = 0;
    size_t chA, chB, nhA = 0, nhB = 0;
#define PG8_OFFS(u, a0, a1, a2, a3, b0, b1, hA_, hB_) do { \
        const unsigned lda_ = VARLD ? (u).lda : Sched::LDA, ldb_ = VARLD ? (u).ldb : Sched::LDB; \
        if (GATHER) { const int r0 = RA[0], r1 = RA[1]; \
            const int i0 = r0 < (u).nvalid ? ((u).gather[r0] >> 1) : 0, i1 = r1 < (u).nvalid ? ((u).gather[r1] >> 1) : 0; \
            const int i2 = (r0 + 128) < (u).nvalid ? ((u).gather[r0 + 128] >> 1) : 0, i3 = (r1 + 128) < (u).nvalid ? ((u).gather[r1 + 128] >> 1) : 0; \
            a0 = (unsigned)i0 * lda_ + CA[0]; a1 = (unsigned)i1 * lda_ + CA[1]; a2 = (unsigned)i2 * lda_ + CA[0]; a3 = (unsigned)i3 * lda_ + CA[1]; hA_ = 0; } \
        else { a0 = (unsigned)RA[0] * lda_ + CA[0]; a1 = (unsigned)RA[1] * lda_ + CA[1]; hA_ = (size_t)128 * lda_; } \
        b0 = (unsigned)RB[0] * ldb_ + CA[0]; b1 = (unsigned)RB[1] * ldb_ + CA[1]; hB_ = (size_t)128 * ldb_; } while (0)
    PG8_OFFS(cur, cA0, cA1, cA2, cA3, cB0, cB1, chA, chB);
    const GAS char* cA = cur.A; const GAS char* cB = cur.B;
    DepWait<Sched>::go(S, cur);
#define PG8_A0(buf, p, X) PG8_STAGE2(buf, p, X##A0, X##A1)
#define PG8_A1(buf, p, X) do { if (GATHER) PG8_STAGE2(buf, p, X##A2, X##A3); else PG8_STAGE2(buf, (p) + X##hA, X##A0, X##A1); } while (0)
#define PG8_B0(buf, p, X) PG8_STAGE2(buf, p, X##B0, X##B1)
#define PG8_B1(buf, p, X) PG8_STAGE2(buf, (p) + X##hB, X##B0, X##B1)
    PG8_B0(PG8_SB(0, 0), cB, c); PG8_B1(PG8_SB(0, 1), cB, c); PG8_A0(PG8_SA(0, 0), cA, c); PG8_A1(PG8_SA(0, 1), cA, c);
    if (wr == 1) PG8_BAR;
    PG8_WAIT_V(2); PG8_BAR;
    PG8_B0(PG8_SB(1, 0), cB + kstep, c); PG8_A0(PG8_SA(1, 0), cA + kstep, c); PG8_B1(PG8_SB(1, 1), cB + kstep, c);
    PG8_WAIT_V(6); PG8_BAR;
    for (;;) {
        PG8_UINIT(tmp); const bool has_next = S.next(ui + 1, tmp);
        if (has_next) { PG8_UCOPY(nxt, tmp); } else { PG8_UCOPY(nxt, cur); }
        if (DYN) { if (has_next) { PG8_OFFS(nxt, nA0, nA1, nA2, nA3, nB0, nB1, nhA, nhB); } else { nA0 = cA0; nA1 = cA1; nA2 = cA2; nA3 = cA3; nB0 = cB0; nB1 = cB1; nhA = chA; nhB = chB; } }
        const GAS char* nA = nxt.A; const GAS char* nB = nxt.B;
        const int nt = (VARLD ? cur.K : Sched::KK) / BK;
        for (int t = 0; t < nt; t += 2) {
            const bool last = (t == nt - 2);
            if (Sched::DEP && last && has_next) DepWait<Sched>::go(S, nxt);
            const GAS char* a1 = cA + (size_t)(t + 1) * kstep;
            const GAS char* a2 = last ? nA : cA + (size_t)(t + 2) * kstep; const GAS char* b2 = last ? nB : cB + (size_t)(t + 2) * kstep;
            const GAS char* a3 = a2 + kstep; const GAS char* b3 = b2 + kstep;
            const unsigned sA0 = DYN ? (last ? nA0 : cA0) : cA0, sA1 = DYN ? (last ? nA1 : cA1) : cA1, sA2 = GATHER ? (last ? nA2 : cA2) : 0u, sA3 = GATHER ? (last ? nA3 : cA3) : 0u;
            const unsigned sB0 = VARLD ? (last ? nB0 : cB0) : cB0, sB1 = VARLD ? (last ? nB1 : cB1) : cB1;
            const size_t shA = VARLD ? (last ? nhA : chA) : chA, shB = VARLD ? (last ? nhB : chB) : chB;
            (void)sA2; (void)sA3;
            PG8_LDB(B0, 0, 0); PG8_LDB(B1, 0, 1); PG8_SCHED; PG8_LDA(At, 0, 0); PG8_A1(PG8_SA(1, 1), a1, c);
            PG8_WAIT_V(8); PG8_WAIT_L(0); PG8_BAR; PG8_MM(0, 0, At, B0); PG8_MM(0, 1, At, B1); PG8_BAR; PG8_SCHED;
            PG8_LDA(At, 0, 1); PG8_B0(PG8_SB(0, 0), b2, s); PG8_B1(PG8_SB(0, 1), b2, s); PG8_A0(PG8_SA(0, 0), a2, s);
            PG8_WAIT_V(8); PG8_WAIT_L(0); PG8_BAR; PG8_MM(1, 0, At, B0); PG8_MM(1, 1, At, B1); PG8_BAR; PG8_SCHED;
            PG8_LDB(B0, 1, 0); PG8_LDB(B1, 1, 1); PG8_SCHED; PG8_LDA(At, 1, 0); PG8_A1(PG8_SA(0, 1), a2, s);
            PG8_WAIT_V(8); PG8_WAIT_L(0); PG8_BAR; PG8_MM(0, 0, At, B0); PG8_MM(0, 1, At, B1); PG8_BAR; PG8_SCHED;
            PG8_LDA(At, 1, 1); PG8_B0(PG8_SB(1, 0), b3, s); PG8_B1(PG8_SB(1, 1), b3, s); PG8_A0(PG8_SA(1, 0), a3, s);
            PG8_WAIT_V(8); PG8_WAIT_L(0); PG8_BAR; PG8_MM(1, 0, At, B0); PG8_MM(1, 1, At, B1); PG8_BAR; PG8_SCHED;
        }
        if (wr == 0) PG8_BAR;
        const bool keep = EpiCall<Epi>::go(E, acc, cur, wr, wc, fr, fq);
        if (!has_next) break;
        if (!keep) {
#pragma unroll
        for (int a = 0; a < 2; ++a)
#pragma unroll
            for (int b = 0; b < 2; ++b)
#pragma unroll
                for (int m = 0; m < 4; ++m)
#pragma unroll
                    for (int n = 0; n < 2; ++n) acc[a][b][m][n] = (f32x4){0.f, 0.f, 0.f, 0.f}; }
        PG8_UCOPY(cur, nxt); cA = nA; cB = nB; ++ui;
        if (DYN) { cA0 = nA0; cA1 = nA1; cA2 = nA2; cA3 = nA3; cB0 = nB0; cB1 = nB1; chA = nhA; chB = nhB; }
        if (wr == 1) PG8_BAR;
    }
    PG8_WAIT_V(0);
    PG8_BAR;
#undef PG8_SA
#undef PG8_SB
#undef PG8_GL
#undef PG8_STAGE2
#undef PG8_A0
#undef PG8_A1
#undef PG8_B0
#undef PG8_B1
#undef PG8_LDA
#undef PG8_LDB
#undef PG8_MM
#undef PG8_WAIT_V
#undef PG8_WAIT_L
#undef PG8_BAR
#undef PG8_SCHED
#undef PG8_OFFS
#undef PG8_UCOPY
#undef PG8_UINIT
}
}

struct Args {
    const float* in[18]; float* out; unsigned char* ws; int ph_lo, ph_hi;
};
struct Frame {
    LAS unsigned char* lds; volatile LAS unsigned* MISC;
    int tid, lane, wave, vcu, G, bx;
};
__device__ __forceinline__ Frame phase_frame(const Frame& F0) {
    Frame F = F0; int t = F0.tid, v = F0.vcu, g = F0.G, b = (int)blockIdx.x;
    asm volatile("" : "+v"(t)); asm volatile("" : "+s"(v)); asm volatile("" : "+s"(g)); asm volatile("" : "+s"(b));
    F.tid = t; F.lane = t & 63; F.wave = __builtin_amdgcn_readfirstlane(t >> 6); F.vcu = v; F.G = g; F.bx = b; return F;
}
template <int OFF> __device__ __forceinline__ const void* karg_ptr() {
    const void* p; auto ka = __builtin_amdgcn_kernarg_segment_ptr();
    asm volatile("s_load_dwordx2 %0, %1, %2\n\ts_waitcnt lgkmcnt(0)" : "=s"(p) : "s"(ka), "i"(OFF) : "memory");
#if defined(__HIP_DEVICE_COMPILE__)
    __builtin_assume(!__builtin_amdgcn_is_shared(p)); __builtin_assume(!__builtin_amdgcn_is_private(p));
#endif
    return p;
}
#define KIN(i) ((const GAS float*)karg_ptr<8 * (i)>())
#define KOUT() ((GAS float*)karg_ptr<144>())
#define KWS() ((GAS unsigned char*)karg_ptr<152>())
static_assert(offsetof(Args, out) == 144 && offsetof(Args, ws) == 152 && offsetof(Args, ph_lo) == 160, "Args layout");

__device__ __forceinline__ void transpose_item(const GAS float* W, int K, int N, GAS bf16_t* WT, int drow0, LAS float* scr, int kb, int nb, int lane, int f8 = 0, float wq = 0.f) {
    const int k0 = 64 * kb, n0 = 32 * nb;
    { const int n4 = lane & 7, kr = lane >> 3; const GAS float* src = W + (size_t)(k0 + kr) * N + n0 + 4 * n4; f32x4 v[8];
#pragma unroll
      for (int i = 0; i < 8; ++i) v[i] = __builtin_nontemporal_load((const GAS f32x4*)(src + (size_t)(8 * i) * N));
#pragma unroll
      for (int i = 0; i < 8; ++i) { LAS float* d = scr + (8 * i + kr) * 33 + 4 * n4; d[0] = v[i][0]; d[1] = v[i][1]; d[2] = v[i][2]; d[3] = v[i][3]; } }
    LDS_WAIT(); asm volatile("" ::: "memory");
    const int c = lane & 7;
#pragma unroll
    for (int j = 0; j < 4; ++j) { const int n = (lane >> 3) + 8 * j; const LAS float* s = scr + (8 * c) * 33 + n;
        if (f8 == 2) {
            unsigned lo_ = 0, hi_ = 0;
            lo_ = __builtin_amdgcn_cvt_pk_fp8_f32(f8c(s[0 * 33] * wq), f8c(s[1 * 33] * wq), lo_, false); lo_ = __builtin_amdgcn_cvt_pk_fp8_f32(f8c(s[2 * 33] * wq), f8c(s[3 * 33] * wq), lo_, true);
            hi_ = __builtin_amdgcn_cvt_pk_fp8_f32(f8c(s[4 * 33] * wq), f8c(s[5 * 33] * wq), hi_, false); hi_ = __builtin_amdgcn_cvt_pk_fp8_f32(f8c(s[6 * 33] * wq), f8c(s[7 * 33] * wq), hi_, true);
            *(GAS u32x2*)((GAS unsigned char*)WT + (size_t)(drow0 + n) * K + k0 + 8 * c) = (u32x2){lo_, hi_}; continue; }
        if (f8) {
            const unsigned lo_ = pk_i8(s[0 * 33], s[1 * 33], s[2 * 33], s[3 * 33], wq), hi_ = pk_i8(s[4 * 33], s[5 * 33], s[6 * 33], s[7 * 33], wq);
            *(GAS u32x2*)((GAS unsigned char*)WT + (size_t)(drow0 + n) * K + k0 + 8 * c) = (u32x2){lo_, hi_}; continue; }
        u32x4 o; o.x = pk2(s[0 * 33], s[1 * 33]); o.y = pk2(s[2 * 33], s[3 * 33]); o.z = pk2(s[4 * 33], s[5 * 33]); o.w = pk2(s[6 * 33], s[7 * 33]);
        *(GAS u32x4*)(WT + (size_t)(drow0 + n) * K + k0 + 8 * c) = o; }
    LDS_WAIT(); asm volatile("" ::: "memory");
}
__device__ __forceinline__ void sincos_d(double a, float& sn, float& cs) {
    const double kf = __builtin_rint(a * 0.63661977236758134308);
    const double r = (a - kf * 1.57079632679489655800) - kf * 6.123233995736766036e-17;
    const double r2 = r * r;
    double s = r * (1.0 + r2 * (-1.0 / 6 + r2 * (1.0 / 120 + r2 * (-1.0 / 5040 + r2 * (1.0 / 362880 + r2 * (-1.0 / 39916800 + r2 * (1.0 / 6227020800.0)))))));
    double c = 1.0 + r2 * (-0.5 + r2 * (1.0 / 24 + r2 * (-1.0 / 720 + r2 * (1.0 / 40320 + r2 * (-1.0 / 3628800 + r2 * (1.0 / 479001600.0 + r2 * (-1.0 / 87178291200.0)))))));
    const int q = ((int)kf) & 3;
    const double ss = (q == 0) ? s : (q == 1) ? c : (q == 2) ? -s : -c;
    const double cc = (q == 0) ? c : (q == 1) ? -s : (q == 2) ? -c : s;
    sn = (float)ss; cs = (float)cc;
}
__device__ __forceinline__ void phase_w0a(Frame& F) {
    LAS float* scr = (LAS float*)(F.lds + F.wave * 16384); GAS unsigned char* ws = KWS();
    const int gw = F.vcu * NWAVES + F.wave, NGW = F.G * NWAVES; constexpr int I_KV = (D / 64) * (2048 / 32);
    for (int it = gw; it < DEPTH * I_KV; it += NGW) { const int l = it / I_KV, r = it % I_KV, nblk = 2048 / 32;
        transpose_item(KIN(6) + (size_t)l * D * 2048, D, 2048, (GAS bf16_t*)(ws + WS_WKV) + (size_t)l * 2048 * D, 32 * (r % nblk), scr, r / nblk, r % nblk, F.lane); }
    const size_t gt = (size_t)F.vcu * 512 + F.tid, GT = (size_t)F.G * 512;
    for (int l = 0; l < DEPTH; ++l) { const GAS f32x4* wv = (const GAS f32x4*)(KIN(2) + (size_t)l * D * INW); float mx = 0.f;
        for (size_t i = gt; i < (size_t)D * INW / 64; i += GT) { const f32x4 v = __builtin_nontemporal_load(wv + i * 16); mx = fmaxf(fmaxf(mx, fmaxf(fabsf(v.x), fabsf(v.y))), fmaxf(fabsf(v.z), fabsf(v.w))); }
        mx = wave_max(mx); if (F.lane == 0) (void)__hip_atomic_fetch_max((GAS unsigned*)(ws + WS_CTL) + CW_WMAX + l, __float_as_uint(mx), __ATOMIC_RELAXED, __HIP_MEMORY_SCOPE_AGENT); }
    { const GAS f32x4* x = (const GAS f32x4*)KIN(1); GAS u32x4* xb = (GAS u32x4*)(ws + WS_MEMB);
      for (size_t i = gt; i < (size_t)2048 * D / 8; i += GT) { const f32x4 a = x[2 * i], b = x[2 * i + 1]; u32x4 o; o.x = pk2(a.x, a.y); o.y = pk2(a.z, a.w); o.z = pk2(b.x, b.y); o.w = pk2(b.z, b.w); xb[i] = o; } }
}
constexpr int KV_WGS = 64;
__device__ __forceinline__ void phase_w(Frame& F, int l) {
    LAS float* scr = (LAS float*)(F.lds + F.wave * 16384);
    GAS unsigned char* ws = KWS();
    const GAS float* w_in = KIN(2) + (size_t)l * D * INW; const GAS float* p_moba = KIN(3) + (size_t)l * 1024 * D; const GAS float* p_ret = KIN(4) + (size_t)l * 2048 * D;
    const GAS float* p_mem = KIN(5) + (size_t)l * 1024 * D; const GAS float* w_o = KIN(7) + (size_t)l * D * D;
    const GAS float* w_gu = KIN(14) + (size_t)l * NEXP * D * 1024; const GAS float* w_dn = KIN(15) + (size_t)l * NEXP * EFF * D;
    constexpr int I_IN = (D / 64) * (INW / 32), I_PM = (1024 / 64) * (D / 32), I_PR = (2048 / 64) * (D / 32), I_PE = I_PM, I_WO = (D / 64) * (D / 32);
    constexpr int I_GU1 = (D / 64) * (1024 / 32), I_GU = NEXP * I_GU1, I_DN1 = (EFF / 64) * (D / 32), I_DN = NEXP * I_DN1;
    constexpr int NITEMS = I_IN + I_PM + I_PR + I_PE + I_WO + I_GU + I_DN;
    const float wmax_in = fmaxf(WQ_RANGE * __uint_as_float(xb_ld((GAS unsigned*)(ws + WS_CTL) + CW_WMAX + l)), 1e-30f), wq_in = 127.0f / wmax_in;
    const bool skew = (F.G > KV_WGS); const int NA = skew ? (int)(0.77f * NITEMS) : NITEMS;
    const int nA = (NA - (F.vcu * NWAVES + F.wave) + F.G * NWAVES - 1) / (F.G * NWAVES);
    const int gwB = (F.vcu - KV_WGS) * NWAVES + F.wave, NGWB = (F.G - KV_WGS) * NWAVES;
    const int nB = (skew && F.vcu >= KV_WGS) ? (NITEMS - NA - gwB + NGWB - 1) / NGWB : 0;
    for (int ii = 0; ii < nA + nB; ++ii) {
        int r = ii < nA ? (F.vcu * NWAVES + F.wave) + ii * (F.G * NWAVES) : NA + gwB + (ii - nA) * NGWB;
        if (r < I_IN) { const int nblk = INW / 32, nb_ = r % nblk;
            transpose_item(w_in, D, INW, (GAS bf16_t*)(ws + WS_WIN8), 32 * nb_, scr, r / nblk, nb_, F.lane, 1, wq_in); continue; } r -= I_IN;
        if (r < I_PM) { const int nblk = D / 32; transpose_item(p_moba, 1024, D, (GAS bf16_t*)(ws + WS_WPM), 32 * (r % nblk), scr, r / nblk, r % nblk, F.lane, 2, GATE_WSCALE); continue; } r -= I_PM;
        if (r < I_PR) { const int nblk = D / 32; transpose_item(p_ret, 2048, D, (GAS bf16_t*)(ws + WS_WPR), 32 * (r % nblk), scr, r / nblk, r % nblk, F.lane, 2, GATE_WSCALE); continue; } r -= I_PR;
        if (r < I_PE) { const int nblk = D / 32; transpose_item(p_mem, 1024, D, (GAS bf16_t*)(ws + WS_WPE), 32 * (r % nblk), scr, r / nblk, r % nblk, F.lane, 2, GATE_WSCALE); continue; } r -= I_PE;
        if (r < I_WO) { const int nblk = D / 32; transpose_item(w_o, D, D, (GAS bf16_t*)(ws + WS_WO), 32 * (r % nblk), scr, r / nblk, r % nblk, F.lane); continue; } r -= I_WO;
        if (r < I_GU) { const int e = r / I_GU1, q = r % I_GU1, nblk = 1024 / 32, nb = q % nblk, kb = q / nblk; const int n0 = 32 * nb;
            const int f = n0 & 511, drow = 256 * (f >> 7) + (f & 127) + ((n0 >= 512) ? 128 : 0);
            transpose_item(w_gu + (size_t)e * D * 1024, D, 1024, (GAS bf16_t*)(ws + WS_WGU) + (size_t)e * 1024 * D, drow, scr, kb, nb, F.lane); continue; } r -= I_GU;
        { const int e = r / I_DN1, q = r % I_DN1, nblk = D / 32; transpose_item(w_dn + (size_t)e * EFF * D, EFF, D, (GAS bf16_t*)(ws + WS_WDN + (size_t)e * D * EFF), 32 * (q % nblk), scr, q / nblk, q % nblk, F.lane, 2, GATE_WSCALE); }
    }
    { const GAS float* wg = KIN(10) + (size_t)l * D * 4; const GAS float* we = KIN(12) + (size_t)l * D * NEXP;
      const GAS float* g1 = KIN(8) + (size_t)l * D; const GAS float* b1 = KIN(9) + (size_t)l * D; const GAS float* bg = KIN(11) + (size_t)l * 4; const GAS float* be = KIN(13) + (size_t)l * NEXP;
      GAS bf16_t* wgh = (GAS bf16_t*)(ws + WS_WRT); GAS bf16_t* wgl = (GAS bf16_t*)(ws + WS_WRT + WRT_GL); GAS float* csp = (GAS float*)(ws + WS_WRT + WRT_CS); GAS float* c0p = (GAS float*)(ws + WS_WRT + WRT_C0);
      const int c = F.G * NWAVES - 1 - (F.vcu * NWAVES + F.wave);
      if (c < 48) { float s_cs = 0.f, s_c0 = 0.f;
          for (int i = 0; i < D / 64; ++i) { const int k = F.lane + 64 * i; const float w = c < 4 ? wg[k * 4 + c] : (c < 36 ? we[k * NEXP + (c - 4)] : 0.f);
              const float v = g1[k] * w; const unsigned hi = pk2(v, 0.f) & 0xffffu; const float hf = bf_lo(hi); const unsigned lo = pk2(v - hf, 0.f) & 0xffffu;
              wgh[(size_t)c * D + k] = (bf16_t)hi; wgl[(size_t)c * D + k] = (bf16_t)lo; s_cs += hf + bf_lo(lo); s_c0 += b1[k] * w; }
          s_cs = wave_sum(s_cs); s_c0 = wave_sum(s_c0);
          if (F.lane == 0) { csp[c] = s_cs; c0p[c] = s_c0 + (c < 4 ? bg[c] : (c < 36 ? be[c - 4] : 0.f)); } } }
    if (l == 0) {
        const size_t gt = (size_t)F.vcu * 512 + F.tid, GT = (size_t)F.G * 512;
        { const GAS float* x = KIN(0); GAS bf16_t* xb = (GAS bf16_t*)(ws + WS_XB); GAS unsigned char* xb8 = (GAS unsigned char*)(ws + WS_XB8); GAS float* xs = (GAS float*)(ws + WS_XS);
          for (int row = F.vcu * NWAVES + F.wave; row < T; row += F.G * NWAVES) { f32x4 v[8]; float mx = 0.f;
#pragma unroll
              for (int j = 0; j < 8; ++j) { v[j] = __builtin_nontemporal_load((const GAS f32x4*)(x + (size_t)row * D + 4 * F.lane + 256 * j)); mx = fmaxf(fmaxf(mx, fmaxf(fabsf(v[j][0]), fabsf(v[j][1]))), fmaxf(fabsf(v[j][2]), fabsf(v[j][3]))); }
              mx = fmaxf(wave_max(mx), 1e-30f); const float q = 127.0f / mx; if (F.lane == 0) xs[row] = mx * (1.0f / 127.0f);
#pragma unroll
              for (int j = 0; j < 8; ++j) { const size_t c = 4 * F.lane + 256 * j; u32x2 wv; wv.x = pk2(v[j][0], v[j][1]); wv.y = pk2(v[j][2], v[j][3]); *(GAS u32x2*)(xb + (size_t)row * D + c) = wv;
                  *(GAS unsigned*)(xb8 + (size_t)row * D + c) = pk_i8(v[j][0], v[j][1], v[j][2], v[j][3], q); } } }
        { GAS float* ct = (GAS float*)(ws + WS_ROPE); GAS float* st = ct + 2048 * 128;
          for (size_t i = gt; i < (size_t)2048 * 128; i += GT) { const int pos = (int)(i >> 7), j = (int)(i & 127);
              double inv = 1.0, rp = 0.9300449458481392; int e = j;
#pragma unroll
              for (int b = 0; b < 7; ++b) { if (e & 1) inv *= rp; rp *= rp; e >>= 1; }
              float sn, cs; sincos_d((double)pos * inv, sn, cs); ct[i] = cs; st[i] = sn; } }
    }
}

using pg8::Unit;
struct SchedProj {
    static constexpr bool VARLD = false, GATHER = false, DEP = false, F8 = false, I8 = true; static constexpr unsigned LDA = 2048, LDB = 2048; static constexpr int KK = 1024;
    const GAS char* xb; const GAS char* win; int G, c, mode;
    __device__ __forceinline__ bool next(int i, Unit& u) const {
        const int L = i * G + c; const int nN = mode ? 12 : 52, nmain = 64 * nN;
        u.gather = nullptr; u.nvalid = 256; u.aux = 0;
        if (L < nmain) { int pm, j; pg8::static_tile(L, 64, nN, pm, j);
            int pn; if (mode) pn = j < 4 ? 8 + j : 16 + j; else pn = j < 8 ? j : (j < 16 ? j + 4 : j + 12);
            u.pm = pm; u.pn = pn; u.A = xb + (size_t)pm * 256 * 2048; u.B = win + (size_t)pn * 256 * 2048; return true; }
        return false;
    }
};
struct SchedGate {
    static constexpr bool VARLD = false, GATHER = false, DEP = false, F8 = true, I8 = false; static constexpr unsigned LDA = 2048, LDB = 2048; static constexpr int KK = 1024;
    const GAS char* xb8; const GAS char* win8; int G, c;
    __device__ __forceinline__ bool next(int i, Unit& u) const {
        const int L = i * G + c; if (L >= 64 * (24 + NF8X)) return false;
        int pm, j; pg8::static_tile(L, 64, 24 + NF8X, pm, j);
        u.gather = nullptr; u.nvalid = 256; u.aux = 0; u.pm = pm; u.pn = j < 24 ? 40 + j : (j < 28 ? 12 + j : j - 28); u.A = xb8 + (size_t)pm * 256 * 2048;
        u.B = win8 + (size_t)(j < 24 ? 256 * j : 9216 + 256 * (j - 24)) * 2048; return true;
    }
};
struct SchedVT8 {
    static constexpr bool VARLD = false, GATHER = false, DEP = false, F8 = true, I8 = false; static constexpr unsigned LDA = 2048, LDB = 2048; static constexpr int KK = 1024;
    const GAS char* xb8; const GAS char* win8; int G, c;
    __device__ __forceinline__ bool next(int i, Unit& u) const {
        const int L = i * G + c; if (L >= 64 * 12) return false;
        int pm, j; pg8::static_tile(L, 64, 12, pm, j);
        u.gather = nullptr; u.nvalid = 256; u.aux = 0; u.pm = pm; u.pn = j < 4 ? 8 + j : 16 + j; u.A = xb8 + (size_t)pm * 256 * 2048; u.B = win8 + (size_t)(6144 + 256 * j) * 2048; return true;
    }
};
struct SchedKv {
    static constexpr bool VARLD = false, GATHER = false, DEP = false, F8 = false, I8 = false; static constexpr unsigned LDA = 4096, LDB = 4096; static constexpr int KK = 2048;
    const GAS char* memb; const GAS char* wkv; int c;
    __device__ __forceinline__ bool next(int i, Unit& u) const {
        if (i > 0 || c >= 64) return false; const int q = c;
        u.gather = nullptr; u.nvalid = 256;
        if (q < 32) { u.aux = 1; u.pm = q >> 2; u.pn = q & 3; u.A = memb + (size_t)u.pm * 256 * 4096; u.B = wkv + (size_t)u.pn * 256 * 4096; }
        else { const int r = q - 32; u.aux = 2; u.pm = r >> 3; u.pn = r & 7; u.A = wkv + (size_t)(1024 + u.pm * 256) * 4096; u.B = memb + (size_t)u.pn * 256 * 4096; }
        return true;
    }
};
struct EpiProj {
    static constexpr bool PERM = true, KEEP = false;
    GAS unsigned char* ws; const GAS float* ropec; const GAS float* ropes;
    template <int MODE, bool I8 = false> __device__ __forceinline__ void store(const f32x4 (&acc)[2][2][4][2], GAS bf16_t* O, int ldc, int row0, int col0, float sc, int head, int wr, int wc, int fr, int fq, const GAS float* xs = nullptr, float wdq = 1.0f) const {
        const int r0 = row0 + wr * 64 + fr, c0 = col0 + wc * 32 + 8 * fq;
        float rq[2][4];
#pragma unroll
        for (int ai = 0; ai < 2; ++ai)
#pragma unroll
            for (int m = 0; m < 4; ++m) rq[ai][m] = I8 ? xs[r0 + ai * 128 + m * 16] * wdq : 1.0f;
#define ACCV(ai_, bj_, m_, n_) (I8 ? __builtin_convertvector(__builtin_bit_cast(v4i32, acc[ai_][bj_][m_][n_]), f32x4) * rq[ai_][m_] : acc[ai_][bj_][m_][n_])
        float lg = 0.f; if ((MODE == 3 || MODE == 4)) lg = log2f(1.0f - exp2f(-5.0f - (float)head));
#pragma unroll
        for (int ai = 0; ai < 2; ++ai) {
            if ((MODE == 3 || MODE == 4)) {
#pragma unroll
                for (int mh = 0; mh < 2; ++mh) {
                f32x4 cA[2], cB[2], sA[2], sB[2];
#pragma unroll
                for (int m2 = 0; m2 < 2; ++m2) { const int m = 2 * mh + m2; const int pos = (r0 + ai * 128 + m * 16) & (SEQ - 1); const GAS float* cp = ropec + pos * 128 + wc * 32 + 8 * fq; const GAS float* sp = ropes + pos * 128 + wc * 32 + 8 * fq;
                    cA[m2] = *(const GAS f32x4*)(cp); cB[m2] = *(const GAS f32x4*)(cp + 4); sA[m2] = *(const GAS f32x4*)(sp); sB[m2] = *(const GAS f32x4*)(sp + 4); }
#pragma unroll
                for (int m2 = 0; m2 < 2; ++m2) { const int m = 2 * mh + m2; const int row = r0 + ai * 128 + m * 16; GAS bf16_t* rowp = O + (size_t)row * ldc + c0;
                    const int pos = row & (SEQ - 1); const float e = (float)(pos & 255) * lg;
                    const float rs = (MODE == 3) ? fast_exp2(e) : 0.0625f * fast_exp2(-e);
                    const f32x4 x1a = ACCV(ai, 0, m, 0), x1b = ACCV(ai, 0, m, 1), x2a = ACCV(ai, 1, m, 0), x2b = ACCV(ai, 1, m, 1);
                    const f32x4 o1a = (x1a * cA[m2] - x2a * sA[m2]) * rs, o1b = (x1b * cB[m2] - x2b * sB[m2]) * rs, o2a = (x1a * sA[m2] + x2a * cA[m2]) * rs, o2b = (x1b * sB[m2] + x2b * cB[m2]) * rs;
                    u32x4 w; w.x = pk2(o1a[0], o1a[1]); w.y = pk2(o1a[2], o1a[3]); w.z = pk2(o1b[0], o1b[1]); w.w = pk2(o1b[2], o1b[3]); *(GAS u32x4*)(rowp) = w;
                    w.x = pk2(o2a[0], o2a[1]); w.y = pk2(o2a[2], o2a[3]); w.z = pk2(o2b[0], o2b[1]); w.w = pk2(o2b[2], o2b[3]); *(GAS u32x4*)(rowp + 128) = w; }
                asm volatile("" ::: "memory"); }
                asm volatile("" ::: "memory");
            } else {
#pragma unroll
                for (int m = 0; m < 4; ++m) { const int row = r0 + ai * 128 + m * 16; GAS bf16_t* rowp = O + (size_t)row * ldc + c0;
#pragma unroll
                    for (int bj = 0; bj < 2; ++bj) { f32x4 v0 = ACCV(ai, bj, m, 0), v1 = ACCV(ai, bj, m, 1);
                        if (MODE == 0) { v0 = v0 * sc; v1 = v1 * sc; }
                        if (MODE == 1) {
#pragma unroll
                            for (int j = 0; j < 4; ++j) { v0[j] = v0[j] * sigmoidf_(v0[j]); v1[j] = v1[j] * sigmoidf_(v1[j]); } }
                        if (MODE == 2) {
#pragma unroll
                            for (int j = 0; j < 4; ++j) { v0[j] = sigmoidf_(v0[j]); v1[j] = sigmoidf_(v1[j]); } }
                        if (MODE == 5) {
                            u32x2 wq = {0u, 0u};
#pragma unroll
                            for (int j = 0; j < 4; ++j) { wq.x = __builtin_amdgcn_cvt_pk_u8_f32(fminf(__builtin_truncf(sigmoidf_(v0[j] * sc) * 256.0f), 255.0f), j, wq.x); wq.y = __builtin_amdgcn_cvt_pk_u8_f32(fminf(__builtin_truncf(sigmoidf_(v1[j] * sc) * 256.0f), 255.0f), j, wq.y); }
                            *(GAS u32x2*)((GAS unsigned char*)O + (size_t)row * ldc + c0 + bj * 128) = wq; continue; }
                        u32x4 w; w.x = pk2(v0[0], v0[1]); w.y = pk2(v0[2], v0[3]); w.z = pk2(v1[0], v1[1]); w.w = pk2(v1[2], v1[3]);
                        if (MODE == 6) {
                            GAS bf16_t* gp = rowp + bj * 128 - 8 * (fq & 1) + 4 * (fq & 1); *(GAS u32x2*)(gp) = (u32x2){w.x, w.y}; *(GAS u32x2*)(gp + 8) = (u32x2){w.z, w.w}; continue; }
                        *(GAS u32x4*)(rowp + bj * 128) = w; } } } }
#undef ACCV
    }
    __device__ __forceinline__ void operator()(const f32x4 (&acc)[2][2][4][2], const Unit& u, int wr, int wc, int fr, int fq) const {
        const int row0 = u.pm * 256, pn = u.pn;
        if (u.aux == 1) { store<0>(acc, (GAS bf16_t*)(ws + WS_KM), 1024, row0, pn * 256, 1.0f, 0, wr, wc, fr, fq); return; }
        if (u.aux == 2) { store<6>(acc, (GAS bf16_t*)(ws + WS_VMT), 2048, row0, pn * 256, 1.0f, 0, wr, wc, fr, fq); return; }
        if (pn < 4) store<0>(acc, (GAS bf16_t*)(ws + WS_AQ), 1024, row0, pn * 256, 0.08838834764831845f * LOG2E, 0, wr, wc, fr, fq);
        else if (pn < 8) store<0>(acc, (GAS bf16_t*)(ws + WS_AK), 1024, row0, (pn - 4) * 256, 1.0f, 0, wr, wc, fr, fq);
        else if (pn < 16) store<3>(acc, (GAS bf16_t*)(ws + WS_RQ), 1024, row0, (pn - 12) * 256, 1.0f, pn - 12, wr, wc, fr, fq);
        else if (pn < 20) store<4>(acc, (GAS bf16_t*)(ws + WS_RK), 1024, row0, (pn - 16) * 256, 1.0f, pn - 16, wr, wc, fr, fq);
        else if (pn < 36) store<1>(acc, (GAS bf16_t*)(ws + WS_RGS), 2048, row0, (pn - 28) * 256, 1.0f, 0, wr, wc, fr, fq);
        else if (pn < 40) store<0>(acc, (GAS bf16_t*)(ws + WS_MQ), 1024, row0, (pn - 36) * 256, 0.0625f * LOG2E, 0, wr, wc, fr, fq);
        else if (pn < 48) store<5>(acc, (GAS bf16_t*)(ws + WS_SGA), 2048, row0, (pn - 40) * 256, 1.0f / GATE_WSCALE, 0, wr, wc, fr, fq);
        else if (pn < 56) store<5>(acc, (GAS bf16_t*)(ws + WS_SGR), 2048, row0, (pn - 48) * 256, 1.0f / GATE_WSCALE, 0, wr, wc, fr, fq);
        else store<5>(acc, (GAS bf16_t*)(ws + WS_SGM), 2048, row0, (pn - 56) * 256, 1.0f / GATE_WSCALE, 0, wr, wc, fr, fq);
    }
};
struct EpiProjQ {
    static constexpr bool PERM = true, KEEP = false;
    EpiProj P; const GAS float* xs; float wdq;
    __device__ __forceinline__ void operator()(const f32x4 (&acc)[2][2][4][2], const Unit& u, int wr, int wc, int fr, int fq) const {
        const int row0 = u.pm * 256, pn = u.pn; GAS unsigned char* ws = P.ws;
        if (pn < 4) P.template store<0, true>(acc, (GAS bf16_t*)(ws + WS_AQ), 1024, row0, pn * 256, 0.08838834764831845f * LOG2E, 0, wr, wc, fr, fq, xs, wdq);
        else if (pn < 8) P.template store<0, true>(acc, (GAS bf16_t*)(ws + WS_AK), 1024, row0, (pn - 4) * 256, 1.0f, 0, wr, wc, fr, fq, xs, wdq);
        else if (pn < 16) P.template store<3, true>(acc, (GAS bf16_t*)(ws + WS_RQ), 1024, row0, (pn - 12) * 256, 1.0f, pn - 12, wr, wc, fr, fq, xs, wdq);
        else if (pn < 20) P.template store<4, true>(acc, (GAS bf16_t*)(ws + WS_RK), 1024, row0, (pn - 16) * 256, 1.0f, pn - 16, wr, wc, fr, fq, xs, wdq);
        else if (pn < 36) P.template store<1, true>(acc, (GAS bf16_t*)(ws + WS_RGS), 2048, row0, (pn - 28) * 256, 1.0f, 0, wr, wc, fr, fq, xs, wdq);
        else if (pn < 40) P.template store<0, true>(acc, (GAS bf16_t*)(ws + WS_MQ), 1024, row0, (pn - 36) * 256, 0.0625f * LOG2E, 0, wr, wc, fr, fq, xs, wdq);
        else { const int g = pn - 40; P.template store<5, true>(acc, (GAS bf16_t*)(ws + WS_SGA + (size_t)(g >> 3) * (64 * MiB)), 2048, row0, (g & 7) * 256, 1.0f, 0, wr, wc, fr, fq, xs, wdq); }
    }
};
struct EpiGate {
    static constexpr bool PERM = true, KEEP = false;
    EpiProj P;
    __device__ __forceinline__ void operator()(const f32x4 (&acc)[2][2][4][2], const Unit& u, int wr, int wc, int fr, int fq) const {
        if (u.pn < 4) { P.template store<0>(acc, (GAS bf16_t*)(P.ws + WS_AQ), 1024, u.pm * 256, u.pn * 256, 0.08838834764831845f * LOG2E / GATE_WSCALE, 0, wr, wc, fr, fq); return; }
        if (u.pn < 8) { P.template store<0>(acc, (GAS bf16_t*)(P.ws + WS_AK), 1024, u.pm * 256, (u.pn - 4) * 256, 1.0f / GATE_WSCALE, 0, wr, wc, fr, fq); return; }
        if (u.pn < 40) { P.template store<0>(acc, (GAS bf16_t*)(P.ws + WS_MQ), 1024, u.pm * 256, (u.pn - 36) * 256, 0.0625f * LOG2E / GATE_WSCALE, 0, wr, wc, fr, fq); return; }
        const int g = u.pn - 40;
        P.template store<5>(acc, (GAS bf16_t*)(P.ws + WS_SGA + (size_t)(g >> 3) * (64 * MiB)), 2048, u.pm * 256, (g & 7) * 256, 1.0f / GATE_WSCALE, 0, wr, wc, fr, fq);
    }
};
struct EpiProjT {
    static constexpr bool PERM = false, KEEP = false;
    GAS unsigned char* ws; float sc; const GAS float* xs;
    __device__ __forceinline__ void operator()(const f32x4 (&acc)[2][2][4][2], const Unit& u, int wr, int wc, int fr, int fq) const {
        const int pn = u.pn; const bool isav = pn < 12; const int ncols = isav ? 1024 : 2048; const int colt = isav ? (pn - 8) * 256 : (pn - 20) * 256;
        GAS bf16_t* base = (GAS bf16_t*)(ws + (isav ? WS_AVT : WS_RVT)) + (size_t)(u.pm >> 3) * ncols * SEQ;
        const int fqp = isav ? ((fq == 1) ? 2 : ((fq == 2) ? 1 : fq)) : fq;
        const int s0 = (u.pm & 7) * 256 + wr * 64 + 4 * fqp, c0 = colt + wc * 32 + fr;
#pragma unroll
        for (int ai = 0; ai < 2; ++ai)
#pragma unroll
            for (int bj = 0; bj < 2; ++bj)
#pragma unroll
                for (int m = 0; m < 4; ++m)
#pragma unroll
                    for (int n = 0; n < 2; ++n) { const f32x4 rs4 = *(const GAS f32x4*)(xs + u.pm * 256 + wr * 64 + 4 * fq + ai * 128 + m * 16);
                        const f32x4 v = __builtin_convertvector(__builtin_bit_cast(v4i32, acc[ai][bj][m][n]), f32x4) * rs4 * sc; u32x2 w; w.x = pk2(v[0], v[1]); w.y = pk2(v[2], v[3]);
                        *(GAS u32x2*)(base + (size_t)(c0 + bj * 128 + n * 16) * SEQ + s0 + ai * 128 + m * 16) = w; }
    }
};
struct SchedMerge {
    static constexpr bool VARLD = true, GATHER = false, DEP = false, F8 = true, I8 = false; static constexpr unsigned LDA = 0, LDB = 0; static constexpr int KK = 0;
    const GAS char* ya; const GAS char* yr; const GAS char* ym; const GAS char* wpm; const GAS char* wpr; const GAS char* wpe; int G, c;
    __device__ __forceinline__ bool next(int i, Unit& u) const {
        const int ti = i / 3, ord = i - 3 * ti;
        const int br = (c & 1) ? (ord == 0 ? 0 : (ord == 1 ? 2 : 1)) : (ord == 0 ? 1 : (ord == 1 ? 0 : 2));
        const int L = ti * G + c; if (L >= 512) return false;
        int pm, pn; pg8::static_tile(L, 64, 8, pm, pn); u.pm = pm; u.pn = pn; const int ordn = ord + 1, brn = (c & 1) ? (ordn == 1 ? 2 : 1) : (ordn == 1 ? 0 : 2); u.aux = br + 4 * ord + 16 * brn; u.gather = nullptr; u.nvalid = 256;
        if (br == 0) { u.K = 512; u.lda = 1024; u.ldb = 1024; u.A = ya + (size_t)pm * 256 * 1024; u.B = wpm + (size_t)pn * 256 * 1024; }
        else if (br == 1) { u.K = 1024; u.lda = 2048; u.ldb = 2048; u.A = yr + (size_t)pm * 256 * 2048; u.B = wpr + (size_t)pn * 256 * 2048; }
        else { u.K = 512; u.lda = 1024; u.ldb = 1024; u.A = ym + (size_t)pm * 256 * 1024; u.B = wpe + (size_t)pn * 256 * 1024; }
        return true;
    }
};
struct EpiMerge {
    static constexpr bool PERM = true, KEEP = true;
    const GAS unsigned char* sga; GAS bf16_t* merged;
    __device__ __forceinline__ bool merge(f32x4 (&acc)[2][2][4][2], const Unit& u, int wr, int wc, int fr, int fq) const {
        const int br = u.aux & 3, ord = (u.aux >> 2) & 3, brn = u.aux >> 4;
        const GAS unsigned char* sg = sga + (size_t)br * (64 * MiB); const GAS unsigned char* sn = sga + (size_t)brn * (64 * MiB);
        const int r0 = u.pm * 256 + wr * 64 + fr, c0 = u.pn * 256 + wc * 32 + 8 * fq;
        if (ord < 2) {
#pragma unroll
            for (int ai = 0; ai < 2; ++ai) {
                u32x2 g[4][2], h[4][2];
#pragma unroll
                for (int m = 0; m < 4; ++m)
#pragma unroll
                    for (int bj = 0; bj < 2; ++bj) { const size_t off = (size_t)(r0 + ai * 128 + m * 16) * D + c0 + bj * 128; g[m][bj] = *(const GAS u32x2*)(sg + off); h[m][bj] = *(const GAS u32x2*)(sn + off); }
#pragma unroll
                for (int m = 0; m < 4; ++m)
#pragma unroll
                    for (int bj = 0; bj < 2; ++bj) { const u32x2 gg = g[m][bj], hh = h[m][bj];
#pragma unroll
                        for (int j = 0; j < 4; ++j) {
                            acc[ai][bj][m][0][j] *= ((float)((gg.x >> (8 * j)) & 0xffu) + 0.5f) * __builtin_amdgcn_rcpf((float)((hh.x >> (8 * j)) & 0xffu) + 0.5f);
                            acc[ai][bj][m][1][j] *= ((float)((gg.y >> (8 * j)) & 0xffu) + 0.5f) * __builtin_amdgcn_rcpf((float)((hh.y >> (8 * j)) & 0xffu) + 0.5f); } }
                asm volatile("" ::: "memory"); }
            return true;
        }
#pragma unroll
        for (int ai = 0; ai < 2; ++ai) {
            u32x2 g[4][2];
#pragma unroll
            for (int m = 0; m < 4; ++m)
#pragma unroll
                for (int bj = 0; bj < 2; ++bj) { const size_t off = (size_t)(r0 + ai * 128 + m * 16) * D + c0 + bj * 128; g[m][bj] = *(const GAS u32x2*)(sg + off); }
#pragma unroll
            for (int m = 0; m < 4; ++m)
#pragma unroll
                for (int bj = 0; bj < 2; ++bj) { const size_t off = (size_t)(r0 + ai * 128 + m * 16) * D + c0 + bj * 128; const u32x2 gg = g[m][bj];
                    f32x4 v0 = acc[ai][bj][m][0] * (1.0f / (256.0f * GATE_WSCALE * Y8_SCALE)), v1 = acc[ai][bj][m][1] * (1.0f / (256.0f * GATE_WSCALE * Y8_SCALE));
#pragma unroll
                    for (int j = 0; j < 4; ++j) { v0[j] *= (float)((gg.x >> (8 * j)) & 0xffu) + 0.5f; v1[j] *= (float)((gg.y >> (8 * j)) & 0xffu) + 0.5f; }
                    u32x4 w; w.x = pk2(v0[0], v0[1]); w.y = pk2(v0[2], v0[3]); w.z = pk2(v1[0], v1[1]); w.w = pk2(v1[2], v1[3]); *(GAS u32x4*)(merged + off) = w; }
            asm volatile("" ::: "memory"); }
        return false;
    }
};
struct SchedPlain {
    static constexpr bool VARLD = false, GATHER = false, DEP = false, F8 = false, I8 = false; static constexpr unsigned LDA = 4096, LDB = 4096; static constexpr int KK = 2048;
    const GAS char* A; const GAS char* B; int nM, nN, G, c;
    __device__ __forceinline__ bool next(int i, Unit& u) const {
        const int L = i * G + c; if (L >= nM * nN) return false;
        int pm, pn; pg8::static_tile(L, nM, nN, pm, pn); u.pm = pm; u.pn = pn; u.aux = 0; u.gather = nullptr; u.nvalid = 256;
        u.A = A + (size_t)pm * 256 * LDA; u.B = B + (size_t)pn * 256 * LDB; return true;
    }
};
struct EpiResid {
    static constexpr bool PERM = true, KEEP = false;
    const GAS bf16_t* xres; GAS bf16_t* out;
    __device__ __forceinline__ void operator()(const f32x4 (&acc)[2][2][4][2], const Unit& u, int wr, int wc, int fr, int fq) const {
        const int r0 = u.pm * 256 + wr * 64 + fr, c0 = u.pn * 256 + wc * 32 + 8 * fq;
#pragma unroll
        for (int ai = 0; ai < 2; ++ai) {
            u32x4 xv[4][2];
#pragma unroll
            for (int m = 0; m < 4; ++m)
#pragma unroll
                for (int bj = 0; bj < 2; ++bj) xv[m][bj] = *(const GAS u32x4*)(xres + (size_t)(r0 + ai * 128 + m * 16) * D + c0 + bj * 128);
#pragma unroll
            for (int m = 0; m < 4; ++m)
#pragma unroll
                for (int bj = 0; bj < 2; ++bj) { const size_t off = (size_t)(r0 + ai * 128 + m * 16) * D + c0 + bj * 128; const u32x4 x = xv[m][bj]; const f32x4 v0 = acc[ai][bj][m][0], v1 = acc[ai][bj][m][1];
                    u32x4 w; w.x = pk2(DN_ALPHA * bf_lo(x.x) + v0[0], DN_ALPHA * bf_hi(x.x) + v0[1]); w.y = pk2(DN_ALPHA * bf_lo(x.y) + v0[2], DN_ALPHA * bf_hi(x.y) + v0[3]);
                    w.z = pk2(DN_ALPHA * bf_lo(x.z) + v1[0], DN_ALPHA * bf_hi(x.z) + v1[1]); w.w = pk2(DN_ALPHA * bf_lo(x.w) + v1[2], DN_ALPHA * bf_hi(x.w) + v1[3]);
                    *(GAS u32x4*)(out + off) = w; }
            asm volatile("" ::: "memory"); }
    }
};
struct MoeTab { int ntiles; };
__device__ __forceinline__ void build_moe_tab(Frame& F, const GAS unsigned* cnt) {
    volatile LAS int* tab = (volatile LAS int*)(F.lds + LDS_TAB);
    if (F.tid == 0) { int rt = 0;
        for (int e = 0; e < NEXP; ++e) { const int c = (int)cnt[64 * e]; tab[576 + e] = c; const int nt = (c + 255) >> 8; for (int j = 0; j < nt && rt < 192; ++j) { tab[64 + rt] = e; tab[320 + rt] = 256 * j; ++rt; } }
        tab[0] = rt; }
    __syncthreads();
}
struct SchedMoe1 {
    static constexpr bool VARLD = false, GATHER = true, DEP = false, F8 = false, I8 = false; static constexpr unsigned LDA = 4096, LDB = 4096; static constexpr int KK = 2048;
    const GAS char* x1b; const GAS char* wgu; const GAS int* list; LAS int* tab; int G, c;
    __device__ __forceinline__ bool next(int i, Unit& u) const {
        const int L = i * G + c; const int RT = __builtin_amdgcn_readfirstlane(tab[0]); if (L >= RT * 4) return false;
        const int rt = L >> 2, pn = L & 3; const int e = __builtin_amdgcn_readfirstlane(tab[64 + rt]), r0 = __builtin_amdgcn_readfirstlane(tab[320 + rt]), cnt = __builtin_amdgcn_readfirstlane(tab[576 + e]);
        u.pm = rt; u.pn = pn; u.aux = e; u.A = x1b; u.B = wgu + ((size_t)e * 1024 + (size_t)pn * 256) * 4096;
        u.gather = list + (size_t)e * T + r0; u.nvalid = (cnt - r0) < 256 ? (cnt - r0) : 256; return true;
    }
};
struct EpiSwiglu {
    static constexpr bool PERM = true, KEEP = false;
    GAS bf16_t* hbuf; GAS unsigned* flag;
    __device__ __forceinline__ void operator()(const f32x4 (&acc)[2][2][4][2], const Unit& u, int wr, int wc, int fr, int fq) const {
        const int r0 = u.pm * 256 + wr * 64 + fr, c0 = u.pn * 128 + wc * 32 + 8 * fq;
#pragma unroll
        for (int ai = 0; ai < 2; ++ai)
#pragma unroll
            for (int m = 0; m < 4; ++m) { const f32x4 g0 = acc[ai][0][m][0], g1 = acc[ai][0][m][1], u0 = acc[ai][1][m][0], u1 = acc[ai][1][m][1]; float h[8];
#pragma unroll
                for (int j = 0; j < 4; ++j) { h[j] = g0[j] * sigmoidf_(g0[j]) * u0[j]; h[4 + j] = g1[j] * sigmoidf_(g1[j]) * u1[j]; }
                unsigned lo_ = 0, hi_ = 0; lo_ = __builtin_amdgcn_cvt_pk_fp8_f32(f8c(h[0]), f8c(h[1]), lo_, false); lo_ = __builtin_amdgcn_cvt_pk_fp8_f32(f8c(h[2]), f8c(h[3]), lo_, true); hi_ = __builtin_amdgcn_cvt_pk_fp8_f32(f8c(h[4]), f8c(h[5]), hi_, false); hi_ = __builtin_amdgcn_cvt_pk_fp8_f32(f8c(h[6]), f8c(h[7]), hi_, true);
                { GAS unsigned long long* hp_ = (GAS unsigned long long*)((GAS unsigned char*)hbuf + (size_t)(r0 + ai * 128 + m * 16) * EFF + c0);
                  __hip_atomic_store(hp_, ((unsigned long long)hi_ << 32) | lo_, __ATOMIC_RELAXED, __HIP_MEMORY_SCOPE_AGENT); } }
        asm volatile("s_waitcnt vmcnt(0)" ::: "memory");
        if ((threadIdx.x & 63) == 0) (void)xb_add(flag + 16 * u.pm, 1u);
    }
};
constexpr int MOE_ADV = 4;
struct SchedMoe2 {
    static constexpr bool VARLD = false, GATHER = false, DEP = true, F8 = true, I8 = false; static constexpr unsigned LDA = 512, LDB = 512; static constexpr int KK = 256;
    const GAS char* hbuf; const GAS char* wdn; const GAS int* list; LAS int* tab; int G, c; GAS unsigned* flag;
    __device__ __forceinline__ bool next(int i, Unit& u) const {
        const int RT = __builtin_amdgcn_readfirstlane(tab[0]); const int n6 = RT * 4, n7 = RT * 8, h = n6 % G, nlow = G - h;
        int L;
        if (h == 0) L = i * G + c;
        else if (c >= h) L = (i < MOE_ADV) ? i * nlow + (c - h) : MOE_ADV * nlow + (i - MOE_ADV) * G + c;
        else L = MOE_ADV * nlow + i * G + c;
        if (L >= n7) return false;
        const int rt = L >> 3, pn = L & 7; const int e = __builtin_amdgcn_readfirstlane(tab[64 + rt]), r0 = __builtin_amdgcn_readfirstlane(tab[320 + rt]), cnt = __builtin_amdgcn_readfirstlane(tab[576 + e]);
        u.pm = rt; u.pn = pn; u.aux = e; u.A = hbuf + (size_t)rt * 256 * 512; u.B = wdn + ((size_t)e * 2048 + (size_t)pn * 256) * 512;
        u.gather = list + (size_t)e * T + r0; u.nvalid = (cnt - r0) < 256 ? (cnt - r0) : 256; return true;
    }
    __device__ __forceinline__ void acquire(const Unit& u) const {
        GAS unsigned* f = flag + 16 * u.pm; unsigned sp = 0;
        while (xb_ld(f) < 32u) { __builtin_amdgcn_s_sleep(8); if (++sp > (1u << 21)) break; }
        asm volatile("" ::: "memory");
    }
};
struct EpiScatter {
    static constexpr bool PERM = true, KEEP = false;
    GAS bf16_t* yasg;
    __device__ __forceinline__ void operator()(const f32x4 (&acc)[2][2][4][2], const Unit& u, int wr, int wc, int fr, int fq) const {
        const int c0 = u.pn * 256 + wc * 32 + 8 * fq;
        int asgs[2][4];
#pragma unroll
        for (int ai = 0; ai < 2; ++ai)
#pragma unroll
            for (int m = 0; m < 4; ++m) { const int r = ai * 128 + wr * 64 + m * 16 + fr; asgs[ai][m] = (r < u.nvalid) ? u.gather[r] : 0; }
#pragma unroll
        for (int ai = 0; ai < 2; ++ai)
#pragma unroll
            for (int m = 0; m < 4; ++m) { const int r = ai * 128 + wr * 64 + m * 16 + fr;
                if (r < u.nvalid) { const int asg = asgs[ai][m]; GAS bf16_t* rowp = yasg + (size_t)asg * D + c0;
#pragma unroll
                    for (int bj = 0; bj < 2; ++bj) { const f32x4 v0 = acc[ai][bj][m][0] * (1.0f / GATE_WSCALE), v1 = acc[ai][bj][m][1] * (1.0f / GATE_WSCALE);
                        u32x4 w; w.x = pk2(v0[0], v0[1]); w.y = pk2(v0[2], v0[3]); w.z = pk2(v1[0], v1[1]); w.w = pk2(v1[2], v1[3]); *(GAS u32x4*)(rowp + bj * 128) = w; } } }
    }
};

struct FlashArgs {
    const GAS bf16_t* Q; int ldq; size_t qrow0; int qcol;
    const GAS bf16_t* K; int ldk; size_t krow0; int kcol;
    const GAS bf16_t* VT; size_t ldvt; size_t vrow0; size_t vcol0;
    GAS bf16_t* O; int ldo; int ocol;
    int qblk;
    GAS float* stat; float lg2g;
};
constexpr int FL_KBUF = 0, FL_VBUF = 65536, FL_PART = 98304, FL_KMEAN = 114688;
template <int MODE, int DK, int FABL = 0>
__device__ __forceinline__ void flash_unit(LAS unsigned char* lds, const FlashArgs& a, int tid) {
    asm volatile("" : "+v"(tid));
    const int lane = tid & 63, w = __builtin_amdgcn_readfirstlane(tid >> 6), l31 = lane & 31, h = lane >> 5;
    constexpr int CPR = DK / 8, NKL = (64 * CPR) / 512, KS = DK / 16, KROWB = DK * 2;
    constexpr int NDT = 4;
    const int nt = (MODE == 1) ? 4 : 4 * (a.qblk + 1);
    bf16x8 qf[KS];
    { const GAS bf16_t* qp = a.Q + (a.qrow0 + (size_t)(32 * w + l31)) * a.ldq + a.qcol + 8 * h;
#pragma unroll
      for (int ks = 0; ks < KS; ++ks) qf[ks] = *(const GAS bf16x8*)(qp + 16 * ks); }
    unsigned selmask = 0;
    if (MODE == 0) {
        const int qb = a.qblk;
        if (qb <= 3) selmask = (1u << qb) - 1u;
        else {
            const LAS float* km = (const LAS float*)(lds + FL_KMEAN);
            f32x16 g; for (int i = 0; i < 16; ++i) g[i] = 0.f;
            const int n = l31 & 7; const bool nv = l31 < 8;
#pragma unroll
            for (int ks = 0; ks < KS; ++ks) { const f32x4 x0 = *(const LAS f32x4*)(km + n * 128 + 16 * ks + 8 * h), x1 = *(const LAS f32x4*)(km + n * 128 + 16 * ks + 8 * h + 4);
                float xv[8] = {x0[0], x0[1], x0[2], x0[3], x1[0], x1[1], x1[2], x1[3]}; unsigned hi[4], lo[4];
#pragma unroll
                for (int j = 0; j < 4; ++j) { const float a0 = nv ? xv[2 * j] : 0.f, a1 = nv ? xv[2 * j + 1] : 0.f; hi[j] = pk2(a0, a1); lo[j] = pk2(a0 - bf_lo(hi[j]), a1 - bf_hi(hi[j])); }
                const bf16x8 ah = __builtin_bit_cast(bf16x8, (u32x4){hi[0], hi[1], hi[2], hi[3]}), al = __builtin_bit_cast(bf16x8, (u32x4){lo[0], lo[1], lo[2], lo[3]});
                g = __builtin_amdgcn_mfma_f32_32x32x16_bf16(ah, qf[ks], g, 0, 0, 0); g = __builtin_amdgcn_mfma_f32_32x32x16_bf16(al, qf[ks], g, 0, 0, 0); }
            float gt[8];
#pragma unroll
            for (int r = 0; r < 4; ++r) { const float mine = g[r], other = __shfl_xor(mine, 32); gt[r] = h ? other : mine; gt[4 + r] = h ? mine : other; }
#pragma unroll
            for (int rep = 0; rep < 3; ++rep) { float best = -3.0e38f; int bi = 0;
#pragma unroll
                for (int nn = 0; nn < 7; ++nn) { const bool ok = (nn < qb) && !((selmask >> nn) & 1u) && (gt[nn] > best); best = ok ? gt[nn] : best; bi = ok ? nn : bi; }
                selmask |= 1u << bi; }
        }
    }
    constexpr int RPP = 1024 / KROWB;
    const int k_rip = (lane * 16) / KROWB, k_cp = ((lane * 16) % KROWB) / 16;
    const int v_rip = lane >> 3, v_cp = lane & 7;
#define FL_TILE_KB(t) ((MODE == 0) ? ((t) < 4 ? 256 * a.qblk + 64 * (t) : 256 * (((t) - 4) >> 2) + 64 * (((t) - 4) & 3)) : 64 * (t))
#define FL_ISSUE(t, buf) do { const int kb_ = FL_TILE_KB(t); \
        _Pragma("unroll") for (int i = 0; i < NKL; ++i) { const int pidx = w + 8 * i, row = pidx * RPP + k_rip, c = k_cp ^ (row & 15); \
            __builtin_amdgcn_global_load_lds((const GAS unsigned*)(a.K + (a.krow0 + kb_ + row) * a.ldk + a.kcol + 8 * c), (LAS unsigned*)(lds + FL_KBUF + (buf) * 32768 + pidx * 1024), 16, 0, 0); } \
        _Pragma("unroll") for (int i = 0; i < 2; ++i) { const int pidx = w + 8 * i, row = pidx * 8 + v_rip, c = v_cp ^ ((row >> 1) & 7); \
            __builtin_amdgcn_global_load_lds((const GAS unsigned*)(a.VT + (a.vrow0 + row) * a.ldvt + a.vcol0 + kb_ + 8 * c), (LAS unsigned*)(lds + FL_VBUF + (buf) * 16384 + pidx * 1024), 16, 0, 0); } } while (0)
    f32x16 o[4];
#pragma unroll
    for (int dt = 0; dt < 4; ++dt)
#pragma unroll
        for (int i = 0; i < 16; ++i) o[dt][i] = 0.f;
    float mrun = -1.0e30f, lsum = 0.f;
    const int qloc = 32 * w + l31;
    int kbase[8], vbase[8], vb4[4];
    { const int x = l31 & 15, xs = (l31 >> 1) & 7;
#pragma unroll
      for (int kl = 0; kl < 8; ++kl) kbase[kl] = l31 * KROWB + (((2 * kl + h) ^ x) * 16);
#pragma unroll
      for (int cc = 0; cc < 8; ++cc) vbase[cc] = l31 * 128 + ((cc ^ xs) * 16) + 8 * h;
#pragma unroll
      for (int st = 0; st < 4; ++st) vb4[st] = l31 * 128 + (((2 * st + h) ^ xs) * 16); }
    FL_ISSUE(0, 0); VM_WAIT(); __syncthreads();
    for (int t = 0; t < nt; ++t) {
        if (t + 1 < nt && FABL != 4) FL_ISSUE(t + 1, (t + 1) & 1);
        bool need = true; int kind = 0; const int tt = t & 3; float tscale = 1.f; int blk = 0;
        if (MODE == 0) { if (t < 4) { kind = 1; need = (64 * tt <= 32 * w + 31); } else { kind = 2; blk = (t - 4) >> 2; need = __any((int)((selmask >> blk) & 1u)) != 0; } }
        if (MODE == 2) { const int J = t >> 2; if (J == a.qblk) { kind = 1; need = (64 * tt <= 32 * w + 31); } tscale = fast_exp2(a.lg2g * 256.0f * (float)(a.qblk - J)); }
        if (need) {
            const LAS unsigned char* kb = lds + FL_KBUF + (t & 1) * 32768; const LAS unsigned char* vb = lds + FL_VBUF + (t & 1) * 16384;
#define FL_KRD(k2, ks) (*(const LAS bf16x8*)(kb + kbase[(ks) & 7] + (32 * (k2)) * KROWB + ((ks) >> 3) * 256))
#define FL_QK(sv, k2) do { _Pragma("unroll") for (int i = 0; i < 16; ++i) sv[i] = 0.f; \
                bf16x8 f0 = FL_KRD(k2, 0), f1 = FL_KRD(k2, 1), f2 = FL_KRD(k2, 2), f3 = FL_KRD(k2, 3); \
                _Pragma("unroll") for (int ks = 0; ks < KS; ks += 4) { \
                    sv = __builtin_amdgcn_mfma_f32_32x32x16_bf16(f0, qf[ks], sv, 0, 0, 0);     if (ks + 4 < KS) f0 = FL_KRD(k2, ks + 4); \
                    sv = __builtin_amdgcn_mfma_f32_32x32x16_bf16(f1, qf[ks + 1], sv, 0, 0, 0); if (ks + 5 < KS) f1 = FL_KRD(k2, ks + 5); \
                    sv = __builtin_amdgcn_mfma_f32_32x32x16_bf16(f2, qf[ks + 2], sv, 0, 0, 0); if (ks + 6 < KS) f2 = FL_KRD(k2, ks + 6); \
                    sv = __builtin_amdgcn_mfma_f32_32x32x16_bf16(f3, qf[ks + 3], sv, 0, 0, 0); if (ks + 7 < KS) f3 = FL_KRD(k2, ks + 7); } } while (0)
#define FL_VRD(st, dt) (MODE != 2) ? (*(const LAS bf16x8*)(vb + vb4[st] + (dt) * 4096)) : ({ const u32x2 lo_ = *(const LAS u32x2*)(vb + vbase[2 * (st)] + (dt) * 4096), hi_ = *(const LAS u32x2*)(vb + vbase[2 * (st) + 1] + (dt) * 4096); __builtin_bit_cast(bf16x8, (u32x4){lo_.x, lo_.y, hi_.x, hi_.y}); })
#define FL_PACK(sv, sx) ({ u32x4 pw_; pw_.x = pk2(sv[8 * (sx) + 0], sv[8 * (sx) + 1]); pw_.y = pk2(sv[8 * (sx) + 2], sv[8 * (sx) + 3]); pw_.z = pk2(sv[8 * (sx) + 4], sv[8 * (sx) + 5]); pw_.w = pk2(sv[8 * (sx) + 6], sv[8 * (sx) + 7]); __builtin_bit_cast(bf16x8, pw_); })
#define FL_PV(sa, sb, st0, NST) do { bf16x8 va[NDT]; _Pragma("unroll") for (int dt = 0; dt < NDT; ++dt) va[dt] = FL_VRD(st0, dt); \
                _Pragma("unroll") for (int q_ = 0; q_ < (NST); ++q_) { const int st = (st0) + q_; const bf16x8 pb = (q_ < 2) ? FL_PACK(sa, q_ & 1) : FL_PACK(sb, q_ & 1); \
                    _Pragma("unroll") for (int dt = 0; dt < NDT; ++dt) { o[dt] = __builtin_amdgcn_mfma_f32_32x32x16_bf16(va[dt], pb, o[dt], 0, 0, 0); if (q_ + 1 < (NST)) va[dt] = FL_VRD(st + 1, dt); } } } while (0)
            if (MODE == 2) {
#pragma unroll
                for (int k2 = 0; k2 < 2; ++k2) { f32x16 sv; FL_QK(sv, k2);
                    const int thr = (kind == 1) ? (qloc - 64 * tt - 32 * k2 - 4 * h) : 1000;
#pragma unroll
                    for (int r = 0; r < 16; ++r) { const int fr_ = (r & 3) + 8 * (r >> 2); const float v = sv[r] * tscale; sv[r] = (fr_ > thr) ? 0.f : v; }
                    FL_PV(sv, sv, 2 * k2, 2); }
            } else {
                f32x16 s0, s1; if (FABL == 1) { for (int i = 0; i < 16; ++i) { s0[i] = 0.f; s1[i] = 0.f; } } else { FL_QK(s0, 0); FL_QK(s1, 1); }
                bool rowsel = true;
                if (MODE == 0) {
                    if (kind == 1) {
                        const int thr = qloc - 64 * tt - 4 * h;
#pragma unroll
                        for (int r = 0; r < 16; ++r) { const int fr_ = (r & 3) + 8 * (r >> 2); s0[r] = (fr_ <= thr) ? s0[r] : -1.0e30f; s1[r] = (fr_ + 32 <= thr) ? s1[r] : -1.0e30f; }
                    } else rowsel = ((selmask >> blk) & 1u) != 0u;
                }
                if (FABL != 3) {
                float mx = fmaxf(s0[0], s1[0]);
#pragma unroll
                for (int r = 1; r < 16; ++r) mx = fmaxf(mx, fmaxf(s0[r], s1[r]));
                mx = rowsel ? mx : -1.0e30f;
                mx = fmaxf(mx, __shfl_xor(mx, 32));
                if (!__all((int)(mx <= mrun + 8.0f))) {
                    const float mnew = fmaxf(mrun, mx), alpha = fast_exp2(mrun - mnew); mrun = mnew; lsum *= alpha;
#pragma unroll
                    for (int dt = 0; dt < NDT; ++dt) o[dt] = o[dt] * alpha;
                }
                float ps = 0.f;
                const float msub = rowsel ? mrun : 3.0e38f;
#pragma unroll
                for (int r = 0; r < 16; ++r) { const float p0 = fast_exp2(s0[r] - msub), p1 = fast_exp2(s1[r] - msub); s0[r] = p0; s1[r] = p1; ps += p0 + p1; }
                lsum += ps;
                }
                if (FABL != 2) FL_PV(s0, s1, 0, 4);
            }
#undef FL_KRD
#undef FL_QK
#undef FL_VRD
#undef FL_PACK
#undef FL_PV
        }
        VM_WAIT();
        __syncthreads();
    }
#undef FL_ISSUE
#undef FL_TILE_KB
    if (FABL != 0) { _Pragma("unroll") for (int dt = 0; dt < NDT; ++dt) asm volatile("" :: "v"(o[dt])); asm volatile("" :: "v"(lsum), "v"(mrun)); return; }
    const size_t grow = a.qrow0 + (size_t)qloc;
    if (MODE != 2) {
        const float ltot = lsum + __shfl_xor(lsum, 32), inv = 1.0f / ltot;
        GAS unsigned char* op = (GAS unsigned char*)a.O + grow * a.ldo + a.ocol + 4 * h; const float i8_ = inv * Y8_SCALE;
#pragma unroll
        for (int dt = 0; dt < 4; ++dt)
#pragma unroll
            for (int g4 = 0; g4 < 4; ++g4) { unsigned w8 = 0; w8 = __builtin_amdgcn_cvt_pk_fp8_f32(f8c(o[dt][4 * g4] * i8_), f8c(o[dt][4 * g4 + 1] * i8_), w8, false); w8 = __builtin_amdgcn_cvt_pk_fp8_f32(f8c(o[dt][4 * g4 + 2] * i8_), f8c(o[dt][4 * g4 + 3] * i8_), w8, true); *(GAS unsigned*)(op + 32 * dt + 8 * g4) = w8; }
    } else {
        float sm = 0.f, sq = 0.f;
        GAS bf16_t* op = a.O + grow * a.ldo + a.ocol + 4 * h;
#pragma unroll
        for (int dt = 0; dt < 4; ++dt)
#pragma unroll
            for (int g4 = 0; g4 < 4; ++g4) {
#pragma unroll
                for (int j = 0; j < 4; ++j) { const float v = o[dt][4 * g4 + j]; sm += v; sq += v * v; }
                u32x2 wv; wv.x = pk2(o[dt][4 * g4], o[dt][4 * g4 + 1]); wv.y = pk2(o[dt][4 * g4 + 2], o[dt][4 * g4 + 3]); *(GAS u32x2*)(op + 32 * dt + 8 * g4) = wv; }
        sm += __shfl_xor(sm, 32); sq += __shfl_xor(sq, 32);
        if (h == 0) { f32x2 st = {sm, sq}; *(GAS f32x2*)(a.stat + grow * 32) = st; }
    }
}
__device__ __forceinline__ void moba_kmean(LAS unsigned char* lds, const GAS bf16_t* K, size_t krow0, int kcol, int nb, int tid) {
    LAS float* part = (LAS float*)(lds + FL_PART); LAS float* km = (LAS float*)(lds + FL_KMEAN);
    const int c = tid & 15, rg = tid >> 4;
    for (int n = 0; n < nb; ++n) {
        float acc[8] = {0, 0, 0, 0, 0, 0, 0, 0};
#pragma unroll
        for (int i = 0; i < 8; ++i) { const u32x4 v = *(const GAS u32x4*)(K + (krow0 + 256 * n + rg + 32 * i) * 1024 + kcol + 8 * c);
            acc[0] += bf_lo(v.x); acc[1] += bf_hi(v.x); acc[2] += bf_lo(v.y); acc[3] += bf_hi(v.y); acc[4] += bf_lo(v.z); acc[5] += bf_hi(v.z); acc[6] += bf_lo(v.w); acc[7] += bf_hi(v.w); }
#pragma unroll
        for (int j = 0; j < 8; ++j) part[rg * 128 + 8 * c + j] = acc[j];
        __syncthreads();
        if (tid < 128) { float s = 0.f;
#pragma unroll 8
            for (int r = 0; r < 32; ++r) s += part[r * 128 + tid]; km[n * 128 + tid] = s * (1.0f / 256.0f); }
        __syncthreads();
    }
}
constexpr int RT_KBUF = 0, RT_VSLAB = 65536, RT_PBUF = 131072, RT_STAT = 0;
template <int ABL> __device__ __forceinline__ void retention_unit(LAS unsigned char* lds, GAS unsigned char* ws, int b, int hh, int qc, int tid) {
    asm volatile("" : "+v"(tid));
    const int lane = tid & 63, w = __builtin_amdgcn_readfirstlane(tid >> 6), l15 = lane & 15, kg = lane >> 4, l31 = lane & 31, h = lane >> 5;
    const int nt = 2 * (qc + 1);
    const GAS bf16_t* Q = (const GAS bf16_t*)(ws + WS_RQ); const GAS bf16_t* K = (const GAS bf16_t*)(ws + WS_RK); const GAS bf16_t* VT = (const GAS bf16_t*)(ws + WS_RVT);
    const size_t trow0 = (size_t)b * SEQ + 128 * qc;
    const float lg2g = log2f(1.0f - exp2f(-5.0f - (float)hh));
    const int k_row = lane >> 5, k_cp = lane & 31;
#define RT_ISSUE_K(t, buf) do { \
        _Pragma("unroll") for (int i = 0; i < 4; ++i) { const int pidx = w + 8 * i, row = 2 * pidx + k_row, c = k_cp ^ (row & 15); \
            __builtin_amdgcn_global_load_lds((const GAS unsigned*)(K + ((size_t)b * SEQ + 64 * (t) + row) * 1024 + hh * 256 + 8 * c), (LAS unsigned*)(lds + RT_KBUF + (buf) * 32768 + pidx * 1024), 16, 0, 0); } } while (0)
    const int v_row = lane >> 3, v_cp = lane & 7;
    const GAS bf16_t* vsrc = VT + ((size_t)b * 2048 + hh * 512 + 64 * w) * SEQ;
#define RT_ISSUE_V(t) do { \
        _Pragma("unroll") for (int i = 0; i < 8; ++i) { const int row = 8 * i + v_row, c = v_cp ^ ((row >> 1) & 7); \
            __builtin_amdgcn_global_load_lds((const GAS unsigned*)(vsrc + (size_t)row * SEQ + 64 * (t) + 8 * c), (LAS unsigned*)(lds + RT_VSLAB + w * 8192 + (8 * i) * 128), 16, 0, 0); } } while (0)
    RT_ISSUE_K(0, 0); RT_ISSUE_V(0); RT_ISSUE_K(1, 1);
    bf16x8 qf[8];
    { const GAS bf16_t* qp = Q + (trow0 + 16 * w + l15) * 1024 + hh * 256 + 8 * kg;
#pragma unroll
      for (int ks = 0; ks < 8; ++ks) qf[ks] = *(const GAS bf16x8*)(qp + 32 * ks); }
    f32x16 o[2][4];
#pragma unroll
    for (int a = 0; a < 2; ++a)
#pragma unroll
        for (int c = 0; c < 4; ++c)
#pragma unroll
            for (int i = 0; i < 16; ++i) o[a][c][i] = 0.f;
    const int kbaseS = l15 * 512;
    const int pw_q = 16 * w + l15;
    const int pw_off = pw_q * 128, pw_x = (pw_q >> 1) & 7;
    const int pr_x = (l31 >> 1) & 7;
    const LAS unsigned char* vslab = lds + RT_VSLAB + w * 8192;
    LAS unsigned char* pbuf = lds + RT_PBUF;
    asm volatile("s_waitcnt vmcnt(0)" ::: "memory"); __builtin_amdgcn_s_barrier(); asm volatile("" ::: "memory");
    for (int t = 0; t < nt; ++t) {
        const bool diag = (t >= 2 * qc);
        const int koff = 64 * (t - 2 * qc);
        const LAS unsigned char* kb = lds + RT_KBUF + (t & 1) * 32768;
        const float tsc = fast_exp2(lg2g * 256.0f * (float)((qc >> 1) - (t >> 2)));
        f32x4 sa[4];
#pragma unroll
        for (int kt = 0; kt < 4; ++kt) sa[kt] = (f32x4){0.f, 0.f, 0.f, 0.f};
        if (ABL != 1) {
#define RT_KF(i) (*(const LAS bf16x8*)(kb + kbaseS + ((i) >> 3) * 16 * 512 + (((4 * ((i) & 7) + kg) ^ l15) * 16)))
            bf16x8 kf[4];
#pragma unroll
            for (int i = 0; i < 4; ++i) kf[i] = RT_KF(i);
#pragma unroll
            for (int i = 0; i < 32; ++i) { sa[i >> 3] = __builtin_amdgcn_mfma_f32_16x16x32_bf16(kf[i & 3], qf[i & 7], sa[i >> 3], 0, 0, 0); if (i + 4 < 32) kf[i & 3] = RT_KF(i + 4); }
#undef RT_KF
        }
        asm volatile("s_waitcnt lgkmcnt(0)" ::: "memory"); __builtin_amdgcn_s_barrier(); asm volatile("" ::: "memory");
#pragma unroll
        for (int kt = 0; kt < 4; ++kt) { const int key0 = 16 * kt + 4 * kg;
            float v[4];
#pragma unroll
            for (int r = 0; r < 4; ++r) { v[r] = sa[kt][r] * tsc; if (diag && (koff + key0 + r > pw_q)) v[r] = 0.f; }
            const int c8 = key0 >> 2, c16 = c8 >> 1, half = c8 & 1;
            u32x2 pk; pk.x = pk2(v[0], v[1]); pk.y = pk2(v[2], v[3]);
            *(LAS u32x2*)(pbuf + pw_off + ((c16 ^ pw_x) * 16) + half * 8) = pk; }
        asm volatile("s_waitcnt vmcnt(0) lgkmcnt(0)" ::: "memory"); __builtin_amdgcn_s_barrier(); asm volatile("" ::: "memory");
        if (t + 2 < nt && ABL != 4) RT_ISSUE_K(t + 2, t & 1);
#pragma unroll
        for (int sx = 0; sx < 4; ++sx) { if (ABL == 2) continue;
            bf16x8 pb[4];
#pragma unroll
            for (int qt2 = 0; qt2 < 4; ++qt2) pb[qt2] = *(const LAS bf16x8*)(pbuf + (32 * qt2 + l31) * 128 + (((2 * sx + h) ^ pr_x) * 16));
#pragma unroll
            for (int dvt = 0; dvt < 2; ++dvt) { const bf16x8 va = *(const LAS bf16x8*)(vslab + (32 * dvt + l31) * 128 + (((2 * sx + h) ^ pr_x) * 16));
#pragma unroll
                for (int qt2 = 0; qt2 < 4; ++qt2) o[dvt][qt2] = __builtin_amdgcn_mfma_f32_32x32x16_bf16(va, pb[qt2], o[dvt][qt2], 0, 0, 0); } }
        asm volatile("s_waitcnt lgkmcnt(0)" ::: "memory");
        __builtin_amdgcn_sched_barrier(0);
        if (t + 1 < nt && ABL != 3) RT_ISSUE_V(t + 1);
    }
#undef RT_ISSUE_K
#undef RT_ISSUE_V
    if (ABL != 0) { _Pragma("unroll") for (int a = 0; a < 2; ++a) _Pragma("unroll") for (int c = 0; c < 4; ++c) asm volatile("" :: "v"(o[a][c])); __syncthreads(); return; }
    __syncthreads();
    LAS float* st = (LAS float*)(lds + RT_STAT);
#pragma unroll
    for (int qt2 = 0; qt2 < 4; ++qt2) { float sm = 0.f, sq = 0.f;
#pragma unroll
        for (int dvt = 0; dvt < 2; ++dvt)
#pragma unroll
            for (int r = 0; r < 16; ++r) { const float v = o[dvt][qt2][r]; sm += v; sq += v * v; }
        sm += __shfl_xor(sm, 32); sq += __shfl_xor(sq, 32);
        if (h == 0) { st[(w * 128 + 32 * qt2 + l31) * 2] = sm; st[(w * 128 + 32 * qt2 + l31) * 2 + 1] = sq; } }
    __syncthreads();
    const GAS bf16_t* rgs = (const GAS bf16_t*)(ws + WS_RGS); GAS bf16_t* yr = (GAS bf16_t*)(ws + WS_YR);
#pragma unroll
    for (int qt2 = 0; qt2 < 4; ++qt2) { const int q = 32 * qt2 + l31; float sm = 0.f, sq = 0.f;
#pragma unroll
        for (int ww = 0; ww < 8; ++ww) { sm += st[(ww * 128 + q) * 2]; sq += st[(ww * 128 + q) * 2 + 1]; }
        const float mean = sm * (1.0f / 512.0f), var = fmaxf(sq * (1.0f / 512.0f) - mean * mean, 0.f), rstd = 1.0f / sqrtf(var + GN_EPS);
        const size_t off = (trow0 + q) * 2048 + hh * 512 + 64 * w + 4 * h;
#pragma unroll
        for (int dvt = 0; dvt < 2; ++dvt)
#pragma unroll
            for (int g4 = 0; g4 < 4; ++g4) { const u32x2 gv = *(const GAS u32x2*)(rgs + off + 32 * dvt + 8 * g4);
                const float rs8 = rstd * Y8_SCALE; unsigned w8 = 0;
                w8 = __builtin_amdgcn_cvt_pk_fp8_f32(f8c(bf_lo(gv.x) * (o[dvt][qt2][4 * g4] - mean) * rs8), f8c(bf_hi(gv.x) * (o[dvt][qt2][4 * g4 + 1] - mean) * rs8), w8, false);
                w8 = __builtin_amdgcn_cvt_pk_fp8_f32(f8c(bf_lo(gv.y) * (o[dvt][qt2][4 * g4 + 2] - mean) * rs8), f8c(bf_hi(gv.y) * (o[dvt][qt2][4 * g4 + 3] - mean) * rs8), w8, true);
                *(GAS unsigned*)((GAS unsigned char*)yr + off + 32 * dvt + 8 * g4) = w8; } }
    __syncthreads();
}
__device__ __forceinline__ void phase_mixers(Frame& F) {
    GAS unsigned char* ws = KWS(); const int c = F.vcu; LAS unsigned char* lds = F.lds; int tid = F.tid; asm volatile("" : "+v"(tid));
#ifndef DUP_MASK
#define DUP_MASK 0
#endif
#define NREPM(k) ((((DUP_MASK) >> (k)) & 1) ? 2 : 1)
    for (int rp_ = 0; rp_ < NREPM(10); ++rp_) { const int bh = c >> 2, pi = c & 3, b = bh >> 3, hh = bh & 7;
      const int qb_hi = 7 - pi;
      moba_kmean(lds, (const GAS bf16_t*)(ws + WS_AK), (size_t)b * SEQ, hh * 128, qb_hi, tid);
      for (int rep = 0; rep < 2; ++rep) { const int qb = rep ? pi : qb_hi;
          FlashArgs a; a.Q = (const GAS bf16_t*)(ws + WS_AQ); a.ldq = 1024; a.qrow0 = (size_t)b * SEQ + 256 * qb; a.qcol = hh * 128;
          a.K = (const GAS bf16_t*)(ws + WS_AK); a.ldk = 1024; a.krow0 = (size_t)b * SEQ; a.kcol = hh * 128;
          a.VT = (const GAS bf16_t*)(ws + WS_AVT); a.ldvt = SEQ; a.vrow0 = (size_t)b * 1024 + hh * 128; a.vcol0 = 0;
          a.O = (GAS bf16_t*)(ws + WS_YA); a.ldo = 1024; a.ocol = hh * 128; a.qblk = qb; a.stat = nullptr; a.lg2g = 0.f;
          flash_unit<0, 128>(lds, a, tid);
#ifdef FL_ABL
          flash_unit<0, 128, FL_ABL>(lds, a, tid); flash_unit<0, 128>(lds, a, tid);
#endif
          } }
    for (int j = 0; j < 2 * NREPM(11); ++j) { const int bh = c >> 3, pi = c & 7, b = bh >> 2, hh = bh & 3;
        retention_unit<0>(lds, ws, b, hh, (j & 1) ? pi : 15 - pi, tid); }
#ifdef RT_ABL
    for (int j = 0; j < 2; ++j) { const int bh = c >> 3, pi = c & 7, b = bh >> 2, hh = bh & 3; retention_unit<RT_ABL>(lds, ws, b, hh, (j & 1) ? pi : 15 - pi, tid); }
    for (int j = 0; j < 2; ++j) { const int bh = c >> 3, pi = c & 7, b = bh >> 2, hh = bh & 3; retention_unit<0>(lds, ws, b, hh, (j & 1) ? pi : 15 - pi, tid); }
#endif
    for (int k = 0; k < 2 * NREPM(12); ++k) { const int m = 2 * c + (k & 1), p = m & 1, qb = (m >> 1) & 7, bh = m >> 4, b = bh >> 2, hh = bh & 3;
        FlashArgs a; a.Q = (const GAS bf16_t*)(ws + WS_MQ); a.ldq = 1024; a.qrow0 = (size_t)b * SEQ + 256 * qb; a.qcol = hh * 256;
        a.K = (const GAS bf16_t*)(ws + WS_KM); a.ldk = 1024; a.krow0 = (size_t)b * 256; a.kcol = hh * 256;
        a.VT = (const GAS bf16_t*)(ws + WS_VMT); a.ldvt = 2048; a.vrow0 = (size_t)hh * 256 + p * 128; a.vcol0 = (size_t)b * 256;
        a.O = (GAS bf16_t*)(ws + WS_YM); a.ldo = 1024; a.ocol = hh * 256 + p * 128; a.qblk = 0; a.stat = nullptr; a.lg2g = 0.f;
        flash_unit<1, 256>(lds, a, tid); }
}
__device__ __forceinline__ void phase_retnorm(Frame& F) {
    GAS unsigned char* ws = KWS(); const int gw = F.vcu * NWAVES + F.wave, NGW = F.G * NWAVES;
    const GAS bf16_t* ro = (const GAS bf16_t*)(ws + WS_RO); const GAS bf16_t* rgs = (const GAS bf16_t*)(ws + WS_RGS); const GAS float* st = (const GAS float*)(ws + WS_RSTAT); GAS bf16_t* yr = (GAS bf16_t*)(ws + WS_YR);
    for (int row = gw; row < T; row += NGW) {
#pragma unroll
        for (int hh = 0; hh < 4; ++hh) {
            const f32x4 s01 = *(const GAS f32x4*)(st + (size_t)row * 32 + hh * 8), s23 = *(const GAS f32x4*)(st + (size_t)row * 32 + hh * 8 + 4);
            const float sm = (s01[0] + s01[2]) + (s23[0] + s23[2]), sq = (s01[1] + s01[3]) + (s23[1] + s23[3]);
            const float mean = sm * (1.0f / 512.0f), var = fmaxf(sq * (1.0f / 512.0f) - mean * mean, 0.f), rstd = 1.0f / sqrtf(var + GN_EPS);
            const size_t off = (size_t)row * 2048 + hh * 512 + 8 * F.lane;
            const u32x4 ov = *(const GAS u32x4*)(ro + off), gv = *(const GAS u32x4*)(rgs + off);
            u32x4 w; w.x = pk2(bf_lo(gv.x) * (bf_lo(ov.x) - mean) * rstd, bf_hi(gv.x) * (bf_hi(ov.x) - mean) * rstd); w.y = pk2(bf_lo(gv.y) * (bf_lo(ov.y) - mean) * rstd, bf_hi(gv.y) * (bf_hi(ov.y) - mean) * rstd);
            w.z = pk2(bf_lo(gv.z) * (bf_lo(ov.z) - mean) * rstd, bf_hi(gv.z) * (bf_hi(ov.z) - mean) * rstd); w.w = pk2(bf_lo(gv.w) * (bf_lo(ov.w) - mean) * rstd, bf_hi(gv.w) * (bf_hi(ov.w) - mean) * rstd);
            *(GAS u32x4*)(yr + off) = w; }
    }
}

__device__ __forceinline__ void ln_row(f32x4 (&v)[8], const GAS float* g, const GAS float* bta, int lane) {
    float s = 0.f;
#pragma unroll
    for (int j = 0; j < 8; ++j) s += (v[j][0] + v[j][1]) + (v[j][2] + v[j][3]);
    const float mean = wave_sum(s) * (1.0f / D); float s2 = 0.f;
#pragma unroll
    for (int j = 0; j < 8; ++j) { v[j] = v[j] - mean; s2 += (v[j][0] * v[j][0] + v[j][1] * v[j][1]) + (v[j][2] * v[j][2] + v[j][3] * v[j][3]); }
    const float rstd = 1.0f / sqrtf(wave_sum(s2) * (1.0f / D) + LN_EPS);
#pragma unroll
    for (int j = 0; j < 8; ++j) { const f32x4 gg = *(const GAS f32x4*)(g + 4 * lane + 256 * j), bb = *(const GAS f32x4*)(bta + 4 * lane + 256 * j); v[j] = v[j] * rstd * gg + bb; }
}
constexpr int R2_PLD = 49, R2_PART = 0, R2_STAT = R2_PART + 8 * 64 * R2_PLD * 4, R2_LGLD = 37, R2_LG = R2_STAT + 8 * 64 * 2 * 4, R2_SEL = R2_LG + 64 * R2_LGLD * 4, R2_CNT = R2_SEL + 64 * 4 * 4;
static_assert(R2_CNT + 256 <= LDS_TAB, "LN1/router LDS map");
__device__ __forceinline__ void phase_ln1_router(Frame& F, int l, bool commit) {
    GAS unsigned char* ws = KWS(); LAS unsigned char* lds = F.lds;
    const GAS float* g1 = KIN(8) + (size_t)l * D; const GAS float* b1 = KIN(9) + (size_t)l * D;
    const GAS bf16_t* hpre = (const GAS bf16_t*)(ws + WS_HPRE); GAS bf16_t* x1b = (GAS bf16_t*)(ws + WS_X1B);
    const GAS bf16_t* wgh = (const GAS bf16_t*)(ws + WS_WRT); const GAS bf16_t* wgl = (const GAS bf16_t*)(ws + WS_WRT + WRT_GL);
    const GAS float* csp = (const GAS float*)(ws + WS_WRT + WRT_CS); const GAS float* c0p = (const GAS float*)(ws + WS_WRT + WRT_C0);
    GAS int* list = (GAS int*)(ws + WS_LIST); GAS float* tokw = (GAS float*)(ws + WS_TOKW);
    GAS unsigned* gcnt = (GAS unsigned*)(ws + WS_CTL) + CW_CNT + l * 64 * NEXP;
    LAS float* part = (LAS float*)(lds + R2_PART); LAS float* stat = (LAS float*)(lds + R2_STAT); LAS float* lgt = (LAS float*)(lds + R2_LG); LAS int* sel = (LAS int*)(lds + R2_SEL);
    LAS int* lcnt = (LAS int*)(lds + R2_CNT); LAS int* lbase = lcnt + 32;
    for (int grp = F.vcu; grp < T / 64; grp += F.G) {
        int tid = F.tid; asm volatile("" : "+v"(tid));
        const int lane = tid & 63, r = lane & 15, q = lane >> 4, w = __builtin_amdgcn_readfirstlane(tid >> 6);
        const int row0 = grp * 64;
        if (tid < 32) lcnt[tid] = 0;
        const size_t coff = (size_t)(256 * w + 8 * q);
        const GAS bf16_t* hp = hpre + (size_t)(row0 + r) * D + coff;
        const GAS bf16_t* bh = wgh + (size_t)r * D + coff; const GAS bf16_t* bl = wgl + (size_t)r * D + coff;
        u32x4 A[2][2][8];
#pragma unroll
        for (int tt = 0; tt < 2; ++tt)
#pragma unroll
            for (int ks = 0; ks < 8; ++ks) A[0][tt][ks] = *(const GAS u32x4*)(hp + (size_t)(16 * tt) * D + 32 * ks);
        __builtin_amdgcn_sched_barrier(0);
#pragma unroll
        for (int hf = 0; hf < 2; ++hf) {
            u32x4 Bc[3][2], Bn[3][2];
#pragma unroll
            for (int ct = 0; ct < 3; ++ct) { Bc[ct][0] = *(const GAS u32x4*)(bh + (size_t)16 * ct * D); Bc[ct][1] = *(const GAS u32x4*)(bl + (size_t)16 * ct * D); }
            f32x4 acc[2][3];
#pragma unroll
            for (int tt = 0; tt < 2; ++tt)
#pragma unroll
                for (int ct = 0; ct < 3; ++ct) acc[tt][ct] = (f32x4){0.f, 0.f, 0.f, 0.f};
#pragma unroll
            for (int ks = 0; ks < 8; ++ks) {
                if (ks < 7) {
#pragma unroll
                    for (int ct = 0; ct < 3; ++ct) { Bn[ct][0] = *(const GAS u32x4*)(bh + (size_t)16 * ct * D + 32 * (ks + 1)); Bn[ct][1] = *(const GAS u32x4*)(bl + (size_t)16 * ct * D + 32 * (ks + 1)); } }
#pragma unroll
                for (int tt = 0; tt < 2; ++tt)
#pragma unroll
                    for (int ct = 0; ct < 3; ++ct) {
                        acc[tt][ct] = __builtin_amdgcn_mfma_f32_16x16x32_bf16(__builtin_bit_cast(bf16x8, A[hf][tt][ks]), __builtin_bit_cast(bf16x8, Bc[ct][0]), acc[tt][ct], 0, 0, 0);
                        acc[tt][ct] = __builtin_amdgcn_mfma_f32_16x16x32_bf16(__builtin_bit_cast(bf16x8, A[hf][tt][ks]), __builtin_bit_cast(bf16x8, Bc[ct][1]), acc[tt][ct], 0, 0, 0); }
                if (ks < 7) {
#pragma unroll
                    for (int ct = 0; ct < 3; ++ct) { Bc[ct][0] = Bn[ct][0]; Bc[ct][1] = Bn[ct][1]; } }
                __builtin_amdgcn_sched_barrier(0);
            }
#pragma unroll
            for (int tt = 0; tt < 2; ++tt)
#pragma unroll
                for (int ct = 0; ct < 3; ++ct)
#pragma unroll
                    for (int i = 0; i < 4; ++i) part[(w * 64 + 32 * hf + 16 * tt + 4 * q + i) * R2_PLD + 16 * ct + r] = acc[tt][ct][i];
#pragma unroll
            for (int tt = 0; tt < 2; ++tt) { float s1 = 0.f, s2 = 0.f;
#pragma unroll
                for (int ks = 0; ks < 8; ++ks)
#pragma unroll
                    for (int e = 0; e < 4; ++e) { const u32x4 av = A[hf][tt][ks]; const unsigned u = e == 0 ? av.x : (e == 1 ? av.y : (e == 2 ? av.z : av.w)); const bf16x2_t pv = __builtin_bit_cast(bf16x2_t, u);
                        s1 = __builtin_amdgcn_fdot2_f32_bf16(pv, __builtin_bit_cast(bf16x2_t, 0x3f803f80u), s1, false); s2 = __builtin_amdgcn_fdot2_f32_bf16(pv, pv, s2, false); }
                s1 += __shfl_xor(s1, 16); s1 += __shfl_xor(s1, 32); s2 += __shfl_xor(s2, 16); s2 += __shfl_xor(s2, 32);
                if (q == 0) { stat[(w * 64 + 32 * hf + 16 * tt + r) * 2] = s1; stat[(w * 64 + 32 * hf + 16 * tt + r) * 2 + 1] = s2; } }
            __builtin_amdgcn_sched_barrier(0);
            if (hf == 0) {
#pragma unroll
                for (int tt = 0; tt < 2; ++tt)
#pragma unroll
                    for (int ks = 0; ks < 8; ++ks) A[1][tt][ks] = *(const GAS u32x4*)(hp + (size_t)(32 + 16 * tt) * D + 32 * ks); }
            __builtin_amdgcn_sched_barrier(0);
            __syncthreads();
            { float mu[2], rs[2];
#pragma unroll
              for (int tt = 0; tt < 2; ++tt) { float S1 = 0.f, S2 = 0.f;
#pragma unroll
                  for (int ww = 0; ww < 8; ++ww) { S1 += stat[(ww * 64 + 32 * hf + 16 * tt + r) * 2]; S2 += stat[(ww * 64 + 32 * hf + 16 * tt + r) * 2 + 1]; }
                  mu[tt] = S1 * (1.0f / D); rs[tt] = 1.0f / sqrtf(fmaxf(S2 * (1.0f / D) - mu[tt] * mu[tt], 0.f) + LN_EPS); }
              GAS bf16_t* xp = x1b + (size_t)(row0 + 32 * hf + r) * D + coff;
              f32x4 gc[4], gn[4];
              gc[0] = *(const GAS f32x4*)(g1 + coff); gc[1] = *(const GAS f32x4*)(g1 + coff + 4); gc[2] = *(const GAS f32x4*)(b1 + coff); gc[3] = *(const GAS f32x4*)(b1 + coff + 4);
#pragma unroll
              for (int ks = 0; ks < 8; ++ks) {
                  if (ks < 7) { gn[0] = *(const GAS f32x4*)(g1 + coff + 32 * (ks + 1)); gn[1] = *(const GAS f32x4*)(g1 + coff + 32 * (ks + 1) + 4); gn[2] = *(const GAS f32x4*)(b1 + coff + 32 * (ks + 1)); gn[3] = *(const GAS f32x4*)(b1 + coff + 32 * (ks + 1) + 4); }
#pragma unroll
                  for (int tt = 0; tt < 2; ++tt) { u32x4 h = A[hf][tt][ks]; asm volatile("" : "+v"(h)); const float m = mu[tt], sc = rs[tt]; u32x4 o;
                      o.x = pk2((bf_lo(h.x) - m) * sc * gc[0][0] + gc[2][0], (bf_hi(h.x) - m) * sc * gc[0][1] + gc[2][1]); o.y = pk2((bf_lo(h.y) - m) * sc * gc[0][2] + gc[2][2], (bf_hi(h.y) - m) * sc * gc[0][3] + gc[2][3]);
                      o.z = pk2((bf_lo(h.z) - m) * sc * gc[1][0] + gc[3][0], (bf_hi(h.z) - m) * sc * gc[1][1] + gc[3][1]); o.w = pk2((bf_lo(h.w) - m) * sc * gc[1][2] + gc[3][2], (bf_hi(h.w) - m) * sc * gc[1][3] + gc[3][3]);
                      *(GAS u32x4*)(xp + (size_t)(16 * tt) * D + 32 * ks) = o; }
                  if (ks < 7) { gc[0] = gn[0]; gc[1] = gn[1]; gc[2] = gn[2]; gc[3] = gn[3]; }
                  __builtin_amdgcn_sched_barrier(0); } }
            { const int row = 32 * hf + (tid & 31), cg = tid >> 5; float S1 = 0.f, S2 = 0.f;
#pragma unroll
              for (int ww = 0; ww < 8; ++ww) { S1 += stat[(ww * 64 + row) * 2]; S2 += stat[(ww * 64 + row) * 2 + 1]; }
              const float m = S1 * (1.0f / D), sc = 1.0f / sqrtf(fmaxf(S2 * (1.0f / D) - m * m, 0.f) + LN_EPS);
#pragma unroll
              for (int j = 0; j < 3; ++j) { const int c = cg * 3 + j;
                  if (c < 36) { float raw = 0.f;
#pragma unroll
                      for (int ww = 7; ww >= 0; --ww) raw += part[(ww * 64 + row) * R2_PLD + c];
                      lgt[row * R2_LGLD + c] = sc * (raw - m * csp[c]) + c0p[c]; } } }
        }
        __syncthreads();
        if (tid < 64) { const int rl = tid, row = row0 + rl; float lg[36];
#pragma unroll
            for (int cc = 0; cc < 36; ++cc) lg[cc] = lgt[rl * R2_LGLD + cc];
            int gs = 0; float gm = lg[0];
#pragma unroll
            for (int cc = 1; cc < 4; ++cc) if (lg[cc] > gm) { gm = lg[cc]; gs = cc; }
            float den = 0.f;
#pragma unroll
            for (int cc = 0; cc < 4; ++cc) den += __expf(lg[cc] - gm);
            const float pg = 1.0f / den;
            float ev[8];
#pragma unroll
            for (int j = 0; j < 8; ++j) ev[j] = gs == 0 ? lg[4 + j] : (gs == 1 ? lg[12 + j] : (gs == 2 ? lg[20 + j] : lg[28 + j]));
            int i0 = 0; float v0 = ev[0];
#pragma unroll
            for (int j = 1; j < 8; ++j) if (ev[j] > v0) { v0 = ev[j]; i0 = j; }
            int i1 = -1; float v1 = -3.0e38f;
#pragma unroll
            for (int j = 0; j < 8; ++j) if (j != i0 && ev[j] > v1) { v1 = ev[j]; i1 = j; }
            const float ex = __expf(v1 - v0), w0 = pg / (1.0f + ex), w1 = pg * ex / (1.0f + ex);
            const int e0 = gs * 8 + i0, e1 = gs * 8 + i1; int p0 = 0, p1 = 0;
            tokw[(size_t)row * 2] = w0; tokw[(size_t)row * 2 + 1] = w1;
            if (commit) { p0 = __hip_atomic_fetch_add(&lcnt[e0], 1, __ATOMIC_RELAXED, __HIP_MEMORY_SCOPE_WORKGROUP); p1 = __hip_atomic_fetch_add(&lcnt[e1], 1, __ATOMIC_RELAXED, __HIP_MEMORY_SCOPE_WORKGROUP); }
            sel[rl * 4] = e0; sel[rl * 4 + 1] = e1; sel[rl * 4 + 2] = p0; sel[rl * 4 + 3] = p1; }
        __syncthreads();
        if (tid < 32 && commit) lbase[tid] = (int)__hip_atomic_fetch_add(gcnt + 64 * tid, (unsigned)lcnt[tid], __ATOMIC_RELAXED, __HIP_MEMORY_SCOPE_AGENT);
        __syncthreads();
        if (tid < 64 && commit) { const int row = row0 + tid; const int e0 = sel[tid * 4], e1 = sel[tid * 4 + 1], p0 = sel[tid * 4 + 2], p1 = sel[tid * 4 + 3];
            list[(size_t)e0 * T + lbase[e0] + p0] = row * 2; list[(size_t)e1 * T + lbase[e1] + p1] = row * 2 + 1; }
        __syncthreads();
    }
}
__device__ __forceinline__ void phase_ln2(Frame& F, int l) {
    GAS unsigned char* ws = KWS(); const int gw = F.vcu * NWAVES + F.wave, NGW = F.G * NWAVES;
    const GAS float* g2 = KIN(16) + (size_t)l * D; const GAS float* b2 = KIN(17) + (size_t)l * D;
    const GAS bf16_t* x1 = (const GAS bf16_t*)(ws + WS_X1B); const GAS bf16_t* yasg = (const GAS bf16_t*)(ws + WS_YASG); const GAS float* tokw = (const GAS float*)(ws + WS_TOKW);
    GAS float* outf = KOUT(); GAS bf16_t* xb = (GAS bf16_t*)(ws + WS_XB);
    for (int row = gw; row < T; row += NGW) {
        const float w0 = tokw[(size_t)row * 2], w1 = tokw[(size_t)row * 2 + 1]; f32x4 v[8];
#pragma unroll
        for (int j = 0; j < 8; ++j) { const size_t c = 4 * F.lane + 256 * j; const u32x2 xw = *(const GAS u32x2*)(x1 + (size_t)row * D + c); const f32x4 xv = {bf_lo(xw.x), bf_hi(xw.x), bf_lo(xw.y), bf_hi(xw.y)};
            const u32x2 y0 = *(const GAS u32x2*)(yasg + (size_t)(2 * row) * D + c), y1 = *(const GAS u32x2*)(yasg + (size_t)(2 * row + 1) * D + c);
            f32x4 t; t[0] = w0 * bf_lo(y0.x) + w1 * bf_lo(y1.x); t[1] = w0 * bf_hi(y0.x) + w1 * bf_hi(y1.x); t[2] = w0 * bf_lo(y0.y) + w1 * bf_lo(y1.y); t[3] = w0 * bf_hi(y0.y) + w1 * bf_hi(y1.y);
            v[j] = xv * DN_ALPHA + t; }
        ln_row(v, g2, b2, F.lane);
        float q8 = 0.f;
        if (l != DEPTH - 1) { float mx = 0.f;
#pragma unroll
            for (int j = 0; j < 8; ++j) mx = fmaxf(fmaxf(mx, fmaxf(fabsf(v[j][0]), fabsf(v[j][1]))), fmaxf(fabsf(v[j][2]), fabsf(v[j][3])));
            mx = fmaxf(wave_max(mx), 1e-30f); q8 = 127.0f / mx; if (F.lane == 0) ((GAS float*)(ws + WS_XS))[row] = mx * (1.0f / 127.0f); }
#pragma unroll
        for (int j = 0; j < 8; ++j) { const size_t c = 4 * F.lane + 256 * j; if (l == DEPTH - 1) *(GAS f32x4*)(outf + (size_t)row * D + c) = v[j];
            else { u32x2 wv; wv.x = pk2(v[j][0], v[j][1]); wv.y = pk2(v[j][2], v[j][3]); *(GAS u32x2*)(xb + (size_t)row * D + c) = wv;
                *(GAS unsigned*)(ws + WS_XB8 + (size_t)row * D + c) = pk_i8(v[j][0], v[j][1], v[j][2], v[j][3], q8); } }
    }
}

constexpr int PH_PER_LAYER = 10, N_PHASES = DEPTH * PH_PER_LAYER;
#ifndef ONLY_PHASE
#define ONLY_PHASE -1
#endif
#define IN(k) ((ONLY_PHASE < 0 || ONLY_PHASE == ((k) % PH_PER_LAYER)) && lo <= (k) && (k) < hi)
#define SEAM(k) do { if (!MK_PER_PHASE && ((((k) % PH_PER_LAYER) == 2) ? IN((k) + 2) : IN((k) + 1))) xcd_barrier(bar); } while (0)
#define PF Frame F = phase_frame(F0)
#ifndef DUP_MASK
#define DUP_MASK 0
#endif
#define NREP(k) ((((DUP_MASK) >> (k)) & 1) ? 2 : 1)
__device__ __forceinline__ void phase_w_kv(const Frame& F0, int l) {
    { Frame F = phase_frame(F0); GAS unsigned char* ws = KWS();
      SchedKv S{(const GAS char*)(ws + WS_MEMB), (const GAS char*)(ws + WS_WKV) + (size_t)l * 2048 * D * 2, F.vcu};
      EpiProj E{ws, (const GAS float*)(ws + WS_ROPE), (const GAS float*)(ws + WS_ROPE) + 2048 * 128};
      pg8::gemm_phase<EpiProj, SchedKv, false>(F.lds, S, E); }
    __syncthreads();
    { Frame F = phase_frame(F0); phase_w(F, l); }
}
template <int l> __device__ __forceinline__ void run_layer(const Frame& F0, const XcdBarrier& bar, int lo, int hi) {
        constexpr int pb = l * PH_PER_LAYER;
        if (l == 0) {
            if (lo <= -1 && -1 < hi) { { PF; phase_w0a(F); } if (!MK_PER_PHASE && IN(pb + 0)) xcd_barrier(bar); }
            if (IN(pb + 0)) { for (int rep_ = 0; rep_ < NREP(0); ++rep_) phase_w_kv(F0, 0); SEAM(pb + 0); } }
        if (IN(pb + 1)) { for (int rep_ = 0; rep_ < NREP(1); ++rep_) {
            { PF; GAS unsigned char* ws = KWS();
              const float wdq = fmaxf(WQ_RANGE * __uint_as_float(xb_ld((GAS unsigned*)(ws + WS_CTL) + CW_WMAX + l)), 1e-30f) * (1.0f / 127.0f);
              SchedProj S{(const GAS char*)(ws + WS_XB8), (const GAS char*)(ws + WS_WIN8), F.G, F.bx, 0};
              EpiProjQ E{EpiProj{ws, (const GAS float*)(ws + WS_ROPE), (const GAS float*)(ws + WS_ROPE) + 2048 * 128}, (const GAS float*)(ws + WS_XS), wdq};
              pg8::gemm_phase<EpiProjQ, SchedProj, false>(F.lds, S, E); }
            { PF; GAS unsigned char* ws = KWS();
              const float wdq = fmaxf(WQ_RANGE * __uint_as_float(xb_ld((GAS unsigned*)(ws + WS_CTL) + CW_WMAX + l)), 1e-30f) * (1.0f / 127.0f);
              SchedProj S{(const GAS char*)(ws + WS_XB8), (const GAS char*)(ws + WS_WIN8), F.G, F.bx, 1};
              EpiProjT E{ws, wdq, (const GAS float*)(ws + WS_XS)};
              pg8::gemm_phase<EpiProjT, SchedProj, true>(F.lds, S, E); } }
            SEAM(pb + 1);
        }
        if (IN(pb + 2)) { for (int rep_ = 0; rep_ < NREP(2); ++rep_) { PF; phase_mixers(F); } SEAM(pb + 2); }
        if (IN(pb + 4)) { for (int rep_ = 0; rep_ < NREP(4); ++rep_) {
            PF; GAS unsigned char* ws = KWS();
            SchedMerge S{(const GAS char*)(ws + WS_YA), (const GAS char*)(ws + WS_YR), (const GAS char*)(ws + WS_YM), (const GAS char*)(ws + WS_WPM), (const GAS char*)(ws + WS_WPR), (const GAS char*)(ws + WS_WPE), F.G, F.bx};
            static_assert(WS_SGR == WS_SGA + 64 * MiB && WS_SGM == WS_SGR + 64 * MiB, "gate arrays");
            EpiMerge E{(const GAS unsigned char*)(ws + WS_SGA), (GAS bf16_t*)(ws + WS_MERGED)};
            pg8::gemm_phase<EpiMerge, SchedMerge, false>(F.lds, S, E); }
            SEAM(pb + 4);
        }
        if (IN(pb + 5)) { for (int rep_ = 0; rep_ < NREP(5); ++rep_) {
            PF; GAS unsigned char* ws = KWS();
            SchedPlain S{(const GAS char*)(ws + WS_MERGED), (const GAS char*)(ws + WS_WO), 64, 8, F.G, F.bx};
            EpiResid E{(const GAS bf16_t*)(ws + WS_XB), (GAS bf16_t*)(ws + WS_HPRE)};
            pg8::gemm_phase<EpiResid, SchedPlain, false>(F.lds, S, E); }
            SEAM(pb + 5);
        }
        if (IN(pb + 6)) { for (int rep_ = 0; rep_ < NREP(6); ++rep_) { PF; phase_ln1_router(F, l, rep_ == NREP(6) - 1); } SEAM(pb + 6); }
        if (IN(pb + 7)) { for (int rep_ = 0; rep_ < NREP(7); ++rep_) {
            PF; GAS unsigned char* ws = KWS();
            build_moe_tab(F, (GAS unsigned*)(ws + WS_CTL) + CW_CNT + l * 64 * NEXP);
            SchedMoe1 S{(const GAS char*)(ws + WS_X1B), (const GAS char*)(ws + WS_WGU), (const GAS int*)(ws + WS_LIST), (LAS int*)(F.lds + LDS_TAB), F.G, F.vcu};
            EpiSwiglu E{(GAS bf16_t*)(ws + WS_HBUF), (GAS unsigned*)(ws + WS_CTL) + CW_FLAG + l * 4096};
            pg8::gemm_phase<EpiSwiglu, SchedMoe1, false>(F.lds, S, E); }
        }
        if (IN(pb + 8)) { for (int rep_ = 0; rep_ < NREP(8); ++rep_) {
            PF; GAS unsigned char* ws = KWS();
            build_moe_tab(F, (GAS unsigned*)(ws + WS_CTL) + CW_CNT + l * 64 * NEXP);
            SchedMoe2 S{(const GAS char*)(ws + WS_HBUF), (const GAS char*)(ws + WS_WDN), (const GAS int*)(ws + WS_LIST), (LAS int*)(F.lds + LDS_TAB), F.G, F.vcu, (GAS unsigned*)(ws + WS_CTL) + CW_FLAG + l * 4096};
            EpiScatter E{(GAS bf16_t*)(ws + WS_YASG)};
            pg8::gemm_phase<EpiScatter, SchedMoe2, false>(F.lds, S, E); }
            SEAM(pb + 8);
        }
        if (IN(pb + 9)) { for (int rep_ = 0; rep_ < NREP(9); ++rep_) { PF; phase_ln2(F, l); }
            if (l + 1 < DEPTH) { phase_w_kv(F0, l + 1); if (!MK_PER_PHASE && IN(pb + 11)) xcd_barrier(bar); } }
}
#undef IN
#undef SEAM
#undef PF
#undef NREP
__global__ void __launch_bounds__(NWAVES * 64, 2) hybrid_fwd(Args args) {
    extern __shared__ __attribute__((aligned(16))) unsigned char lds_raw[];
    Frame F0;
    F0.lds = (LAS unsigned char*)lds_raw; F0.MISC = (volatile LAS unsigned*)(F0.lds + MISC_OFF);
    F0.tid = threadIdx.x; F0.lane = F0.tid & 63; F0.wave = __builtin_amdgcn_readfirstlane(F0.tid >> 6);
    F0.G = gridDim.x; { const int bx = blockIdx.x; F0.bx = bx; F0.vcu = (F0.G % 8 == 0) ? (bx % 8) * (F0.G / 8) + bx / 8 : bx; }
    for (int u = F0.tid; u < (LDS_BYTES - LDSCTL_OFF) / 4; u += NWAVES * 64) ((LAS unsigned*)(F0.lds + LDSCTL_OFF))[u] = 0u;
    __syncthreads();
    XcdBarrier bar; bar.bar = (GAS unsigned*)(KWS() + WS_CTL) + CW_BAR; bar.x = 0; bar.st = nullptr;
    if (!MK_PER_PHASE) bar = xcd_barrier_post((GAS unsigned*)(KWS() + WS_CTL) + CW_BAR, F0.MISC + 8);
    const int lo = args.ph_lo, hi = args.ph_hi;
    run_layer<0>(F0, bar, lo, hi);
    run_layer<1>(F0, bar, lo, hi);
}

extern "C" void kernel_launch(void* const* d_in, const int* in_sizes, int n_in, void* d_out, int out_size, void* d_ws, size_t ws_size, hipStream_t stream) {
    static int grid = 0;
    if (grid == 0) {
        if (n_in != 18 || out_size != T * D || ws_size < WS_END) { fprintf(stderr, "kernel_launch: unexpected shapes (n_in %d, out %d, ws %zu < %zu)\n", n_in, out_size, ws_size, (size_t)WS_END); grid = -1; return; }
        int dev = 0, cus = 0, per_cu = 0;
        if (hipGetDevice(&dev) != hipSuccess || hipDeviceGetAttribute(&cus, hipDeviceAttributeMultiprocessorCount, dev) != hipSuccess) { grid = -1; return; }
        if (hipFuncSetAttribute((const void*)hybrid_fwd, hipFuncAttributeMaxDynamicSharedMemorySize, LDS_BYTES) != hipSuccess) { fprintf(stderr, "kernel_launch: hipFuncSetAttribute failed\n"); grid = -1; return; }
        if (hipOccupancyMaxActiveBlocksPerMultiprocessor(&per_cu, (const void*)hybrid_fwd, NWAVES * 64, LDS_BYTES) != hipSuccess || per_cu < 1) { fprintf(stderr, "kernel_launch: occupancy query says %d\n", per_cu); per_cu = 1; }
        (void)hipGetLastError();
        grid = cus;
    }
    if (grid < 0) return;
    (void)hipMemsetAsync((char*)d_ws + WS_CTL, 0, CTL_ZERO_BYTES, stream);
    Args a{};
    for (int i = 0; i < 18; ++i) a.in[i] = (const float*)d_in[i];
    a.out = (float*)d_out; a.ws = (unsigned char*)d_ws;
#if MK_PER_PHASE
    for (int p = -1; p < N_PHASES; ++p) { a.ph_lo = p; a.ph_hi = p + 1; hipLaunchKernelGGL(hybrid_fwd, dim3(grid), dim3(NWAVES * 64), LDS_BYTES, stream, a); }
#else
    a.ph_lo = -1; a.ph_hi = N_PHASES;
    hipLaunchKernelGGL(hybrid_fwd, dim3(grid), dim3(NWAVES * 64), LDS_BYTES, stream, a);
#endif
}
```

```cpp
#include <hip/hip_runtime.h>
#include <cstdio>
#include <cstdint>
#include <cstddef>

#ifndef MK_PER_PHASE
#define MK_PER_PHASE 0
#endif

#define LAS __attribute__((address_space(3)))
#define GAS __attribute__((address_space(1)))
typedef unsigned short bf16_t;
typedef short bf16x8 __attribute__((ext_vector_type(8)));
typedef short s16x4 __attribute__((ext_vector_type(4)));
typedef float f32x2 __attribute__((ext_vector_type(2)));
typedef float f32x4 __attribute__((ext_vector_type(4)));
typedef float f32x16 __attribute__((ext_vector_type(16)));
typedef unsigned u32x2 __attribute__((ext_vector_type(2)));
typedef unsigned u32x4 __attribute__((ext_vector_type(4)));
typedef int v4i32 __attribute__((ext_vector_type(4)));
typedef int v8i32 __attribute__((ext_vector_type(8)));
typedef __bf16 bf16x2_t __attribute__((ext_vector_type(2)));
typedef GAS unsigned gu32;

constexpr int D = 2048, BATCH = 8, SEQ = 2048, T = BATCH * SEQ, DEPTH = 2;
constexpr int INW = 16384;
constexpr int NEXP = 32, EFF = 512;
constexpr float DN_ALPHA = 1.41421356237309515f;
constexpr float LN_EPS = 1e-5f, GN_EPS = 1e-6f;
constexpr float LOG2E = 1.44269504088896341f;

constexpr size_t MiB = 1u << 20;
constexpr size_t WS_CTL = 0, CTL_ZERO_BYTES = 1 * MiB;
constexpr size_t WS_ROPE = 1 * MiB;
constexpr size_t WS_WRT = 3 * MiB;
constexpr size_t WRT_GL = 196608, WRT_CS = 393216, WRT_C0 = WRT_CS + 256;
constexpr size_t WS_WIN = 4 * MiB;
constexpr size_t WS_WPM = 68 * MiB;
constexpr size_t WS_WPR = 72 * MiB;
constexpr size_t WS_WPE = 80 * MiB;
constexpr size_t WS_WO = 84 * MiB;
constexpr size_t WS_WKV = 372 * MiB;
constexpr size_t WS_WGU = 100 * MiB;
constexpr size_t WS_WDN = 228 * MiB;
constexpr size_t WS_MEMB = 292 * MiB;
constexpr size_t WS_KM = 300 * MiB;
constexpr size_t WS_VMT = 304 * MiB;
constexpr size_t WS_XB = 308 * MiB;
constexpr size_t WS_X1 = 372 * MiB;
constexpr size_t WS_X1B = 500 * MiB;
constexpr size_t WS_XN = 564 * MiB;
constexpr size_t WS_XB8 = WS_XN, WS_WIN8 = WS_XN + 32 * MiB, WS_XS = WS_XN + 96 * MiB;
constexpr float WQ_RANGE = 1.0f;
constexpr int CW_WMAX = 49152;
#ifndef F8_QK
#define F8_QK 1
#endif
constexpr int NF8X = F8_QK ? 12 : 4;
constexpr float GATE_WSCALE = 64.0f;
constexpr float Y8_SCALE = 4.0f;
constexpr size_t WS_HPRE = 692 * MiB;
constexpr size_t WS_MACC = 820 * MiB;
constexpr size_t WS_MERGED = 948 * MiB;
constexpr size_t WS_YA = 1012 * MiB;
constexpr size_t WS_YR = 1044 * MiB;
constexpr size_t WS_YM = 1108 * MiB;
constexpr size_t WS_RO = 1140 * MiB;
constexpr size_t WS_RSTAT = 1204 * MiB;
constexpr size_t WS_PROJ = 1208 * MiB;
constexpr size_t WS_AQ = WS_PROJ, WS_AK = WS_AQ + 32 * MiB, WS_AVT = WS_AK + 32 * MiB, WS_RQ = WS_AVT + 32 * MiB, WS_RK = WS_RQ + 32 * MiB;
constexpr size_t WS_RVT = WS_RK + 32 * MiB, WS_RGS = WS_RVT + 64 * MiB, WS_MQ = WS_RGS + 64 * MiB, WS_SGA = WS_MQ + 32 * MiB, WS_SGR = WS_SGA + 64 * MiB, WS_SGM = WS_SGR + 64 * MiB;
constexpr size_t WS_PROJ_END = WS_SGM + 64 * MiB;
constexpr size_t WS_LIST = WS_PROJ;
constexpr size_t WS_TOKW = WS_PROJ + 2 * MiB;
constexpr size_t WS_HBUF = WS_PROJ + 4 * MiB;
constexpr size_t WS_YASG = WS_PROJ + 44 * MiB;
constexpr size_t WS_END = WS_PROJ_END;
static_assert(WS_PROJ_END == (1208 + 512) * MiB && WS_YASG + 128 * MiB <= WS_PROJ_END, "ws map");
constexpr int CW_BAR = 4096;
constexpr int CW_CNT = 16384;
constexpr int CW_FLAG = 32768;

constexpr int RING_BYTES = 131072;
constexpr int LDS_TAB = 158720;
constexpr int LDSCTL_OFF = LDS_TAB + 4096, MISC_OFF = LDSCTL_OFF + 320;
constexpr int LDS_BYTES = 163840;
constexpr int NWAVES = 8;

__device__ __forceinline__ unsigned pk2(float lo, float hi) { f32x2 v = {lo, hi}; bf16x2_t b = __builtin_convertvector(v, bf16x2_t); return __builtin_bit_cast(unsigned, b); }
__device__ __forceinline__ float bf_lo(unsigned w) { return __uint_as_float(w << 16); }
__device__ __forceinline__ float bf_hi(unsigned w) { return __uint_as_float(w & 0xffff0000u); }
__device__ __forceinline__ float wave_sum(float v) {
#pragma unroll
    for (int o = 1; o < 64; o <<= 1) v += __shfl_xor(v, o);
    return v;
}
__device__ __forceinline__ float wave_max(float v) {
#pragma unroll
    for (int o = 1; o < 64; o <<= 1) v = fmaxf(v, __shfl_xor(v, o));
    return v;
}
__device__ __forceinline__ unsigned pk_i8(float a, float b, float c, float d, float q) {
    unsigned w = 0;
    w = __builtin_amdgcn_cvt_pk_u8_f32(fminf(fmaxf(__builtin_rintf(a * q), -127.0f), 127.0f) + 128.0f, 0, w); w = __builtin_amdgcn_cvt_pk_u8_f32(fminf(fmaxf(__builtin_rintf(b * q), -127.0f), 127.0f) + 128.0f, 1, w);
    w = __builtin_amdgcn_cvt_pk_u8_f32(fminf(fmaxf(__builtin_rintf(c * q), -127.0f), 127.0f) + 128.0f, 2, w); w = __builtin_amdgcn_cvt_pk_u8_f32(fminf(fmaxf(__builtin_rintf(d * q), -127.0f), 127.0f) + 128.0f, 3, w);
    return w ^ 0x80808080u;
}
__device__ __forceinline__ float f8c(float x) { return __builtin_amdgcn_fmed3f(x, -440.0f, 440.0f); }
__device__ __forceinline__ float fast_exp2(float x) { return __builtin_amdgcn_exp2f(x); }
__device__ __forceinline__ float max3f(float a, float b, float c) { float r; asm("v_max3_f32 %0, %1, %2, %3" : "=v"(r) : "v"(a), "v"(b), "v"(c)); return r; }
__device__ __forceinline__ float sigmoidf_(float x) { return __builtin_amdgcn_rcpf(1.0f + __builtin_amdgcn_exp2f(-LOG2E * x)); }
#define LDS_WAIT() asm volatile("s_waitcnt lgkmcnt(0)" ::: "memory")
#define VM_WAIT() asm volatile("s_waitcnt vmcnt(0)" ::: "memory")

#define XB_TMO      128
#define XB_XCNT(j)  (256  + 64 * (j))
#define XB_XSUB(j)  (1280 + 64 * (j))
#define XB_XGEN(j)  (2304 + 64 * (j))
#define XB_TOP      3328
#define XB_TOPGEN   3392
#define XCD_BAR_WORDS 3456
#define XB_SPIN_CAP (1u << 18)
__device__ __forceinline__ unsigned xb_ld(GAS unsigned* p)              { return __hip_atomic_load(p, __ATOMIC_RELAXED, __HIP_MEMORY_SCOPE_AGENT); }
__device__ __forceinline__ unsigned xb_add(GAS unsigned* p, unsigned v) { return __hip_atomic_fetch_add(p, v, __ATOMIC_RELAXED, __HIP_MEMORY_SCOPE_AGENT); }
__device__ __forceinline__ unsigned xb_xcc_id() { return (unsigned)__builtin_amdgcn_s_getreg((3 << 11) | 20) & 0xFu; }
#define XB_SPIN(cond, bar) do { unsigned _sp = 0; while (cond) { __builtin_amdgcn_s_sleep(1); \
    if ((++_sp & 255u) == 0u) { if (xb_ld(&(bar)[XB_TMO])) break; if (_sp > XB_SPIN_CAP) { (void)xb_add(&(bar)[XB_TMO], 1u); break; } } } } while (0)
struct XcdBarrier { GAS unsigned* bar; unsigned x; volatile LAS unsigned* st; };
__device__ __forceinline__ XcdBarrier xcd_barrier_post(GAS unsigned* bar, volatile LAS unsigned* st) {
    XcdBarrier b; b.bar = bar; b.x = xb_xcc_id(); b.st = st;
    if (threadIdx.x == 0) (void)xb_add(&bar[XB_XCNT(b.x)], 1u);
    return b;
}
__device__ __forceinline__ void xcd_barrier_complete(GAS unsigned* bar, unsigned x, unsigned& nloc, unsigned& nx) {
    const unsigned G = gridDim.x * gridDim.y * gridDim.z;
    unsigned sum, cnt, mine, sp = 0u;
    for (;;) {
        sum = 0u; cnt = 0u; mine = 0u;
#pragma unroll
        for (unsigned j = 0; j < 16; ++j) { const unsigned c = xb_ld(&bar[XB_XCNT(j)]); sum += c; cnt += (c > 0u) ? 1u : 0u; mine = (j == x) ? c : mine; }
        if (sum == G) break;
        __builtin_amdgcn_s_sleep(1);
        if ((++sp & 255u) == 0u) { if (xb_ld(&bar[XB_TMO])) break; if (sp > XB_SPIN_CAP) { (void)xb_add(&bar[XB_TMO], 1u); break; } }
    }
    nloc = mine > 0u ? mine : 1u; nx = cnt > 0u ? cnt : 1u;
}
__device__ __forceinline__ void xcd_barrier(const XcdBarrier& b) {
    asm volatile("s_waitcnt vmcnt(0)" ::: "memory");
    __syncthreads();
    if (threadIdx.x == 0) {
        GAS unsigned* bar = b.bar; asm volatile("" : "+s"(bar));
        __builtin_amdgcn_s_waitcnt(0);
        unsigned nloc = b.st[0], nx = b.st[1];
        if (nloc == 0u) { xcd_barrier_complete(bar, b.x, nloc, nx); b.st[0] = nloc; b.st[1] = nx; }
        const unsigned old = xb_add(&bar[XB_XSUB(b.x)], 1u);
        const unsigned gen = old / nloc;
        if (old + 1u == (gen + 1u) * nloc) {
            __builtin_amdgcn_fence(__ATOMIC_RELEASE, "agent");
            asm volatile("s_waitcnt vmcnt(0)" ::: "memory");
            const unsigned og = xb_add(&bar[XB_TOP], 1u);
            const unsigned tg = og / nx;
            if (og + 1u == (tg + 1u) * nx) xb_add(&bar[XB_TOPGEN], 1u);
            else XB_SPIN(xb_ld(&bar[XB_TOPGEN]) == tg, bar);
            __builtin_amdgcn_fence(__ATOMIC_ACQUIRE, "agent");
            xb_add(&bar[XB_XGEN(b.x)], 1u);
            asm volatile("s_waitcnt vmcnt(0)" ::: "memory");
        } else {
            XB_SPIN(xb_ld(&bar[XB_XGEN(b.x)]) == gen, bar);
            __builtin_amdgcn_fence(__ATOMIC_ACQUIRE, "agent");
            asm volatile("s_waitcnt vmcnt(0)" ::: "memory");
        }
    }
    __syncthreads();
}

namespace pg8 {
constexpr int BM = 256, BK = 64, HALF = 128, HTB = HALF * BK * 2, STAGE_BYTES = 8 * HTB, NXCD = 8, WGM = 8;
__host__ __device__ __forceinline__ int lds_byte(int r, int c) { const int st = (r >> 4) * 2 + (c >> 5), rr = r & 15, cc = c & 31, ob = rr * 64 + cc * 2; return st * 1024 + (ob ^ (((ob >> 9) & 1) << 5)); }
__host__ __device__ __forceinline__ void stage_rc(int b, int& R, int& C) { const int st = b / 1024, sb = b % 1024, swz = sb ^ (((sb >> 9) & 1) << 5); R = (st >> 1) * 16 + swz / 64; C = (st & 1) * 32 + (swz % 64) / 2; }
__host__ __device__ __forceinline__ int perm32(int rho) { const int n = rho >> 4, i = rho & 15; return 8 * (i >> 2) + 4 * n + (i & 3); }

struct Unit {
    const GAS char* A; const GAS char* B; int pm, pn; int aux, nvalid; const GAS int* gather;
    unsigned lda, ldb; int K;
};
__device__ __forceinline__ void static_tile(int L, int nM, int nN, int& pm, int& pn) {
    const int nwg = nM * nN; int wgid = L;
    { const int q = nwg / NXCD, r = nwg % NXCD, xcd = wgid % NXCD, off = wgid / NXCD; wgid = (xcd < r ? xcd * (q + 1) : r * (q + 1) + (xcd - r) * q) + off; }
    const int nig = WGM * nN, gid = wgid / nig, fm = gid * WGM, gsz = (nM - fm) < WGM ? (nM - fm) : WGM;
    pm = fm + ((wgid % nig) % gsz); pn = (wgid % nig) / gsz;
}

template <int QM_> struct Frag { using T = bf16x8; static constexpr int NK = 2;
    static __device__ __forceinline__ T ld(const LAS unsigned char* p, int k) { return *(const LAS bf16x8*)(p + k * 1024); } };
template <> struct Frag<2> { using T = v4i32; static constexpr int NK = 2;
    static __device__ __forceinline__ T ld(const LAS unsigned char* p, int k) { return *(const LAS v4i32*)(p + k * 1024); } };
__device__ __forceinline__ f32x4 mma_frag(v4i32 a, v4i32 b, f32x4 c) { return __builtin_bit_cast(f32x4, __builtin_amdgcn_mfma_i32_16x16x64_i8(a, b, __builtin_bit_cast(v4i32, c), 0, 0, 0)); }
template <> struct Frag<1> { using T = v8i32; static constexpr int NK = 1;
    static __device__ __forceinline__ T ld(const LAS unsigned char* p, int) { return __builtin_shufflevector(*(const LAS v4i32*)(p), *(const LAS v4i32*)(p + 1024), 0, 1, 2, 3, 4, 5, 6, 7); } };
__device__ __forceinline__ f32x4 mma_frag(bf16x8 a, bf16x8 b, f32x4 c) { return __builtin_amdgcn_mfma_f32_16x16x32_bf16(a, b, c, 0, 0, 0); }
__device__ __forceinline__ f32x4 mma_frag(v8i32 a, v8i32 b, f32x4 c) { const unsigned sc_ = 0x7F7F7F7Fu;
    asm volatile("v_mfma_scale_f32_16x16x128_f8f6f4 %0, %1, %2, %0, %3, %3 op_sel_hi:[0,0,0]" : "+v"(c) : "v"(a), "v"(b), "v"(sc_)); return c; }
template <class S, bool Dp = S::DEP> struct DepWait { static __device__ __forceinline__ void go(const S&, const Unit&) {} };
template <class S> struct DepWait<S, true> { static __device__ __forceinline__ void go(const S& s, const Unit& u) { s.acquire(u); } };
template <class E_, bool Kp = E_::KEEP> struct EpiCall { static __device__ __forceinline__ bool go(const E_& e, f32x4 (&acc)[2][2][4][2], const Unit& u, int wr, int wc, int fr, int fq) { e(acc, u, wr, wc, fr, fq); return false; } };
template <class E_> struct EpiCall<E_, true> { static __device__ __forceinline__ bool go(const E_& e, f32x4 (&acc)[2][2][4][2], const Unit& u, int wr, int wc, int fr, int fq) { return e.merge(acc, u, wr, wc, fr, fq); } };
template <class Epi, class Sched, bool SWAP>
__device__ __forceinline__ void gemm_phase(LAS unsigned char* lds, const Sched& S, const Epi& E) {
    constexpr bool VARLD = Sched::VARLD, GATHER = Sched::GATHER, DYN = VARLD || GATHER;
    int tid = threadIdx.x; asm volatile("" : "+v"(tid));
    const int wid = __builtin_amdgcn_readfirstlane(tid >> 6), lane = tid & 63, wr = wid >> 2, wc = wid & 3, fr = lane & 15, fq = lane >> 4;
    int RA[2], CA[2], RB[2];
#pragma unroll
    for (int i = 0; i < 2; ++i) { int R, C; stage_rc(tid * 16 + i * 8192, R, C); RA[i] = R; CA[i] = C * 2; RB[i] = Epi::PERM ? ((R & ~31) + perm32(R & 31)) : R; }
    const unsigned ldsw = (unsigned)wid * 1024u;
    const int aoff = lds_byte(wr * 64 + fr, fq * 8), boff = lds_byte(wc * 32 + fr, fq * 8);
    constexpr size_t kstep = (size_t)(BK * 2);
#define PG8_SA(b, h) (((b) * 2 + (h)) * HTB)
#define PG8_SB(b, h) ((4 + (b) * 2 + (h)) * HTB)
#define PG8_GL(bufoff, gptr, i) __builtin_amdgcn_global_load_lds((const GAS unsigned*)(gptr), (LAS unsigned*)(lds + (bufoff) + ldsw + (i) * 8192), 16, 0, 0)
#define PG8_STAGE2(bufoff, p, oa, ob) do { PG8_GL(bufoff, (p) + (oa), 0); PG8_GL(bufoff, (p) + (ob), 1); } while (0)
#define PG8_LDA(dst, b, h) do { _Pragma("unroll") for (int m = 0; m < 4; ++m) _Pragma("unroll") for (int k = 0; k < NK; ++k) dst[m][k] = FR::ld(lds + PG8_SA(b, h) + aoff + m * 2048, k); } while (0)
#define PG8_LDB(dst, b, h) do { _Pragma("unroll") for (int n = 0; n < 2; ++n) _Pragma("unroll") for (int k = 0; k < NK; ++k) dst[n][k] = FR::ld(lds + PG8_SB(b, h) + boff + n * 2048, k); } while (0)
#define PG8_MM(ai, bj, At, Bt) do { __builtin_amdgcn_s_setprio(1); _Pragma("unroll") for (int m = 0; m < 4; ++m) _Pragma("unroll") for (int n = 0; n < 2; ++n) _Pragma("unroll") for (int k = 0; k < NK; ++k) \
        acc[ai][bj][m][n] = SWAP ? mma_frag(At[m][k], Bt[n][k], acc[ai][bj][m][n]) : mma_frag(Bt[n][k], At[m][k], acc[ai][bj][m][n]); __builtin_amdgcn_s_setprio(0); } while (0)
#define PG8_WAIT_V(n) asm volatile("s_waitcnt vmcnt(" #n ")" ::: "memory")
#define PG8_WAIT_L(n) asm volatile("s_waitcnt lgkmcnt(" #n ")" ::: "memory")
#define PG8_BAR __builtin_amdgcn_s_barrier()
#define PG8_SCHED __builtin_amdgcn_sched_barrier(0)
#define PG8_UCOPY(d, s_) do { (d).A = (s_).A; (d).B = (s_).B; (d).pm = (s_).pm; (d).pn = (s_).pn; (d).aux = (s_).aux; (d).nvalid = (s_).nvalid; (d).gather = (s_).gather; (d).lda = (s_).lda; (d).ldb = (s_).ldb; (d).K = (s_).K; } while (0)
#define PG8_UINIT(d) do { (d).A = nullptr; (d).B = nullptr; (d).pm = 0; (d).pn = 0; (d).aux = 0; (d).nvalid = 256; (d).gather = nullptr; (d).lda = 0; (d).ldb = 0; (d).K = 256; } while (0)
    Unit cur, nxt, tmp; int ui = 0;
    PG8_UINIT(cur); PG8_UINIT(nxt);
    if (!S.next(0, cur)) return;
    f32x4 acc[2][2][4][2];
#pragma unroll
    for (int a = 0; a < 2; ++a)
#pragma unroll
        for (int b = 0; b < 2; ++b)
#pragma unroll
            for (int m = 0; m < 4; ++m)
#pragma unroll
                for (int n = 0; n < 2; ++n) acc[a][b][m][n] = (f32x4){0.f, 0.f, 0.f, 0.f};
    using FR = Frag<Sched::F8 ? 1 : (Sched::I8 ? 2 : 0)>; constexpr int NK = FR::NK;
    typename FR::T At[4][NK], B0[2][NK], B1[2][NK];
    unsigned cA0, cA1, cA2 = 0, cA3 = 0, cB0, cB1, nA0 = 0, nA1 = 0, nA2 = 0, nA3 = 0, nB0 = 0, nB1 = 0;
    size_t chA, chB, nhA = 0, nhB = 0;
#define PG8_OFFS(u, a0, a1, a2, a3, b0, b1, hA_, hB_) do { \
        const unsigned lda_ = VARLD ? (u).lda : Sched::LDA, ldb_ = VARLD ? (u).ldb : Sched::LDB; \
        if (GATHER) { const int r0 = RA[0], r1 = RA[1]; \
            const int i0 = r0 < (u).nvalid ? ((u).gather[r0] >> 1) : 0, i1 = r1 < (u).nvalid ? ((u).gather[r1] >> 1) : 0; \
            const int i2 = (r0 + 128) < (u).nvalid ? ((u).gather[r0 + 128] >> 1) : 0, i3 = (r1 + 128) < (u).nvalid ? ((u).gather[r1 + 128] >> 1) : 0; \
            a0 = (unsigned)i0 * lda_ + CA[0]; a1 = (unsigned)i1 * lda_ + CA[1]; a2 = (unsigned)i2 * lda_ + CA[0]; a3 = (unsigned)i3 * lda_ + CA[1]; hA_ = 0; } \
        else { a0 = (unsigned)RA[0] * lda_ + CA[0]; a1 = (unsigned)RA[1] * lda_ + CA[1]; hA_ = (size_t)128 * lda_; } \
        b0 = (unsigned)RB[0] * ldb_ + CA[0]; b1 = (unsigned)RB[1] * ldb_ + CA[1]; hB_ = (size_t)128 * ldb_; } while (0)
    PG8_OFFS(cur, cA0, cA1, cA2, cA3, cB0, cB1, chA, chB);
    const GAS char* cA = cur.A; const GAS char* cB = cur.B;
    DepWait<Sched>::go(S, cur);
#define PG8_A0(buf, p, X) PG8_STAGE2(buf, p, X##A0, X##A1)
#define PG8_A1(buf, p, X) do { if (GATHER) PG8_STAGE2(buf, p, X##A2, X##A3); else PG8_STAGE2(buf, (p) + X##hA, X##A0, X##A1); } while (0)
#define PG8_B0(buf, p, X) PG8_STAGE2(buf, p, X##B0, X##B1)
#define PG8_B1(buf, p, X) PG8_STAGE2(buf, (p) + X##hB, X##B0, X##B1)
    PG8_B0(PG8_SB(0, 0), cB, c); PG8_B1(PG8_SB(0, 1), cB, c); PG8_A0(PG8_SA(0, 0), cA, c); PG8_A1(PG8_SA(0, 1), cA, c);
    if (wr == 1) PG8_BAR;
    PG8_WAIT_V(2); PG8_BAR;
    PG8_B0(PG8_SB(1, 0), cB + kstep, c); PG8_A0(PG8_SA(1, 0), cA + kstep, c); PG8_B1(PG8_SB(1, 1), cB + kstep, c);
    PG8_WAIT_V(6); PG8_BAR;
    for (;;) {
        PG8_UINIT(tmp); const bool has_next = S.next(ui + 1, tmp);
        if (has_next) { PG8_UCOPY(nxt, tmp); } else { PG8_UCOPY(nxt, cur); }
        if (DYN) { if (has_next) { PG8_OFFS(nxt, nA0, nA1, nA2, nA3, nB0, nB1, nhA, nhB); } else { nA0 = cA0; nA1 = cA1; nA2 = cA2; nA3 = cA3; nB0 = cB0; nB1 = cB1; nhA = chA; nhB = chB; } }
        const GAS char* nA = nxt.A; const GAS char* nB = nxt.B;
        const int nt = (VARLD ? cur.K : Sched::KK) / BK;
        for (int t = 0; t < nt; t += 2) {
            const bool last = (t == nt - 2);
            if (Sched::DEP && last && has_next) DepWait<Sched>::go(S, nxt);
            const GAS char* a1 = cA + (size_t)(t + 1) * kstep;
            const GAS char* a2 = last ? nA : cA + (size_t)(t + 2) * kstep; const GAS char* b2 = last ? nB : cB + (size_t)(t + 2) * kstep;
            const GAS char* a3 = a2 + kstep; const GAS char* b3 = b2 + kstep;
            const unsigned sA0 = DYN ? (last ? nA0 : cA0) : cA0, sA1 = DYN ? (last ? nA1 : cA1) : cA1, sA2 = GATHER ? (last ? nA2 : cA2) : 0u, sA3 = GATHER ? (last ? nA3 : cA3) : 0u;
            const unsigned sB0 = VARLD ? (last ? nB0 : cB0) : cB0, sB1 = VARLD ? (last ? nB1 : cB1) : cB1;
            const size_t shA = VARLD ? (last ? nhA : chA) : chA, shB = VARLD ? (last ? nhB : chB) : chB;
            (void)sA2; (void)sA3;
            PG8_LDB(B0, 0, 0); PG8_LDB(B1, 0, 1); PG8_SCHED; PG8_LDA(At, 0, 0); PG8_A1(PG8_SA(1, 1), a1, c);
            PG8_WAIT_V(8); PG8_WAIT_L(0); PG8_BAR; PG8_MM(0, 0, At, B0); PG8_MM(0, 1, At, B1); PG8_BAR; PG8_SCHED;
            PG8_LDA(At, 0, 1); PG8_B0(PG8_SB(0, 0), b2, s); PG8_B1(PG8_SB(0, 1), b2, s); PG8_A0(PG8_SA(0, 0), a2, s);
            PG8_WAIT_V(8); PG8_WAIT_L(0); PG8_BAR; PG8_MM(1, 0, At, B0); PG8_MM(1, 1, At, B1); PG8_BAR; PG8_SCHED;
            PG8_LDB(B0, 1, 0); PG8_LDB(B1, 1, 1); PG8_SCHED; PG8_LDA(At, 1, 0); PG8_A1(PG8_SA(0, 1), a2, s);
            PG8_WAIT_V(8); PG8_WAIT_L(0); PG8_BAR; PG8_MM(0, 0, At, B0); PG8_MM(0, 1, At, B1); PG8_BAR; PG8_SCHED;
            PG8_LDA(At, 1, 1); PG8_B0(PG8_SB(1, 0), b3, s); PG8_B1(PG8_SB(1, 1), b3, s); PG8_A0(PG8_SA(1, 0), a3, s);
            PG8_WAIT_V(8); PG8_WAIT_L(0); PG8_BAR; PG8_MM(1, 0, At, B0); PG8_MM(1, 1, At, B1); PG8_BAR; PG8_SCHED;
        }
        if (wr == 0) PG8_BAR;
        const bool keep = EpiCall<Epi>::go(E, acc, cur, wr, wc, fr, fq);
        if (!has_next) break;
        if (!keep) {
#pragma unroll
        for (int a = 0; a < 2; ++a)
#pragma unroll
            for (int b = 0; b < 2; ++b)
#pragma unroll
                for (int m = 0; m < 4; ++m)
#pragma unroll
                    for (int n = 0; n < 2; ++n) acc[a][b][m][n] = (f32x4){0.f, 0.f, 0.f, 0.f}; }
        PG8_UCOPY(cur, nxt); cA = nA; cB = nB; ++ui;
        if (DYN) { cA0 = nA0; cA1 = nA1; cA2 = nA2; cA3 = nA3; cB0 = nB0; cB1 = nB1; chA = nhA; chB = nhB; }
        if (wr == 1) PG8_BAR;
    }
    PG8_WAIT_V(0);
    PG8_BAR;
#undef PG8_SA
#undef PG8_SB
#undef PG8_GL
#undef PG8_STAGE2
#undef PG8_A0
#undef PG8_A1
#undef PG8_B0
#undef PG8_B1
#undef PG8_LDA
#undef PG8_LDB
#undef PG8_MM
#undef PG8_WAIT_V
#undef PG8_WAIT_L
#undef PG8_BAR
#undef PG8_SCHED
#undef PG8_OFFS
#undef PG8_UCOPY
#undef PG8_UINIT
}
}

struct Args {
    const float* in[18]; float* out; unsigned char* ws; int ph_lo, ph_hi;
};
struct Frame {
    LAS unsigned char* lds; volatile LAS unsigned* MISC;
    int tid, lane, wave, vcu, G, bx;
};
__device__ __forceinline__ Frame phase_frame(const Frame& F0) {
    Frame F = F0; int t = F0.tid, v = F0.vcu, g = F0.G, b = (int)blockIdx.x;
    asm volatile("" : "+v"(t)); asm volatile("" : "+s"(v)); asm volatile("" : "+s"(g)); asm volatile("" : "+s"(b));
    F.tid = t; F.lane = t & 63; F.wave = __builtin_amdgcn_readfirstlane(t >> 6); F.vcu = v; F.G = g; F.bx = b; return F;
}
template <int OFF> __device__ __forceinline__ const void* karg_ptr() {
    const void* p; auto ka = __builtin_amdgcn_kernarg_segment_ptr();
    asm volatile("s_load_dwordx2 %0, %1, %2\n\ts_waitcnt lgkmcnt(0)" : "=s"(p) : "s"(ka), "i"(OFF) : "memory");
#if defined(__HIP_DEVICE_COMPILE__)
    __builtin_assume(!__builtin_amdgcn_is_shared(p)); __builtin_assume(!__builtin_amdgcn_is_private(p));
#endif
    return p;
}
#define KIN(i) ((const GAS float*)karg_ptr<8 * (i)>())
#define KOUT() ((GAS float*)karg_ptr<144>())
#define KWS() ((GAS unsigned char*)karg_ptr<152>())
static_assert(offsetof(Args, out) == 144 && offsetof(Args, ws) == 152 && offsetof(Args, ph_lo) == 160, "Args layout");

__device__ __forceinline__ void transpose_item(const GAS float* W, int K, int N, GAS bf16_t* WT, int drow0, LAS float* scr, int kb, int nb, int lane, int f8 = 0, float wq = 0.f) {
    const int k0 = 64 * kb, n0 = 32 * nb;
    { const int n4 = lane & 7, kr = lane >> 3; const GAS float* src = W + (size_t)(k0 + kr) * N + n0 + 4 * n4; f32x4 v[8];
#pragma unroll
      for (int i = 0; i < 8; ++i) v[i] = __builtin_nontemporal_load((const GAS f32x4*)(src + (size_t)(8 * i) * N));
#pragma unroll
      for (int i = 0; i < 8; ++i) { LAS float* d = scr + (8 * i + kr) * 33 + 4 * n4; d[0] = v[i][0]; d[1] = v[i][1]; d[2] = v[i][2]; d[3] = v[i][3]; } }
    LDS_WAIT(); asm volatile("" ::: "memory");
    const int c = lane & 7;
#pragma unroll
    for (int j = 0; j < 4; ++j) { const int n = (lane >> 3) + 8 * j; const LAS float* s = scr + (8 * c) * 33 + n;
        if (f8 == 2) {
            unsigned lo_ = 0, hi_ = 0;
            lo_ = __builtin_amdgcn_cvt_pk_fp8_f32(f8c(s[0 * 33] * wq), f8c(s[1 * 33] * wq), lo_, false); lo_ = __builtin_amdgcn_cvt_pk_fp8_f32(f8c(s[2 * 33] * wq), f8c(s[3 * 33] * wq), lo_, true);
            hi_ = __builtin_amdgcn_cvt_pk_fp8_f32(f8c(s[4 * 33] * wq), f8c(s[5 * 33] * wq), hi_, false); hi_ = __builtin_amdgcn_cvt_pk_fp8_f32(f8c(s[6 * 33] * wq), f8c(s[7 * 33] * wq), hi_, true);
            *(GAS u32x2*)((GAS unsigned char*)WT + (size_t)(drow0 + n) * K + k0 + 8 * c) = (u32x2){lo_, hi_}; continue; }
        if (f8) {
            const unsigned lo_ = pk_i8(s[0 * 33], s[1 * 33], s[2 * 33], s[3 * 33], wq), hi_ = pk_i8(s[4 * 33], s[5 * 33], s[6 * 33], s[7 * 33], wq);
            *(GAS u32x2*)((GAS unsigned char*)WT + (size_t)(drow0 + n) * K + k0 + 8 * c) = (u32x2){lo_, hi_}; continue; }
        u32x4 o; o.x = pk2(s[0 * 33], s[1 * 33]); o.y = pk2(s[2 * 33], s[3 * 33]); o.z = pk2(s[4 * 33], s[5 * 33]); o.w = pk2(s[6 * 33], s[7 * 33]);
        *(GAS u32x4*)(WT + (size_t)(drow0 + n) * K + k0 + 8 * c) = o; }
    LDS_WAIT(); asm volatile("" ::: "memory");
}
__device__ __forceinline__ void sincos_d(double a, float& sn, float& cs) {
    const double kf = __builtin_rint(a * 0.63661977236758134308);
    const double r = (a - kf * 1.57079632679489655800) - kf * 6.123233995736766036e-17;
    const double r2 = r * r;
    double s = r * (1.0 + r2 * (-1.0 / 6 + r2 * (1.0 / 120 + r2 * (-1.0 / 5040 + r2 * (1.0 / 362880 + r2 * (-1.0 / 39916800 + r2 * (1.0 / 6227020800.0)))))));
    double c = 1.0 + r2 * (-0.5 + r2 * (1.0 / 24 + r2 * (-1.0 / 720 + r2 * (1.0 / 40320 + r2 * (-1.0 / 3628800 + r2 * (1.0 / 479001600.0 + r2 * (-1.0 / 87178291200.0)))))));
    const int q = ((int)kf) & 3;
    const double ss = (q == 0) ? s : (q == 1) ? c : (q == 2) ? -s : -c;
    const double cc = (q == 0) ? c : (q == 1) ? -s : (q == 2) ? -c : s;
    sn = (float)ss; cs = (float)cc;
}
__device__ __forceinline__ void phase_w0a(Frame& F) {
    LAS float* scr = (LAS float*)(F.lds + F.wave * 16384); GAS unsigned char* ws = KWS();
    const int gw = F.vcu * NWAVES + F.wave, NGW = F.G * NWAVES; constexpr int I_KV = (D / 64) * (2048 / 32);
    for (int it = gw; it < DEPTH * I_KV; it += NGW) { const int l = it / I_KV, r = it % I_KV, nblk = 2048 / 32;
        transpose_item(KIN(6) + (size_t)l * D * 2048, D, 2048, (GAS bf16_t*)(ws + WS_WKV) + (size_t)l * 2048 * D, 32 * (r % nblk), scr, r / nblk, r % nblk, F.lane); }
    const size_t gt = (size_t)F.vcu * 512 + F.tid, GT = (size_t)F.G * 512;
    for (int l = 0; l < DEPTH; ++l) { const GAS f32x4* wv = (const GAS f32x4*)(KIN(2) + (size_t)l * D * INW); float mx = 0.f;
        for (size_t i = gt; i < (size_t)D * INW / 64; i += GT) { const f32x4 v = __builtin_nontemporal_load(wv + i * 16); mx = fmaxf(fmaxf(mx, fmaxf(fabsf(v.x), fabsf(v.y))), fmaxf(fabsf(v.z), fabsf(v.w))); }
        mx = wave_max(mx); if (F.lane == 0) (void)__hip_atomic_fetch_max((GAS unsigned*)(ws + WS_CTL) + CW_WMAX + l, __float_as_uint(mx), __ATOMIC_RELAXED, __HIP_MEMORY_SCOPE_AGENT); }
    { const GAS f32x4* x = (const GAS f32x4*)KIN(1); GAS u32x4* xb = (GAS u32x4*)(ws + WS_MEMB);
      for (size_t i = gt; i < (size_t)2048 * D / 8; i += GT) { const f32x4 a = x[2 * i], b = x[2 * i + 1]; u32x4 o; o.x = pk2(a.x, a.y); o.y = pk2(a.z, a.w); o.z = pk2(b.x, b.y); o.w = pk2(b.z, b.w); xb[i] = o; } }
}
constexpr int KV_WGS = 64;
__device__ __forceinline__ void phase_w(Frame& F, int l) {
    LAS float* scr = (LAS float*)(F.lds + F.wave * 16384);
    GAS unsigned char* ws = KWS();
    const GAS float* w_in = KIN(2) + (size_t)l * D * INW; const GAS float* p_moba = KIN(3) + (size_t)l * 1024 * D; const GAS float* p_ret = KIN(4) + (size_t)l * 2048 * D;
    const GAS float* p_mem = KIN(5) + (size_t)l * 1024 * D; const GAS float* w_o = KIN(7) + (size_t)l * D * D;
    const GAS float* w_gu = KIN(14) + (size_t)l * NEXP * D * 1024; const GAS float* w_dn = KIN(15) + (size_t)l * NEXP * EFF * D;
    constexpr int I_IN = (D / 64) * (INW / 32), I_PM = (1024 / 64) * (D / 32), I_PR = (2048 / 64) * (D / 32), I_PE = I_PM, I_WO = (D / 64) * (D / 32);
    constexpr int I_GU1 = (D / 64) * (1024 / 32), I_GU = NEXP * I_GU1, I_DN1 = (EFF / 64) * (D / 32), I_DN = NEXP * I_DN1;
    constexpr int NITEMS = I_IN + I_PM + I_PR + I_PE + I_WO + I_GU + I_DN;
    const float wmax_in = fmaxf(WQ_RANGE * __uint_as_float(xb_ld((GAS unsigned*)(ws + WS_CTL) + CW_WMAX + l)), 1e-30f), wq_in = 127.0f / wmax_in;
    const bool skew = (F.G > KV_WGS); const int NA = skew ? (int)(0.77f * NITEMS) : NITEMS;
    const int nA = (NA - (F.vcu * NWAVES + F.wave) + F.G * NWAVES - 1) / (F.G * NWAVES);
    const int gwB = (F.vcu - KV_WGS) * NWAVES + F.wave, NGWB = (F.G - KV_WGS) * NWAVES;
    const int nB = (skew && F.vcu >= KV_WGS) ? (NITEMS - NA - gwB + NGWB - 1) / NGWB : 0;
    for (int ii = 0; ii < nA + nB; ++ii) {
        int r = ii < nA ? (F.vcu * NWAVES + F.wave) + ii * (F.G * NWAVES) : NA + gwB + (ii - nA) * NGWB;
        if (r < I_IN) { const int nblk = INW / 32, nb_ = r % nblk;
            transpose_item(w_in, D, INW, (GAS bf16_t*)(ws + WS_WIN8), 32 * nb_, scr, r / nblk, nb_, F.lane, 1, wq_in); continue; } r -= I_IN;
        if (r < I_PM) { const int nblk = D / 32; transpose_item(p_moba, 1024, D, (GAS bf16_t*)(ws + WS_WPM), 32 * (r % nblk), scr, r / nblk, r % nblk, F.lane, 2, GATE_WSCALE); continue; } r -= I_PM;
        if (r < I_PR) { const int nblk = D / 32; transpose_item(p_ret, 2048, D, (GAS bf16_t*)(ws + WS_WPR), 32 * (r % nblk), scr, r / nblk, r % nblk, F.lane, 2, GATE_WSCALE); continue; } r -= I_PR;
        if (r < I_PE) { const int nblk = D / 32; transpose_item(p_mem, 1024, D, (GAS bf16_t*)(ws + WS_WPE), 32 * (r % nblk), scr, r / nblk, r % nblk, F.lane, 2, GATE_WSCALE); continue; } r -= I_PE;
        if (r < I_WO) { const int nblk = D / 32; transpose_item(w_o, D, D, (GAS bf16_t*)(ws + WS_WO), 32 * (r % nblk), scr, r / nblk, r % nblk, F.lane); continue; } r -= I_WO;
        if (r < I_GU) { const int e = r / I_GU1, q = r % I_GU1, nblk = 1024 / 32, nb = q % nblk, kb = q / nblk; const int n0 = 32 * nb;
            const int f = n0 & 511, drow = 256 * (f >> 7) + (f & 127) + ((n0 >= 512) ? 128 : 0);
            transpose_item(w_gu + (size_t)e * D * 1024, D, 1024, (GAS bf16_t*)(ws + WS_WGU) + (size_t)e * 1024 * D, drow, scr, kb, nb, F.lane); continue; } r -= I_GU;
        { const int e = r / I_DN1, q = r % I_DN1, nblk = D / 32; transpose_item(w_dn + (size_t)e * EFF * D, EFF, D, (GAS bf16_t*)(ws + WS_WDN + (size_t)e * D * EFF), 32 * (q % nblk), scr, q / nblk, q % nblk, F.lane, 2, GATE_WSCALE); }
    }
    { const GAS float* wg = KIN(10) + (size_t)l * D * 4; const GAS float* we = KIN(12) + (size_t)l * D * NEXP;
      const GAS float* g1 = KIN(8) + (size_t)l * D; const GAS float* b1 = KIN(9) + (size_t)l * D; const GAS float* bg = KIN(11) + (size_t)l * 4; const GAS float* be = KIN(13) + (size_t)l * NEXP;
      GAS bf16_t* wgh = (GAS bf16_t*)(ws + WS_WRT); GAS bf16_t* wgl = (GAS bf16_t*)(ws + WS_WRT + WRT_GL); GAS float* csp = (GAS float*)(ws + WS_WRT + WRT_CS); GAS float* c0p = (GAS float*)(ws + WS_WRT + WRT_C0);
      const int c = F.G * NWAVES - 1 - (F.vcu * NWAVES + F.wave);
      if (c < 48) { float s_cs = 0.f, s_c0 = 0.f;
          for (int i = 0; i < D / 64; ++i) { const int k = F.lane + 64 * i; const float w = c < 4 ? wg[k * 4 + c] : (c < 36 ? we[k * NEXP + (c - 4)] : 0.f);
              const float v = g1[k] * w; const unsigned hi = pk2(v, 0.f) & 0xffffu; const float hf = bf_lo(hi); const unsigned lo = pk2(v - hf, 0.f) & 0xffffu;
              wgh[(size_t)c * D + k] = (bf16_t)hi; wgl[(size_t)c * D + k] = (bf16_t)lo; s_cs += hf + bf_lo(lo); s_c0 += b1[k] * w; }
          s_cs = wave_sum(s_cs); s_c0 = wave_sum(s_c0);
          if (F.lane == 0) { csp[c] = s_cs; c0p[c] = s_c0 + (c < 4 ? bg[c] : (c < 36 ? be[c - 4] : 0.f)); } } }
    if (l == 0) {
        const size_t gt = (size_t)F.vcu * 512 + F.tid, GT = (size_t)F.G * 512;
        { const GAS float* x = KIN(0); GAS bf16_t* xb = (GAS bf16_t*)(ws + WS_XB); GAS unsigned char* xb8 = (GAS unsigned char*)(ws + WS_XB8); GAS float* xs = (GAS float*)(ws + WS_XS);
          for (int row = F.vcu * NWAVES + F.wave; row < T; row += F.G * NWAVES) { f32x4 v[8]; float mx = 0.f;
#pragma unroll
              for (int j = 0; j < 8; ++j) { v[j] = __builtin_nontemporal_load((const GAS f32x4*)(x + (size_t)row * D + 4 * F.lane + 256 * j)); mx = fmaxf(fmaxf(mx, fmaxf(fabsf(v[j][0]), fabsf(v[j][1]))), fmaxf(fabsf(v[j][2]), fabsf(v[j][3]))); }
              mx = fmaxf(wave_max(mx), 1e-30f); const float q = 127.0f / mx; if (F.lane == 0) xs[row] = mx * (1.0f / 127.0f);
#pragma unroll
              for (int j = 0; j < 8; ++j) { const size_t c = 4 * F.lane + 256 * j; u32x2 wv; wv.x = pk2(v[j][0], v[j][1]); wv.y = pk2(v[j][2], v[j][3]); *(GAS u32x2*)(xb + (size_t)row * D + c) = wv;
                  *(GAS unsigned*)(xb8 + (size_t)row * D + c) = pk_i8(v[j][0], v[j][1], v[j][2], v[j][3], q); } } }
        { GAS float* ct = (GAS float*)(ws + WS_ROPE); GAS float* st = ct + 2048 * 128;
          for (size_t i = gt; i < (size_t)2048 * 128; i += GT) { const int pos = (int)(i >> 7), j = (int)(i & 127);
              double inv = 1.0, rp = 0.9300449458481392; int e = j;
#pragma unroll
              for (int b = 0; b < 7; ++b) { if (e & 1) inv *= rp; rp *= rp; e >>= 1; }
              float sn, cs; sincos_d((double)pos * inv, sn, cs); ct[i] = cs; st[i] = sn; } }
    }
}

using pg8::Unit;
struct SchedProj {
    static constexpr bool VARLD = false, GATHER = false, DEP = false, F8 = false, I8 = true; static constexpr unsigned LDA = 2048, LDB = 2048; static constexpr int KK = 1024;
    const GAS char* xb; const GAS char* win; int G, c, mode;
    __device__ __forceinline__ bool next(int i, Unit& u) const {
        const int L = i * G + c; const int nN = mode ? 12 : 52, nmain = 64 * nN;
        u.gather = nullptr; u.nvalid = 256; u.aux = 0;
        if (L < nmain) { int pm, j; pg8::static_tile(L, 64, nN, pm, j);
            int pn; if (mode) pn = j < 4 ? 8 + j : 16 + j; else pn = j < 8 ? j : (j < 16 ? j + 4 : j + 12);
            u.pm = pm; u.pn = pn; u.A = xb + (size_t)pm * 256 * 2048; u.B = win + (size_t)pn * 256 * 2048; return true; }
        return false;
    }
};
struct SchedGate {
    static constexpr bool VARLD = false, GATHER = false, DEP = false, F8 = true, I8 = false; static constexpr unsigned LDA = 2048, LDB = 2048; static constexpr int KK = 1024;
    const GAS char* xb8; const GAS char* win8; int G, c;
    __device__ __forceinline__ bool next(int i, Unit& u) const {
        const int L = i * G + c; if (L >= 64 * (24 + NF8X)) return false;
        int pm, j; pg8::static_tile(L, 64, 24 + NF8X, pm, j);
        u.gather = nullptr; u.nvalid = 256; u.aux = 0; u.pm = pm; u.pn = j < 24 ? 40 + j : (j < 28 ? 12 + j : j - 28); u.A = xb8 + (size_t)pm * 256 * 2048;
        u.B = win8 + (size_t)(j < 24 ? 256 * j : 9216 + 256 * (j - 24)) * 2048; return true;
    }
};
struct SchedVT8 {
    static constexpr bool VARLD = false, GATHER = false, DEP = false, F8 = true, I8 = false; static constexpr unsigned LDA = 2048, LDB = 2048; static constexpr int KK = 1024;
    const GAS char* xb8; const GAS char* win8; int G, c;
    __device__ __forceinline__ bool next(int i, Unit& u) const {
        const int L = i * G + c; if (L >= 64 * 12) return false;
        int pm, j; pg8::static_tile(L, 64, 12, pm, j);
        u.gather = nullptr; u.nvalid = 256; u.aux = 0; u.pm = pm; u.pn = j < 4 ? 8 + j : 16 + j; u.A = xb8 + (size_t)pm * 256 * 2048; u.B = win8 + (size_t)(6144 + 256 * j) * 2048; return true;
    }
};
struct SchedKv {
    static constexpr bool VARLD = false, GATHER = false, DEP = false, F8 = false, I8 = false; static constexpr unsigned LDA = 4096, LDB = 4096; static constexpr int KK = 2048;
    const GAS char* memb; const GAS char* wkv; int c;
    __device__ __forceinline__ bool next(int i, Unit& u) const {
        if (i > 0 || c >= 64) return false; const int q = c;
        u.gather = nullptr; u.nvalid = 256;
        if (q < 32) { u.aux = 1; u.pm = q >> 2; u.pn = q & 3; u.A = memb + (size_t)u.pm * 256 * 4096; u.B = wkv + (size_t)u.pn * 256 * 4096; }
        else { const int r = q - 32; u.aux = 2; u.pm = r >> 3; u.pn = r & 7; u.A = wkv + (size_t)(1024 + u.pm * 256) * 4096; u.B = memb + (size_t)u.pn * 256 * 4096; }
        return true;
    }
};
struct EpiProj {
    static constexpr bool PERM = true, KEEP = false;
    GAS unsigned char* ws; const GAS float* ropec; const GAS float* ropes;
    template <int MODE, bool I8 = false> __device__ __forceinline__ void store(const f32x4 (&acc)[2][2][4][2], GAS bf16_t* O, int ldc, int row0, int col0, float sc, int head, int wr, int wc, int fr, int fq, const GAS float* xs = nullptr, float wdq = 1.0f) const {
        const int r0 = row0 + wr * 64 + fr, c0 = col0 + wc * 32 + 8 * fq;
        float rq[2][4];
#pragma unroll
        for (int ai = 0; ai < 2; ++ai)
#pragma unroll
            for (int m = 0; m < 4; ++m) rq[ai][m] = I8 ? xs[r0 + ai * 128 + m * 16] * wdq : 1.0f;
#define ACCV(ai_, bj_, m_, n_) (I8 ? __builtin_convertvector(__builtin_bit_cast(v4i32, acc[ai_][bj_][m_][n_]), f32x4) * rq[ai_][m_] : acc[ai_][bj_][m_][n_])
        float lg = 0.f; if ((MODE == 3 || MODE == 4)) lg = log2f(1.0f - exp2f(-5.0f - (float)head));
#pragma unroll
        for (int ai = 0; ai < 2; ++ai) {
            if ((MODE == 3 || MODE == 4)) {
#pragma unroll
                for (int mh = 0; mh < 2; ++mh) {
                f32x4 cA[2], cB[2], sA[2], sB[2];
#pragma unroll
                for (int m2 = 0; m2 < 2; ++m2) { const int m = 2 * mh + m2; const int pos = (r0 + ai * 128 + m * 16) & (SEQ - 1); const GAS float* cp = ropec + pos * 128 + wc * 32 + 8 * fq; const GAS float* sp = ropes + pos * 128 + wc * 32 + 8 * fq;
                    cA[m2] = *(const GAS f32x4*)(cp); cB[m2] = *(const GAS f32x4*)(cp + 4); sA[m2] = *(const GAS f32x4*)(sp); sB[m2] = *(const GAS f32x4*)(sp + 4); }
#pragma unroll
                for (int m2 = 0; m2 < 2; ++m2) { const int m = 2 * mh + m2; const int row = r0 + ai * 128 + m * 16; GAS bf16_t* rowp = O + (size_t)row * ldc + c0;
                    const int pos = row & (SEQ - 1); const float e = (float)(pos & 255) * lg;
                    const float rs = (MODE == 3) ? fast_exp2(e) : 0.0625f * fast_exp2(-e);
                    const f32x4 x1a = ACCV(ai, 0, m, 0), x1b = ACCV(ai, 0, m, 1), x2a = ACCV(ai, 1, m, 0), x2b = ACCV(ai, 1, m, 1);
                    const f32x4 o1a = (x1a * cA[m2] - x2a * sA[m2]) * rs, o1b = (x1b * cB[m2] - x2b * sB[m2]) * rs, o2a = (x1a * sA[m2] + x2a * cA[m2]) * rs, o2b = (x1b * sB[m2] + x2b * cB[m2]) * rs;
                    u32x4 w; w.x = pk2(o1a[0], o1a[1]); w.y = pk2(o1a[2], o1a[3]); w.z = pk2(o1b[0], o1b[1]); w.w = pk2(o1b[2], o1b[3]); *(GAS u32x4*)(rowp) = w;
                    w.x = pk2(o2a[0], o2a[1]); w.y = pk2(o2a[2], o2a[3]); w.z = pk2(o2b[0], o2b[1]); w.w = pk2(o2b[2], o2b[3]); *(GAS u32x4*)(rowp + 128) = w; }
                asm volatile("" ::: "memory"); }
                asm volatile("" ::: "memory");
            } else {
#pragma unroll
                for (int m = 0; m < 4; ++m) { const int row = r0 + ai * 128 + m * 16; GAS bf16_t* rowp = O + (size_t)row * ldc + c0;
                    if (MODE == 5) {
                        u32x2 wq[2];
#pragma unroll
                        for (int bj = 0; bj < 2; ++bj) { const f32x4 v0 = ACCV(ai, bj, m, 0), v1 = ACCV(ai, bj, m, 1); wq[bj] = (u32x2){0u, 0u};
#pragma unroll
                            for (int jj = 0; jj < 4; ++jj) { wq[bj].x = __builtin_amdgcn_cvt_pk_u8_f32(fminf(__builtin_truncf(sigmoidf_(v0[jj] * sc) * 256.0f), 255.0f), jj, wq[bj].x); wq[bj].y = __builtin_amdgcn_cvt_pk_u8_f32(fminf(__builtin_truncf(sigmoidf_(v1[jj] * sc) * 256.0f), 255.0f), jj, wq[bj].y); } }
                        const auto sx_ = __builtin_amdgcn_permlane16_swap(wq[0].x, wq[1].x, false, false), sy_ = __builtin_amdgcn_permlane16_swap(wq[0].y, wq[1].y, false, false);
                        const int ce_ = (fq & 1) ? c0 - 8 + 128 : c0;
                        *(GAS u32x4*)((GAS unsigned char*)O + (size_t)row * ldc + ce_) = (u32x4){sx_[0], sy_[0], sx_[1], sy_[1]}; continue; }
#pragma unroll
                    for (int bj = 0; bj < 2; ++bj) { f32x4 v0 = ACCV(ai, bj, m, 0), v1 = ACCV(ai, bj, m, 1);
                        if (MODE == 0) { v0 = v0 * sc; v1 = v1 * sc; }
                        if (MODE == 1) {
#pragma unroll
                            for (int j = 0; j < 4; ++j) { v0[j] = v0[j] * sigmoidf_(v0[j]); v1[j] = v1[j] * sigmoidf_(v1[j]); } }
                        if (MODE == 2) {
#pragma unroll
                            for (int j = 0; j < 4; ++j) { v0[j] = sigmoidf_(v0[j]); v1[j] = sigmoidf_(v1[j]); } }
                        if (MODE == 5) {
                            u32x2 wq = {0u, 0u};
#pragma unroll
                            for (int j = 0; j < 4; ++j) { wq.x = __builtin_amdgcn_cvt_pk_u8_f32(fminf(__builtin_truncf(sigmoidf_(v0[j] * sc) * 256.0f), 255.0f), j, wq.x); wq.y = __builtin_amdgcn_cvt_pk_u8_f32(fminf(__builtin_truncf(sigmoidf_(v1[j] * sc) * 256.0f), 255.0f), j, wq.y); }
                            *(GAS u32x2*)((GAS unsigned char*)O + (size_t)row * ldc + c0 + bj * 128) = wq; continue; }
                        u32x4 w; w.x = pk2(v0[0], v0[1]); w.y = pk2(v0[2], v0[3]); w.z = pk2(v1[0], v1[1]); w.w = pk2(v1[2], v1[3]);
                        if (MODE == 6) {
                            GAS bf16_t* gp = rowp + bj * 128 - 8 * (fq & 1) + 4 * (fq & 1); *(GAS u32x2*)(gp) = (u32x2){w.x, w.y}; *(GAS u32x2*)(gp + 8) = (u32x2){w.z, w.w}; continue; }
                        *(GAS u32x4*)(rowp + bj * 128) = w; } } } }
#undef ACCV
    }
    __device__ __forceinline__ void operator()(const f32x4 (&acc)[2][2][4][2], const Unit& u, int wr, int wc, int fr, int fq) const {
        const int row0 = u.pm * 256, pn = u.pn;
        if (u.aux == 1) { store<0>(acc, (GAS bf16_t*)(ws + WS_KM), 1024, row0, pn * 256, 1.0f, 0, wr, wc, fr, fq); return; }
        if (u.aux == 2) { store<6>(acc, (GAS bf16_t*)(ws + WS_VMT), 2048, row0, pn * 256, 1.0f, 0, wr, wc, fr, fq); return; }
        if (pn < 4) store<0>(acc, (GAS bf16_t*)(ws + WS_AQ), 1024, row0, pn * 256, 0.08838834764831845f * LOG2E, 0, wr, wc, fr, fq);
        else if (pn < 8) store<0>(acc, (GAS bf16_t*)(ws + WS_AK), 1024, row0, (pn - 4) * 256, 1.0f, 0, wr, wc, fr, fq);
        else if (pn < 16) store<3>(acc, (GAS bf16_t*)(ws + WS_RQ), 1024, row0, (pn - 12) * 256, 1.0f, pn - 12, wr, wc, fr, fq);
        else if (pn < 20) store<4>(acc, (GAS bf16_t*)(ws + WS_RK), 1024, row0, (pn - 16) * 256, 1.0f, pn - 16, wr, wc, fr, fq);
        else if (pn < 36) store<1>(acc, (GAS bf16_t*)(ws + WS_RGS), 2048, row0, (pn - 28) * 256, 1.0f, 0, wr, wc, fr, fq);
        else if (pn < 40) store<0>(acc, (GAS bf16_t*)(ws + WS_MQ), 1024, row0, (pn - 36) * 256, 0.0625f * LOG2E, 0, wr, wc, fr, fq);
        else if (pn < 48) store<5>(acc, (GAS bf16_t*)(ws + WS_SGA), 2048, row0, (pn - 40) * 256, 1.0f / GATE_WSCALE, 0, wr, wc, fr, fq);
        else if (pn < 56) store<5>(acc, (GAS bf16_t*)(ws + WS_SGR), 2048, row0, (pn - 48) * 256, 1.0f / GATE_WSCALE, 0, wr, wc, fr, fq);
        else store<5>(acc, (GAS bf16_t*)(ws + WS_SGM), 2048, row0, (pn - 56) * 256, 1.0f / GATE_WSCALE, 0, wr, wc, fr, fq);
    }
};
struct EpiProjQ {
    static constexpr bool PERM = true, KEEP = false;
    EpiProj P; const GAS float* xs; float wdq;
    __device__ __forceinline__ void operator()(const f32x4 (&acc)[2][2][4][2], const Unit& u, int wr, int wc, int fr, int fq) const {
        const int row0 = u.pm * 256, pn = u.pn; GAS unsigned char* ws = P.ws;
        if (pn < 4) P.template store<0, true>(acc, (GAS bf16_t*)(ws + WS_AQ), 1024, row0, pn * 256, 0.08838834764831845f * LOG2E, 0, wr, wc, fr, fq, xs, wdq);
        else if (pn < 8) P.template store<0, true>(acc, (GAS bf16_t*)(ws + WS_AK), 1024, row0, (pn - 4) * 256, 1.0f, 0, wr, wc, fr, fq, xs, wdq);
        else if (pn < 16) P.template store<3, true>(acc, (GAS bf16_t*)(ws + WS_RQ), 1024, row0, (pn - 12) * 256, 1.0f, pn - 12, wr, wc, fr, fq, xs, wdq);
        else if (pn < 20) P.template store<4, true>(acc, (GAS bf16_t*)(ws + WS_RK), 1024, row0, (pn - 16) * 256, 1.0f, pn - 16, wr, wc, fr, fq, xs, wdq);
        else if (pn < 36) P.template store<1, true>(acc, (GAS bf16_t*)(ws + WS_RGS), 2048, row0, (pn - 28) * 256, 1.0f, 0, wr, wc, fr, fq, xs, wdq);
        else if (pn < 40) P.template store<0, true>(acc, (GAS bf16_t*)(ws + WS_MQ), 1024, row0, (pn - 36) * 256, 0.0625f * LOG2E, 0, wr, wc, fr, fq, xs, wdq);
        else { const int g = pn - 40; P.template store<5, true>(acc, (GAS bf16_t*)(ws + WS_SGA + (size_t)(g >> 3) * (64 * MiB)), 2048, row0, (g & 7) * 256, 1.0f, 0, wr, wc, fr, fq, xs, wdq); }
    }
};
struct EpiGate {
    static constexpr bool PERM = true, KEEP = false;
    EpiProj P;
    __device__ __forceinline__ void operator()(const f32x4 (&acc)[2][2][4][2], const Unit& u, int wr, int wc, int fr, int fq) const {
        if (u.pn < 4) { P.template store<0>(acc, (GAS bf16_t*)(P.ws + WS_AQ), 1024, u.pm * 256, u.pn * 256, 0.08838834764831845f * LOG2E / GATE_WSCALE, 0, wr, wc, fr, fq); return; }
        if (u.pn < 8) { P.template store<0>(acc, (GAS bf16_t*)(P.ws + WS_AK), 1024, u.pm * 256, (u.pn - 4) * 256, 1.0f / GATE_WSCALE, 0, wr, wc, fr, fq); return; }
        if (u.pn < 40) { P.template store<0>(acc, (GAS bf16_t*)(P.ws + WS_MQ), 1024, u.pm * 256, (u.pn - 36) * 256, 0.0625f * LOG2E / GATE_WSCALE, 0, wr, wc, fr, fq); return; }
        const int g = u.pn - 40;
        P.template store<5>(acc, (GAS bf16_t*)(P.ws + WS_SGA + (size_t)(g >> 3) * (64 * MiB)), 2048, u.pm * 256, (g & 7) * 256, 1.0f / GATE_WSCALE, 0, wr, wc, fr, fq);
    }
};
struct EpiProjT {
    static constexpr bool PERM = false, KEEP = false;
    GAS unsigned char* ws; float sc; const GAS float* xs;
    __device__ __forceinline__ void operator()(const f32x4 (&acc)[2][2][4][2], const Unit& u, int wr, int wc, int fr, int fq) const {
        const int pn = u.pn; const bool isav = pn < 12; const int ncols = isav ? 1024 : 2048; const int colt = isav ? (pn - 8) * 256 : (pn - 20) * 256;
        GAS bf16_t* base = (GAS bf16_t*)(ws + (isav ? WS_AVT : WS_RVT)) + (size_t)(u.pm >> 3) * ncols * SEQ;
        const int fqp = isav ? ((fq == 1) ? 2 : ((fq == 2) ? 1 : fq)) : fq;
        const int sbase = (u.pm & 7) * 256 + wr * 64, c0 = colt + wc * 32 + fr; (void)fqp;
#pragma unroll
        for (int ai = 0; ai < 2; ++ai)
#pragma unroll
            for (int bj = 0; bj < 2; ++bj)
#pragma unroll
                for (int m = 0; m < 4; ++m) { u32x2 w[2];
                    const f32x4 rs4 = *(const GAS f32x4*)(xs + u.pm * 256 + wr * 64 + 4 * fq + ai * 128 + m * 16);
#pragma unroll
                    for (int n = 0; n < 2; ++n) { const f32x4 v = __builtin_convertvector(__builtin_bit_cast(v4i32, acc[ai][bj][m][n]), f32x4) * rs4 * sc; w[n].x = pk2(v[0], v[1]); w[n].y = pk2(v[2], v[3]); }
                    u32x4 ww; int nsel, sb;
                    if (isav) { const auto sx_ = __builtin_amdgcn_permlane32_swap(w[0].x, w[1].x, false, false), sy_ = __builtin_amdgcn_permlane32_swap(w[0].y, w[1].y, false, false);
                        ww = (u32x4){sx_[0], sy_[0], sx_[1], sy_[1]}; nsel = fq >> 1; sb = 8 * (fq & 1); }
                    else { const auto sx_ = __builtin_amdgcn_permlane16_swap(w[0].x, w[1].x, false, false), sy_ = __builtin_amdgcn_permlane16_swap(w[0].y, w[1].y, false, false);
                        ww = (u32x4){sx_[0], sy_[0], sx_[1], sy_[1]}; nsel = fq & 1; sb = 4 * (fq & ~1); }
                    *(GAS u32x4*)(base + (size_t)(c0 + bj * 128 + nsel * 16) * SEQ + sbase + sb + ai * 128 + m * 16) = ww; }
    }
};
struct SchedMerge {
    static constexpr bool VARLD = true, GATHER = false, DEP = false, F8 = true, I8 = false; static constexpr unsigned LDA = 0, LDB = 0; static constexpr int KK = 0;
    const GAS char* ya; const GAS char* yr; const GAS char* ym; const GAS char* wpm; const GAS char* wpr; const GAS char* wpe; int G, c;
    __device__ __forceinline__ bool next(int i, Unit& u) const {
        const int ti = i / 3, ord = i - 3 * ti;
        const int br = (c & 1) ? (ord == 0 ? 0 : (ord == 1 ? 2 : 1)) : (ord == 0 ? 1 : (ord == 1 ? 0 : 2));
        const int L = ti * G + c; if (L >= 512) return false;
        int pm, pn; pg8::static_tile(L, 64, 8, pm, pn); u.pm = pm; u.pn = pn; const int ordn = ord + 1, brn = (c & 1) ? (ordn == 1 ? 2 : 1) : (ordn == 1 ? 0 : 2); u.aux = br + 4 * ord + 16 * brn; u.gather = nullptr; u.nvalid = 256;
        if (br == 0) { u.K = 512; u.lda = 1024; u.ldb = 1024; u.A = ya + (size_t)pm * 256 * 1024; u.B = wpm + (size_t)pn * 256 * 1024; }
        else if (br == 1) { u.K = 1024; u.lda = 2048; u.ldb = 2048; u.A = yr + (size_t)pm * 256 * 2048; u.B = wpr + (size_t)pn * 256 * 2048; }
        else { u.K = 512; u.lda = 1024; u.ldb = 1024; u.A = ym + (size_t)pm * 256 * 1024; u.B = wpe + (size_t)pn * 256 * 1024; }
        return true;
    }
};
struct EpiMerge {
    static constexpr bool PERM = true, KEEP = true;
    const GAS unsigned char* sga; GAS bf16_t* merged;
    __device__ __forceinline__ bool merge(f32x4 (&acc)[2][2][4][2], const Unit& u, int wr, int wc, int fr, int fq) const {
        const int br = u.aux & 3, ord = (u.aux >> 2) & 3, brn = u.aux >> 4;
        const GAS unsigned char* sg = sga + (size_t)br * (64 * MiB); const GAS unsigned char* sn = sga + (size_t)brn * (64 * MiB);
        const int r0 = u.pm * 256 + wr * 64 + fr, c0 = u.pn * 256 + wc * 32 + 8 * fq;
        if (ord < 2) {
#pragma unroll
            for (int ai = 0; ai < 2; ++ai) {
                u32x2 g[4][2], h[4][2];
#pragma unroll
                for (int m = 0; m < 4; ++m)
#pragma unroll
                    for (int bj = 0; bj < 2; ++bj) { const size_t off = (size_t)(r0 + ai * 128 + m * 16) * D + c0 + bj * 128; g[m][bj] = *(const GAS u32x2*)(sg + off); h[m][bj] = *(const GAS u32x2*)(sn + off); }
#pragma unroll
                for (int m = 0; m < 4; ++m)
#pragma unroll
                    for (int bj = 0; bj < 2; ++bj) { const u32x2 gg = g[m][bj], hh = h[m][bj];
#pragma unroll
                        for (int j = 0; j < 4; ++j) {
                            acc[ai][bj][m][0][j] *= ((float)((gg.x >> (8 * j)) & 0xffu) + 0.5f) * __builtin_amdgcn_rcpf((float)((hh.x >> (8 * j)) & 0xffu) + 0.5f);
                            acc[ai][bj][m][1][j] *= ((float)((gg.y >> (8 * j)) & 0xffu) + 0.5f) * __builtin_amdgcn_rcpf((float)((hh.y >> (8 * j)) & 0xffu) + 0.5f); } }
                asm volatile("" ::: "memory"); }
            return true;
        }
#pragma unroll
        for (int ai = 0; ai < 2; ++ai) {
            u32x2 g[4][2];
#pragma unroll
            for (int m = 0; m < 4; ++m)
#pragma unroll
                for (int bj = 0; bj < 2; ++bj) { const size_t off = (size_t)(r0 + ai * 128 + m * 16) * D + c0 + bj * 128; g[m][bj] = *(const GAS u32x2*)(sg + off); }
#pragma unroll
            for (int m = 0; m < 4; ++m)
#pragma unroll
                for (int bj = 0; bj < 2; ++bj) { const size_t off = (size_t)(r0 + ai * 128 + m * 16) * D + c0 + bj * 128; const u32x2 gg = g[m][bj];
                    f32x4 v0 = acc[ai][bj][m][0] * (1.0f / (256.0f * GATE_WSCALE * Y8_SCALE)), v1 = acc[ai][bj][m][1] * (1.0f / (256.0f * GATE_WSCALE * Y8_SCALE));
#pragma unroll
                    for (int j = 0; j < 4; ++j) { v0[j] *= (float)((gg.x >> (8 * j)) & 0xffu) + 0.5f; v1[j] *= (float)((gg.y >> (8 * j)) & 0xffu) + 0.5f; }
                    u32x4 w; w.x = pk2(v0[0], v0[1]); w.y = pk2(v0[2], v0[3]); w.z = pk2(v1[0], v1[1]); w.w = pk2(v1[2], v1[3]); *(GAS u32x4*)(merged + off) = w; }
            asm volatile("" ::: "memory"); }
        return false;
    }
};
struct SchedPlain {
    static constexpr bool VARLD = false, GATHER = false, DEP = false, F8 = false, I8 = false; static constexpr unsigned LDA = 4096, LDB = 4096; static constexpr int KK = 2048;
    const GAS char* A; const GAS char* B; int nM, nN, G, c;
    __device__ __forceinline__ bool next(int i, Unit& u) const {
        const int L = i * G + c; if (L >= nM * nN) return false;
        int pm, pn; pg8::static_tile(L, nM, nN, pm, pn); u.pm = pm; u.pn = pn; u.aux = 0; u.gather = nullptr; u.nvalid = 256;
        u.A = A + (size_t)pm * 256 * LDA; u.B = B + (size_t)pn * 256 * LDB; return true;
    }
};
struct EpiResid {
    static constexpr bool PERM = true, KEEP = false;
    const GAS bf16_t* xres; GAS bf16_t* out;
    __device__ __forceinline__ void operator()(const f32x4 (&acc)[2][2][4][2], const Unit& u, int wr, int wc, int fr, int fq) const {
        const int r0 = u.pm * 256 + wr * 64 + fr, c0 = u.pn * 256 + wc * 32 + 8 * fq;
#pragma unroll
        for (int ai = 0; ai < 2; ++ai) {
            u32x4 xv[4][2];
#pragma unroll
            for (int m = 0; m < 4; ++m)
#pragma unroll
                for (int bj = 0; bj < 2; ++bj) xv[m][bj] = *(const GAS u32x4*)(xres + (size_t)(r0 + ai * 128 + m * 16) * D + c0 + bj * 128);
#pragma unroll
            for (int m = 0; m < 4; ++m)
#pragma unroll
                for (int bj = 0; bj < 2; ++bj) { const size_t off = (size_t)(r0 + ai * 128 + m * 16) * D + c0 + bj * 128; const u32x4 x = xv[m][bj]; const f32x4 v0 = acc[ai][bj][m][0], v1 = acc[ai][bj][m][1];
                    u32x4 w; w.x = pk2(DN_ALPHA * bf_lo(x.x) + v0[0], DN_ALPHA * bf_hi(x.x) + v0[1]); w.y = pk2(DN_ALPHA * bf_lo(x.y) + v0[2], DN_ALPHA * bf_hi(x.y) + v0[3]);
                    w.z = pk2(DN_ALPHA * bf_lo(x.z) + v1[0], DN_ALPHA * bf_hi(x.z) + v1[1]); w.w = pk2(DN_ALPHA * bf_lo(x.w) + v1[2], DN_ALPHA * bf_hi(x.w) + v1[3]);
                    *(GAS u32x4*)(out + off) = w; }
            asm volatile("" ::: "memory"); }
    }
};
struct MoeTab { int ntiles; };
__device__ __forceinline__ void build_moe_tab(Frame& F, const GAS unsigned* cnt) {
    volatile LAS int* tab = (volatile LAS int*)(F.lds + LDS_TAB);
    if (F.tid == 0) { int rt = 0;
        for (int e = 0; e < NEXP; ++e) { const int c = (int)cnt[64 * e]; tab[576 + e] = c; const int nt = (c + 255) >> 8; for (int j = 0; j < nt && rt < 192; ++j) { tab[64 + rt] = e; tab[320 + rt] = 256 * j; ++rt; } }
        tab[0] = rt; }
    __syncthreads();
}
struct SchedMoe1 {
    static constexpr bool VARLD = false, GATHER = true, DEP = false, F8 = false, I8 = false; static constexpr unsigned LDA = 4096, LDB = 4096; static constexpr int KK = 2048;
    const GAS char* x1b; const GAS char* wgu; const GAS int* list; LAS int* tab; int G, c;
    __device__ __forceinline__ bool next(int i, Unit& u) const {
        const int L = i * G + c; const int RT = __builtin_amdgcn_readfirstlane(tab[0]); if (L >= RT * 4) return false;
        const int rt = L >> 2, pn = L & 3; const int e = __builtin_amdgcn_readfirstlane(tab[64 + rt]), r0 = __builtin_amdgcn_readfirstlane(tab[320 + rt]), cnt = __builtin_amdgcn_readfirstlane(tab[576 + e]);
        u.pm = rt; u.pn = pn; u.aux = e; u.A = x1b; u.B = wgu + ((size_t)e * 1024 + (size_t)pn * 256) * 4096;
        u.gather = list + (size_t)e * T + r0; u.nvalid = (cnt - r0) < 256 ? (cnt - r0) : 256; return true;
    }
};
struct EpiSwiglu {
    static constexpr bool PERM = true, KEEP = false;
    GAS bf16_t* hbuf; GAS unsigned* flag;
    __device__ __forceinline__ void operator()(const f32x4 (&acc)[2][2][4][2], const Unit& u, int wr, int wc, int fr, int fq) const {
        const int r0 = u.pm * 256 + wr * 64 + fr, c0 = u.pn * 128 + wc * 32 + 8 * fq;
#pragma unroll
        for (int ai = 0; ai < 2; ++ai)
#pragma unroll
            for (int m = 0; m < 4; ++m) { const f32x4 g0 = acc[ai][0][m][0], g1 = acc[ai][0][m][1], u0 = acc[ai][1][m][0], u1 = acc[ai][1][m][1]; float h[8];
#pragma unroll
                for (int j = 0; j < 4; ++j) { h[j] = g0[j] * sigmoidf_(g0[j]) * u0[j]; h[4 + j] = g1[j] * sigmoidf_(g1[j]) * u1[j]; }
                unsigned lo_ = 0, hi_ = 0; lo_ = __builtin_amdgcn_cvt_pk_fp8_f32(f8c(h[0]), f8c(h[1]), lo_, false); lo_ = __builtin_amdgcn_cvt_pk_fp8_f32(f8c(h[2]), f8c(h[3]), lo_, true); hi_ = __builtin_amdgcn_cvt_pk_fp8_f32(f8c(h[4]), f8c(h[5]), hi_, false); hi_ = __builtin_amdgcn_cvt_pk_fp8_f32(f8c(h[6]), f8c(h[7]), hi_, true);
                { GAS unsigned long long* hp_ = (GAS unsigned long long*)((GAS unsigned char*)hbuf + (size_t)(r0 + ai * 128 + m * 16) * EFF + c0);
                  __hip_atomic_store(hp_, ((unsigned long long)hi_ << 32) | lo_, __ATOMIC_RELAXED, __HIP_MEMORY_SCOPE_AGENT); } }
        asm volatile("s_waitcnt vmcnt(0)" ::: "memory");
        if ((threadIdx.x & 63) == 0) (void)xb_add(flag + 16 * u.pm, 1u);
    }
};
constexpr int MOE_ADV = 4;
struct SchedMoe2 {
    static constexpr bool VARLD = false, GATHER = false, DEP = true, F8 = true, I8 = false; static constexpr unsigned LDA = 512, LDB = 512; static constexpr int KK = 256;
    const GAS char* hbuf; const GAS char* wdn; const GAS int* list; LAS int* tab; int G, c; GAS unsigned* flag;
    __device__ __forceinline__ bool next(int i, Unit& u) const {
        const int RT = __builtin_amdgcn_readfirstlane(tab[0]); const int n6 = RT * 4, n7 = RT * 8, h = n6 % G, nlow = G - h;
        int L;
        if (h == 0) L = i * G + c;
        else if (c >= h) L = (i < MOE_ADV) ? i * nlow + (c - h) : MOE_ADV * nlow + (i - MOE_ADV) * G + c;
        else L = MOE_ADV * nlow + i * G + c;
        if (L >= n7) return false;
        const int rt = L >> 3, pn = L & 7; const int e = __builtin_amdgcn_readfirstlane(tab[64 + rt]), r0 = __builtin_amdgcn_readfirstlane(tab[320 + rt]), cnt = __builtin_amdgcn_readfirstlane(tab[576 + e]);
        u.pm = rt; u.pn = pn; u.aux = e; u.A = hbuf + (size_t)rt * 256 * 512; u.B = wdn + ((size_t)e * 2048 + (size_t)pn * 256) * 512;
        u.gather = list + (size_t)e * T + r0; u.nvalid = (cnt - r0) < 256 ? (cnt - r0) : 256; return true;
    }
    __device__ __forceinline__ void acquire(const Unit& u) const {
        GAS unsigned* f = flag + 16 * u.pm; unsigned sp = 0;
        while (xb_ld(f) < 32u) { __builtin_amdgcn_s_sleep(8); if (++sp > (1u << 21)) break; }
        asm volatile("" ::: "memory");
    }
};
struct EpiScatter {
    static constexpr bool PERM = true, KEEP = false;
    GAS bf16_t* yasg;
    __device__ __forceinline__ void operator()(const f32x4 (&acc)[2][2][4][2], const Unit& u, int wr, int wc, int fr, int fq) const {
        const int c0 = u.pn * 256 + wc * 32 + 8 * fq;
        int asgs[2][4];
#pragma unroll
        for (int ai = 0; ai < 2; ++ai)
#pragma unroll
            for (int m = 0; m < 4; ++m) { const int r = ai * 128 + wr * 64 + m * 16 + fr; asgs[ai][m] = (r < u.nvalid) ? u.gather[r] : 0; }
#pragma unroll
        for (int ai = 0; ai < 2; ++ai)
#pragma unroll
            for (int m = 0; m < 4; ++m) { const int r = ai * 128 + wr * 64 + m * 16 + fr;
                if (r < u.nvalid) { const int asg = asgs[ai][m]; GAS bf16_t* rowp = yasg + (size_t)asg * D + c0;
#pragma unroll
                    for (int bj = 0; bj < 2; ++bj) { const f32x4 v0 = acc[ai][bj][m][0] * (1.0f / GATE_WSCALE), v1 = acc[ai][bj][m][1] * (1.0f / GATE_WSCALE);
                        u32x4 w; w.x = pk2(v0[0], v0[1]); w.y = pk2(v0[2], v0[3]); w.z = pk2(v1[0], v1[1]); w.w = pk2(v1[2], v1[3]); *(GAS u32x4*)(rowp + bj * 128) = w; } } }
    }
};

struct FlashArgs {
    const GAS bf16_t* Q; int ldq; size_t qrow0; int qcol;
    const GAS bf16_t* K; int ldk; size_t krow0; int kcol;
    const GAS bf16_t* VT; size_t ldvt; size_t vrow0; size_t vcol0;
    GAS bf16_t* O; int ldo; int ocol;
    int qblk;
    GAS float* stat; float lg2g;
};
constexpr int FL_KBUF = 0, FL_VBUF = 65536, FL_PART = 98304, FL_KMEAN = 114688;
template <int MODE, int DK, int FABL = 0>
__device__ __forceinline__ void flash_unit(LAS unsigned char* lds, const FlashArgs& a, int tid) {
    asm volatile("" : "+v"(tid));
    const int lane = tid & 63, w = __builtin_amdgcn_readfirstlane(tid >> 6), l31 = lane & 31, h = lane >> 5;
    constexpr int CPR = DK / 8, NKL = (64 * CPR) / 512, KS = DK / 16, KROWB = DK * 2;
    constexpr int NDT = 4;
    const int nt = (MODE == 1) ? 4 : 4 * (a.qblk + 1);
    bf16x8 qf[KS];
    { const GAS bf16_t* qp = a.Q + (a.qrow0 + (size_t)(32 * w + l31)) * a.ldq + a.qcol + 8 * h;
#pragma unroll
      for (int ks = 0; ks < KS; ++ks) qf[ks] = *(const GAS bf16x8*)(qp + 16 * ks); }
    unsigned selmask = 0;
    if (MODE == 0) {
        const int qb = a.qblk;
        if (qb <= 3) selmask = (1u << qb) - 1u;
        else {
            const LAS float* km = (const LAS float*)(lds + FL_KMEAN);
            f32x16 g; for (int i = 0; i < 16; ++i) g[i] = 0.f;
            const int n = l31 & 7; const bool nv = l31 < 8;
#pragma unroll
            for (int ks = 0; ks < KS; ++ks) { const f32x4 x0 = *(const LAS f32x4*)(km + n * 128 + 16 * ks + 8 * h), x1 = *(const LAS f32x4*)(km + n * 128 + 16 * ks + 8 * h + 4);
                float xv[8] = {x0[0], x0[1], x0[2], x0[3], x1[0], x1[1], x1[2], x1[3]}; unsigned hi[4], lo[4];
#pragma unroll
                for (int j = 0; j < 4; ++j) { const float a0 = nv ? xv[2 * j] : 0.f, a1 = nv ? xv[2 * j + 1] : 0.f; hi[j] = pk2(a0, a1); lo[j] = pk2(a0 - bf_lo(hi[j]), a1 - bf_hi(hi[j])); }
                const bf16x8 ah = __builtin_bit_cast(bf16x8, (u32x4){hi[0], hi[1], hi[2], hi[3]}), al = __builtin_bit_cast(bf16x8, (u32x4){lo[0], lo[1], lo[2], lo[3]});
                g = __builtin_amdgcn_mfma_f32_32x32x16_bf16(ah, qf[ks], g, 0, 0, 0); g = __builtin_amdgcn_mfma_f32_32x32x16_bf16(al, qf[ks], g, 0, 0, 0); }
            float gt[8];
#pragma unroll
            for (int r = 0; r < 4; ++r) { const float mine = g[r], other = __shfl_xor(mine, 32); gt[r] = h ? other : mine; gt[4 + r] = h ? mine : other; }
#pragma unroll
            for (int rep = 0; rep < 3; ++rep) { float best = -3.0e38f; int bi = 0;
#pragma unroll
                for (int nn = 0; nn < 7; ++nn) { const bool ok = (nn < qb) && !((selmask >> nn) & 1u) && (gt[nn] > best); best = ok ? gt[nn] : best; bi = ok ? nn : bi; }
                selmask |= 1u << bi; }
        }
    }
    constexpr int RPP = 1024 / KROWB;
    const int k_rip = (lane * 16) / KROWB, k_cp = ((lane * 16) % KROWB) / 16;
    const int v_rip = lane >> 3, v_cp = lane & 7;
#define FL_TILE_KB(t) ((MODE == 0) ? ((t) < 4 ? 256 * a.qblk + 64 * (t) : 256 * (((t) - 4) >> 2) + 64 * (((t) - 4) & 3)) : 64 * (t))
#define FL_ISSUE(t, buf) do { const int kb_ = FL_TILE_KB(t); \
        _Pragma("unroll") for (int i = 0; i < NKL; ++i) { const int pidx = w + 8 * i, row = pidx * RPP + k_rip, c = k_cp ^ (row & 15); \
            __builtin_amdgcn_global_load_lds((const GAS unsigned*)(a.K + (a.krow0 + kb_ + row) * a.ldk + a.kcol + 8 * c), (LAS unsigned*)(lds + FL_KBUF + (buf) * 32768 + pidx * 1024), 16, 0, 0); } \
        _Pragma("unroll") for (int i = 0; i < 2; ++i) { const int pidx = w + 8 * i, row = pidx * 8 + v_rip, c = v_cp ^ ((row >> 1) & 7); \
            __builtin_amdgcn_global_load_lds((const GAS unsigned*)(a.VT + (a.vrow0 + row) * a.ldvt + a.vcol0 + kb_ + 8 * c), (LAS unsigned*)(lds + FL_VBUF + (buf) * 16384 + pidx * 1024), 16, 0, 0); } } while (0)
    f32x16 o[4];
#pragma unroll
    for (int dt = 0; dt < 4; ++dt)
#pragma unroll
        for (int i = 0; i < 16; ++i) o[dt][i] = 0.f;
    float mrun = -1.0e30f, lsum = 0.f;
    const int qloc = 32 * w + l31;
    int kbase[8], vbase[8], vb4[4];
    { const int x = l31 & 15, xs = (l31 >> 1) & 7;
#pragma unroll
      for (int kl = 0; kl < 8; ++kl) kbase[kl] = l31 * KROWB + (((2 * kl + h) ^ x) * 16);
#pragma unroll
      for (int cc = 0; cc < 8; ++cc) vbase[cc] = l31 * 128 + ((cc ^ xs) * 16) + 8 * h;
#pragma unroll
      for (int st = 0; st < 4; ++st) vb4[st] = l31 * 128 + (((2 * st + h) ^ xs) * 16); }
    FL_ISSUE(0, 0); VM_WAIT(); __syncthreads();
    for (int t = 0; t < nt; ++t) {
        if (t + 1 < nt && FABL != 4) FL_ISSUE(t + 1, (t + 1) & 1);
        bool need = true; int kind = 0; const int tt = t & 3; float tscale = 1.f; int blk = 0;
        if (MODE == 0) { if (t < 4) { kind = 1; need = (64 * tt <= 32 * w + 31); } else { kind = 2; blk = (t - 4) >> 2; need = __any((int)((selmask >> blk) & 1u)) != 0; } }
        if (MODE == 2) { const int J = t >> 2; if (J == a.qblk) { kind = 1; need = (64 * tt <= 32 * w + 31); } tscale = fast_exp2(a.lg2g * 256.0f * (float)(a.qblk - J)); }
        if (need) {
            const LAS unsigned char* kb = lds + FL_KBUF + (t & 1) * 32768; const LAS unsigned char* vb = lds + FL_VBUF + (t & 1) * 16384;
#define FL_KRD(k2, ks) (*(const LAS bf16x8*)(kb + kbase[(ks) & 7] + (32 * (k2)) * KROWB + ((ks) >> 3) * 256))
#define FL_QK(sv, k2) do { _Pragma("unroll") for (int i = 0; i < 16; ++i) sv[i] = 0.f; \
                bf16x8 f0 = FL_KRD(k2, 0), f1 = FL_KRD(k2, 1), f2 = FL_KRD(k2, 2), f3 = FL_KRD(k2, 3); \
                _Pragma("unroll") for (int ks = 0; ks < KS; ks += 4) { \
                    sv = __builtin_amdgcn_mfma_f32_32x32x16_bf16(f0, qf[ks], sv, 0, 0, 0);     if (ks + 4 < KS) f0 = FL_KRD(k2, ks + 4); \
                    sv = __builtin_amdgcn_mfma_f32_32x32x16_bf16(f1, qf[ks + 1], sv, 0, 0, 0); if (ks + 5 < KS) f1 = FL_KRD(k2, ks + 5); \
                    sv = __builtin_amdgcn_mfma_f32_32x32x16_bf16(f2, qf[ks + 2], sv, 0, 0, 0); if (ks + 6 < KS) f2 = FL_KRD(k2, ks + 6); \
                    sv = __builtin_amdgcn_mfma_f32_32x32x16_bf16(f3, qf[ks + 3], sv, 0, 0, 0); if (ks + 7 < KS) f3 = FL_KRD(k2, ks + 7); } } while (0)
#define FL_VRD(st, dt) (MODE != 2) ? (*(const LAS bf16x8*)(vb + vb4[st] + (dt) * 4096)) : ({ const u32x2 lo_ = *(const LAS u32x2*)(vb + vbase[2 * (st)] + (dt) * 4096), hi_ = *(const LAS u32x2*)(vb + vbase[2 * (st) + 1] + (dt) * 4096); __builtin_bit_cast(bf16x8, (u32x4){lo_.x, lo_.y, hi_.x, hi_.y}); })
#define FL_PACK(sv, sx) ({ u32x4 pw_; pw_.x = pk2(sv[8 * (sx) + 0], sv[8 * (sx) + 1]); pw_.y = pk2(sv[8 * (sx) + 2], sv[8 * (sx) + 3]); pw_.z = pk2(sv[8 * (sx) + 4], sv[8 * (sx) + 5]); pw_.w = pk2(sv[8 * (sx) + 6], sv[8 * (sx) + 7]); __builtin_bit_cast(bf16x8, pw_); })
#define FL_PV(sa, sb, st0, NST) do { bf16x8 va[NDT]; _Pragma("unroll") for (int dt = 0; dt < NDT; ++dt) va[dt] = FL_VRD(st0, dt); \
                _Pragma("unroll") for (int q_ = 0; q_ < (NST); ++q_) { const int st = (st0) + q_; const bf16x8 pb = (q_ < 2) ? FL_PACK(sa, q_ & 1) : FL_PACK(sb, q_ & 1); \
                    _Pragma("unroll") for (int dt = 0; dt < NDT; ++dt) { o[dt] = __builtin_amdgcn_mfma_f32_32x32x16_bf16(va[dt], pb, o[dt], 0, 0, 0); if (q_ + 1 < (NST)) va[dt] = FL_VRD(st + 1, dt); } } } while (0)
            if (MODE == 2) {
#pragma unroll
                for (int k2 = 0; k2 < 2; ++k2) { f32x16 sv; FL_QK(sv, k2);
                    const int thr = (kind == 1) ? (qloc - 64 * tt - 32 * k2 - 4 * h) : 1000;
#pragma unroll
                    for (int r = 0; r < 16; ++r) { const int fr_ = (r & 3) + 8 * (r >> 2); const float v = sv[r] * tscale; sv[r] = (fr_ > thr) ? 0.f : v; }
                    FL_PV(sv, sv, 2 * k2, 2); }
            } else {
                f32x16 s0, s1; if (FABL == 1) { for (int i = 0; i < 16; ++i) { s0[i] = 0.f; s1[i] = 0.f; } } else { FL_QK(s0, 0); FL_QK(s1, 1); }
                bool rowsel = true;
                if (MODE == 0) {
                    if (kind == 1) {
                        const int thr = qloc - 64 * tt - 4 * h;
#pragma unroll
                        for (int r = 0; r < 16; ++r) { const int fr_ = (r & 3) + 8 * (r >> 2); s0[r] = (fr_ <= thr) ? s0[r] : -1.0e30f; s1[r] = (fr_ + 32 <= thr) ? s1[r] : -1.0e30f; }
                    } else rowsel = ((selmask >> blk) & 1u) != 0u;
                }
                if (FABL != 3) {
                float mx = fmaxf(s0[0], s1[0]);
#pragma unroll
                for (int r = 1; r < 16; ++r) mx = fmaxf(mx, fmaxf(s0[r], s1[r]));
                mx = rowsel ? mx : -1.0e30f;
                mx = fmaxf(mx, __shfl_xor(mx, 32));
                if (!__all((int)(mx <= mrun + 8.0f))) {
                    const float mnew = fmaxf(mrun, mx), alpha = fast_exp2(mrun - mnew); mrun = mnew; lsum *= alpha;
#pragma unroll
                    for (int dt = 0; dt < NDT; ++dt) o[dt] = o[dt] * alpha;
                }
                float ps = 0.f;
                const float msub = rowsel ? mrun : 3.0e38f;
#pragma unroll
                for (int r = 0; r < 16; ++r) { const float p0 = fast_exp2(s0[r] - msub), p1 = fast_exp2(s1[r] - msub); s0[r] = p0; s1[r] = p1; ps += p0 + p1; }
                lsum += ps;
                }
                if (FABL != 2) FL_PV(s0, s1, 0, 4);
            }
#undef FL_KRD
#undef FL_QK
#undef FL_VRD
#undef FL_PACK
#undef FL_PV
        }
        VM_WAIT();
        __syncthreads();
    }
#undef FL_ISSUE
#undef FL_TILE_KB
    if (FABL != 0) { _Pragma("unroll") for (int dt = 0; dt < NDT; ++dt) asm volatile("" :: "v"(o[dt])); asm volatile("" :: "v"(lsum), "v"(mrun)); return; }
    const size_t grow = a.qrow0 + (size_t)qloc;
    if (MODE != 2) {
        const float ltot = lsum + __shfl_xor(lsum, 32), inv = 1.0f / ltot;
        GAS unsigned char* op = (GAS unsigned char*)a.O + grow * a.ldo + a.ocol + 4 * h; const float i8_ = inv * Y8_SCALE;
#pragma unroll
        for (int dt = 0; dt < 4; ++dt)
#pragma unroll
            for (int g4 = 0; g4 < 4; ++g4) { unsigned w8 = 0; w8 = __builtin_amdgcn_cvt_pk_fp8_f32(f8c(o[dt][4 * g4] * i8_), f8c(o[dt][4 * g4 + 1] * i8_), w8, false); w8 = __builtin_amdgcn_cvt_pk_fp8_f32(f8c(o[dt][4 * g4 + 2] * i8_), f8c(o[dt][4 * g4 + 3] * i8_), w8, true); *(GAS unsigned*)(op + 32 * dt + 8 * g4) = w8; }
    } else {
        float sm = 0.f, sq = 0.f;
        GAS bf16_t* op = a.O + grow * a.ldo + a.ocol + 4 * h;
#pragma unroll
        for (int dt = 0; dt < 4; ++dt)
#pragma unroll
            for (int g4 = 0; g4 < 4; ++g4) {
#pragma unroll
                for (int j = 0; j < 4; ++j) { const float v = o[dt][4 * g4 + j]; sm += v; sq += v * v; }
                u32x2 wv; wv.x = pk2(o[dt][4 * g4], o[dt][4 * g4 + 1]); wv.y = pk2(o[dt][4 * g4 + 2], o[dt][4 * g4 + 3]); *(GAS u32x2*)(op + 32 * dt + 8 * g4) = wv; }
        sm += __shfl_xor(sm, 32); sq += __shfl_xor(sq, 32);
        if (h == 0) { f32x2 st = {sm, sq}; *(GAS f32x2*)(a.stat + grow * 32) = st; }
    }
}
__device__ __forceinline__ void moba_kmean(LAS unsigned char* lds, const GAS bf16_t* K, size_t krow0, int kcol, int nb, int tid) {
    LAS float* part = (LAS float*)(lds + FL_PART); LAS float* km = (LAS float*)(lds + FL_KMEAN);
    const int c = tid & 15, rg = tid >> 4;
    for (int n = 0; n < nb; ++n) {
        float acc[8] = {0, 0, 0, 0, 0, 0, 0, 0};
#pragma unroll
        for (int i = 0; i < 8; ++i) { const u32x4 v = *(const GAS u32x4*)(K + (krow0 + 256 * n + rg + 32 * i) * 1024 + kcol + 8 * c);
            acc[0] += bf_lo(v.x); acc[1] += bf_hi(v.x); acc[2] += bf_lo(v.y); acc[3] += bf_hi(v.y); acc[4] += bf_lo(v.z); acc[5] += bf_hi(v.z); acc[6] += bf_lo(v.w); acc[7] += bf_hi(v.w); }
#pragma unroll
        for (int j = 0; j < 8; ++j) part[rg * 128 + 8 * c + j] = acc[j];
        __syncthreads();
        if (tid < 128) { float s = 0.f;
#pragma unroll 8
            for (int r = 0; r < 32; ++r) s += part[r * 128 + tid]; km[n * 128 + tid] = s * (1.0f / 256.0f); }
        __syncthreads();
    }
}
constexpr int RT_KBUF = 0, RT_VSLAB = 65536, RT_PBUF = 131072, RT_STAT = 0;
template <int ABL> __device__ __forceinline__ void retention_unit(LAS unsigned char* lds, GAS unsigned char* ws, int b, int hh, int qc, int tid) {
    asm volatile("" : "+v"(tid));
    const int lane = tid & 63, w = __builtin_amdgcn_readfirstlane(tid >> 6), l15 = lane & 15, kg = lane >> 4, l31 = lane & 31, h = lane >> 5;
    const int nt = 2 * (qc + 1);
    const GAS bf16_t* Q = (const GAS bf16_t*)(ws + WS_RQ); const GAS bf16_t* K = (const GAS bf16_t*)(ws + WS_RK); const GAS bf16_t* VT = (const GAS bf16_t*)(ws + WS_RVT);
    const size_t trow0 = (size_t)b * SEQ + 128 * qc;
    const float lg2g = log2f(1.0f - exp2f(-5.0f - (float)hh));
    const int k_row = lane >> 5, k_cp = lane & 31;
#define RT_ISSUE_K(t, buf) do { \
        _Pragma("unroll") for (int i = 0; i < 4; ++i) { const int pidx = w + 8 * i, row = 2 * pidx + k_row, c = k_cp ^ (row & 15); \
            __builtin_amdgcn_global_load_lds((const GAS unsigned*)(K + ((size_t)b * SEQ + 64 * (t) + row) * 1024 + hh * 256 + 8 * c), (LAS unsigned*)(lds + RT_KBUF + (buf) * 32768 + pidx * 1024), 16, 0, 0); } } while (0)
    const int v_row = lane >> 3, v_cp = lane & 7;
    const GAS bf16_t* vsrc = VT + ((size_t)b * 2048 + hh * 512 + 64 * w) * SEQ;
#define RT_ISSUE_V(t) do { \
        _Pragma("unroll") for (int i = 0; i < 8; ++i) { const int row = 8 * i + v_row, c = v_cp ^ ((row >> 1) & 7); \
            __builtin_amdgcn_global_load_lds((const GAS unsigned*)(vsrc + (size_t)row * SEQ + 64 * (t) + 8 * c), (LAS unsigned*)(lds + RT_VSLAB + w * 8192 + (8 * i) * 128), 16, 0, 0); } } while (0)
    RT_ISSUE_K(0, 0); RT_ISSUE_V(0); RT_ISSUE_K(1, 1);
    bf16x8 qf[8];
    { const GAS bf16_t* qp = Q + (trow0 + 16 * w + l15) * 1024 + hh * 256 + 8 * kg;
#pragma unroll
      for (int ks = 0; ks < 8; ++ks) qf[ks] = *(const GAS bf16x8*)(qp + 32 * ks); }
    f32x16 o[2][4];
#pragma unroll
    for (int a = 0; a < 2; ++a)
#pragma unroll
        for (int c = 0; c < 4; ++c)
#pragma unroll
            for (int i = 0; i < 16; ++i) o[a][c][i] = 0.f;
    const int kbaseS = l15 * 512;
    const int pw_q = 16 * w + l15;
    const int pw_off = pw_q * 128, pw_x = (pw_q >> 1) & 7;
    const int pr_x = (l31 >> 1) & 7;
    const LAS unsigned char* vslab = lds + RT_VSLAB + w * 8192;
    LAS unsigned char* pbuf = lds + RT_PBUF;
    asm volatile("s_waitcnt vmcnt(0)" ::: "memory"); __builtin_amdgcn_s_barrier(); asm volatile("" ::: "memory");
    for (int t = 0; t < nt; ++t) {
        const bool diag = (t >= 2 * qc);
        const int koff = 64 * (t - 2 * qc);
        const LAS unsigned char* kb = lds + RT_KBUF + (t & 1) * 32768;
        const float tsc = fast_exp2(lg2g * 256.0f * (float)((qc >> 1) - (t >> 2)));
        f32x4 sa[4];
#pragma unroll
        for (int kt = 0; kt < 4; ++kt) sa[kt] = (f32x4){0.f, 0.f, 0.f, 0.f};
        if (ABL != 1) {
#define RT_KF(i) (*(const LAS bf16x8*)(kb + kbaseS + ((i) >> 3) * 16 * 512 + (((4 * ((i) & 7) + kg) ^ l15) * 16)))
            bf16x8 kf[4];
#pragma unroll
            for (int i = 0; i < 4; ++i) kf[i] = RT_KF(i);
#pragma unroll
            for (int i = 0; i < 32; ++i) { sa[i >> 3] = __builtin_amdgcn_mfma_f32_16x16x32_bf16(kf[i & 3], qf[i & 7], sa[i >> 3], 0, 0, 0); if (i + 4 < 32) kf[i & 3] = RT_KF(i + 4); }
#undef RT_KF
        }
        asm volatile("s_waitcnt lgkmcnt(0)" ::: "memory"); __builtin_amdgcn_s_barrier(); asm volatile("" ::: "memory");
#pragma unroll
        for (int kt = 0; kt < 4; ++kt) { const int key0 = 16 * kt + 4 * kg;
            float v[4];
#pragma unroll
            for (int r = 0; r < 4; ++r) { v[r] = sa[kt][r] * tsc; if (diag && (koff + key0 + r > pw_q)) v[r] = 0.f; }
            const int c8 = key0 >> 2, c16 = c8 >> 1, half = c8 & 1;
            u32x2 pk; pk.x = pk2(v[0], v[1]); pk.y = pk2(v[2], v[3]);
            *(LAS u32x2*)(pbuf + pw_off + ((c16 ^ pw_x) * 16) + half * 8) = pk; }
        asm volatile("s_waitcnt vmcnt(0) lgkmcnt(0)" ::: "memory"); __builtin_amdgcn_s_barrier(); asm volatile("" ::: "memory");
        if (t + 2 < nt && ABL != 4) RT_ISSUE_K(t + 2, t & 1);
#pragma unroll
        for (int sx = 0; sx < 4; ++sx) { if (ABL == 2) continue;
            bf16x8 pb[4];
#pragma unroll
            for (int qt2 = 0; qt2 < 4; ++qt2) pb[qt2] = *(const LAS bf16x8*)(pbuf + (32 * qt2 + l31) * 128 + (((2 * sx + h) ^ pr_x) * 16));
#pragma unroll
            for (int dvt = 0; dvt < 2; ++dvt) { const bf16x8 va = *(const LAS bf16x8*)(vslab + (32 * dvt + l31) * 128 + (((2 * sx + h) ^ pr_x) * 16));
#pragma unroll
                for (int qt2 = 0; qt2 < 4; ++qt2) o[dvt][qt2] = __builtin_amdgcn_mfma_f32_32x32x16_bf16(va, pb[qt2], o[dvt][qt2], 0, 0, 0); } }
        asm volatile("s_waitcnt lgkmcnt(0)" ::: "memory");
        __builtin_amdgcn_sched_barrier(0);
        if (t + 1 < nt && ABL != 3) RT_ISSUE_V(t + 1);
    }
#undef RT_ISSUE_K
#undef RT_ISSUE_V
    if (ABL != 0) { _Pragma("unroll") for (int a = 0; a < 2; ++a) _Pragma("unroll") for (int c = 0; c < 4; ++c) asm volatile("" :: "v"(o[a][c])); __syncthreads(); return; }
    __syncthreads();
    LAS float* st = (LAS float*)(lds + RT_STAT);
#pragma unroll
    for (int qt2 = 0; qt2 < 4; ++qt2) { float sm = 0.f, sq = 0.f;
#pragma unroll
        for (int dvt = 0; dvt < 2; ++dvt)
#pragma unroll
            for (int r = 0; r < 16; ++r) { const float v = o[dvt][qt2][r]; sm += v; sq += v * v; }
        sm += __shfl_xor(sm, 32); sq += __shfl_xor(sq, 32);
        if (h == 0) { st[(w * 128 + 32 * qt2 + l31) * 2] = sm; st[(w * 128 + 32 * qt2 + l31) * 2 + 1] = sq; } }
    __syncthreads();
    const GAS bf16_t* rgs = (const GAS bf16_t*)(ws + WS_RGS); GAS bf16_t* yr = (GAS bf16_t*)(ws + WS_YR);
#pragma unroll
    for (int qt2 = 0; qt2 < 4; ++qt2) { const int q = 32 * qt2 + l31; float sm = 0.f, sq = 0.f;
#pragma unroll
        for (int ww = 0; ww < 8; ++ww) { sm += st[(ww * 128 + q) * 2]; sq += st[(ww * 128 + q) * 2 + 1]; }
        const float mean = sm * (1.0f / 512.0f), var = fmaxf(sq * (1.0f / 512.0f) - mean * mean, 0.f), rstd = 1.0f / sqrtf(var + GN_EPS);
        const size_t off = (trow0 + q) * 2048 + hh * 512 + 64 * w + 4 * h;
#pragma unroll
        for (int dvt = 0; dvt < 2; ++dvt)
#pragma unroll
            for (int g4 = 0; g4 < 4; ++g4) { const u32x2 gv = *(const GAS u32x2*)(rgs + off + 32 * dvt + 8 * g4);
                const float rs8 = rstd * Y8_SCALE; unsigned w8 = 0;
                w8 = __builtin_amdgcn_cvt_pk_fp8_f32(f8c(bf_lo(gv.x) * (o[dvt][qt2][4 * g4] - mean) * rs8), f8c(bf_hi(gv.x) * (o[dvt][qt2][4 * g4 + 1] - mean) * rs8), w8, false);
                w8 = __builtin_amdgcn_cvt_pk_fp8_f32(f8c(bf_lo(gv.y) * (o[dvt][qt2][4 * g4 + 2] - mean) * rs8), f8c(bf_hi(gv.y) * (o[dvt][qt2][4 * g4 + 3] - mean) * rs8), w8, true);
                *(GAS unsigned*)((GAS unsigned char*)yr + off + 32 * dvt + 8 * g4) = w8; } }
    __syncthreads();
}
__device__ __forceinline__ void phase_mixers(Frame& F) {
    GAS unsigned char* ws = KWS(); const int c = F.vcu; LAS unsigned char* lds = F.lds; int tid = F.tid; asm volatile("" : "+v"(tid));
#ifndef DUP_MASK
#define DUP_MASK 0
#endif
#define NREPM(k) ((((DUP_MASK) >> (k)) & 1) ? 2 : 1)
    for (int rp_ = 0; rp_ < NREPM(10); ++rp_) { const int bh = c >> 2, pi = c & 3, b = bh >> 3, hh = bh & 7;
      const int qb_hi = 7 - pi;
      moba_kmean(lds, (const GAS bf16_t*)(ws + WS_AK), (size_t)b * SEQ, hh * 128, qb_hi, tid);
      for (int rep = 0; rep < 2; ++rep) { const int qb = rep ? pi : qb_hi;
          FlashArgs a; a.Q = (const GAS bf16_t*)(ws + WS_AQ); a.ldq = 1024; a.qrow0 = (size_t)b * SEQ + 256 * qb; a.qcol = hh * 128;
          a.K = (const GAS bf16_t*)(ws + WS_AK); a.ldk = 1024; a.krow0 = (size_t)b * SEQ; a.kcol = hh * 128;
          a.VT = (const GAS bf16_t*)(ws + WS_AVT); a.ldvt = SEQ; a.vrow0 = (size_t)b * 1024 + hh * 128; a.vcol0 = 0;
          a.O = (GAS bf16_t*)(ws + WS_YA); a.ldo = 1024; a.ocol = hh * 128; a.qblk = qb; a.stat = nullptr; a.lg2g = 0.f;
          flash_unit<0, 128>(lds, a, tid);
#ifdef FL_ABL
          flash_unit<0, 128, FL_ABL>(lds, a, tid); flash_unit<0, 128>(lds, a, tid);
#endif
          } }
    for (int j = 0; j < 2 * NREPM(11); ++j) { const int bh = c >> 3, pi = c & 7, b = bh >> 2, hh = bh & 3;
        retention_unit<0>(lds, ws, b, hh, (j & 1) ? pi : 15 - pi, tid); }
#ifdef RT_ABL
    for (int j = 0; j < 2; ++j) { const int bh = c >> 3, pi = c & 7, b = bh >> 2, hh = bh & 3; retention_unit<RT_ABL>(lds, ws, b, hh, (j & 1) ? pi : 15 - pi, tid); }
    for (int j = 0; j < 2; ++j) { const int bh = c >> 3, pi = c & 7, b = bh >> 2, hh = bh & 3; retention_unit<0>(lds, ws, b, hh, (j & 1) ? pi : 15 - pi, tid); }
#endif
    for (int k = 0; k < 2 * NREPM(12); ++k) { const int m = 2 * c + (k & 1), p = m & 1, qb = (m >> 1) & 7, bh = m >> 4, b = bh >> 2, hh = bh & 3;
        FlashArgs a; a.Q = (const GAS bf16_t*)(ws + WS_MQ); a.ldq = 1024; a.qrow0 = (size_t)b * SEQ + 256 * qb; a.qcol = hh * 256;
        a.K = (const GAS bf16_t*)(ws + WS_KM); a.ldk = 1024; a.krow0 = (size_t)b * 256; a.kcol = hh * 256;
        a.VT = (const GAS bf16_t*)(ws + WS_VMT); a.ldvt = 2048; a.vrow0 = (size_t)hh * 256 + p * 128; a.vcol0 = (size_t)b * 256;
        a.O = (GAS bf16_t*)(ws + WS_YM); a.ldo = 1024; a.ocol = hh * 256 + p * 128; a.qblk = 0; a.stat = nullptr; a.lg2g = 0.f;
        flash_unit<1, 256>(lds, a, tid); }
}
__device__ __forceinline__ void phase_retnorm(Frame& F) {
    GAS unsigned char* ws = KWS(); const int gw = F.vcu * NWAVES + F.wave, NGW = F.G * NWAVES;
    const GAS bf16_t* ro = (const GAS bf16_t*)(ws + WS_RO); const GAS bf16_t* rgs = (const GAS bf16_t*)(ws + WS_RGS); const GAS float* st = (const GAS float*)(ws + WS_RSTAT); GAS bf16_t* yr = (GAS bf16_t*)(ws + WS_YR);
    for (int row = gw; row < T; row += NGW) {
#pragma unroll
        for (int hh = 0; hh < 4; ++hh) {
            const f32x4 s01 = *(const GAS f32x4*)(st + (size_t)row * 32 + hh * 8), s23 = *(const GAS f32x4*)(st + (size_t)row * 32 + hh * 8 + 4);
            const float sm = (s01[0] + s01[2]) + (s23[0] + s23[2]), sq = (s01[1] + s01[3]) + (s23[1] + s23[3]);
            const float mean = sm * (1.0f / 512.0f), var = fmaxf(sq * (1.0f / 512.0f) - mean * mean, 0.f), rstd = 1.0f / sqrtf(var + GN_EPS);
            const size_t off = (size_t)row * 2048 + hh * 512 + 8 * F.lane;
            const u32x4 ov = *(const GAS u32x4*)(ro + off), gv = *(const GAS u32x4*)(rgs + off);
            u32x4 w; w.x = pk2(bf_lo(gv.x) * (bf_lo(ov.x) - mean) * rstd, bf_hi(gv.x) * (bf_hi(ov.x) - mean) * rstd); w.y = pk2(bf_lo(gv.y) * (bf_lo(ov.y) - mean) * rstd, bf_hi(gv.y) * (bf_hi(ov.y) - mean) * rstd);
            w.z = pk2(bf_lo(gv.z) * (bf_lo(ov.z) - mean) * rstd, bf_hi(gv.z) * (bf_hi(ov.z) - mean) * rstd); w.w = pk2(bf_lo(gv.w) * (bf_lo(ov.w) - mean) * rstd, bf_hi(gv.w) * (bf_hi(ov.w) - mean) * rstd);
            *(GAS u32x4*)(yr + off) = w; }
    }
}

__device__ __forceinline__ void ln_row(f32x4 (&v)[8], const GAS float* g, const GAS float* bta, int lane) {
    float s = 0.f;
#pragma unroll
    for (int j = 0; j < 8; ++j) s += (v[j][0] + v[j][1]) + (v[j][2] + v[j][3]);
    const float mean = wave_sum(s) * (1.0f / D); float s2 = 0.f;
#pragma unroll
    for (int j = 0; j < 8; ++j) { v[j] = v[j] - mean; s2 += (v[j][0] * v[j][0] + v[j][1] * v[j][1]) + (v[j][2] * v[j][2] + v[j][3] * v[j][3]); }
    const float rstd = 1.0f / sqrtf(wave_sum(s2) * (1.0f / D) + LN_EPS);
#pragma unroll
    for (int j = 0; j < 8; ++j) { const f32x4 gg = *(const GAS f32x4*)(g + 4 * lane + 256 * j), bb = *(const GAS f32x4*)(bta + 4 * lane + 256 * j); v[j] = v[j] * rstd * gg + bb; }
}
constexpr int R2_PLD = 49, R2_PART = 0, R2_STAT = R2_PART + 8 * 64 * R2_PLD * 4, R2_LGLD = 37, R2_LG = R2_STAT + 8 * 64 * 2 * 4, R2_SEL = R2_LG + 64 * R2_LGLD * 4, R2_CNT = R2_SEL + 64 * 4 * 4;
static_assert(R2_CNT + 256 <= LDS_TAB, "LN1/router LDS map");
__device__ __forceinline__ void phase_ln1_router(Frame& F, int l, bool commit) {
    GAS unsigned char* ws = KWS(); LAS unsigned char* lds = F.lds;
    const GAS float* g1 = KIN(8) + (size_t)l * D; const GAS float* b1 = KIN(9) + (size_t)l * D;
    const GAS bf16_t* hpre = (const GAS bf16_t*)(ws + WS_HPRE); GAS bf16_t* x1b = (GAS bf16_t*)(ws + WS_X1B);
    const GAS bf16_t* wgh = (const GAS bf16_t*)(ws + WS_WRT); const GAS bf16_t* wgl = (const GAS bf16_t*)(ws + WS_WRT + WRT_GL);
    const GAS float* csp = (const GAS float*)(ws + WS_WRT + WRT_CS); const GAS float* c0p = (const GAS float*)(ws + WS_WRT + WRT_C0);
    GAS int* list = (GAS int*)(ws + WS_LIST); GAS float* tokw = (GAS float*)(ws + WS_TOKW);
    GAS unsigned* gcnt = (GAS unsigned*)(ws + WS_CTL) + CW_CNT + l * 64 * NEXP;
    LAS float* part = (LAS float*)(lds + R2_PART); LAS float* stat = (LAS float*)(lds + R2_STAT); LAS float* lgt = (LAS float*)(lds + R2_LG); LAS int* sel = (LAS int*)(lds + R2_SEL);
    LAS int* lcnt = (LAS int*)(lds + R2_CNT); LAS int* lbase = lcnt + 32;
    for (int grp = F.vcu; grp < T / 64; grp += F.G) {
        int tid = F.tid; asm volatile("" : "+v"(tid));
        const int lane = tid & 63, r = lane & 15, q = lane >> 4, w = __builtin_amdgcn_readfirstlane(tid >> 6);
        const int row0 = grp * 64;
        if (tid < 32) lcnt[tid] = 0;
        const size_t coff = (size_t)(256 * w + 8 * q);
        const GAS bf16_t* hp = hpre + (size_t)(row0 + r) * D + coff;
        const GAS bf16_t* bh = wgh + (size_t)r * D + coff; const GAS bf16_t* bl = wgl + (size_t)r * D + coff;
        u32x4 A[2][2][8];
#pragma unroll
        for (int tt = 0; tt < 2; ++tt)
#pragma unroll
            for (int ks = 0; ks < 8; ++ks) A[0][tt][ks] = *(const GAS u32x4*)(hp + (size_t)(16 * tt) * D + 32 * ks);
        __builtin_amdgcn_sched_barrier(0);
#pragma unroll
        for (int hf = 0; hf < 2; ++hf) {
            u32x4 Bc[3][2], Bn[3][2];
#pragma unroll
            for (int ct = 0; ct < 3; ++ct) { Bc[ct][0] = *(const GAS u32x4*)(bh + (size_t)16 * ct * D); Bc[ct][1] = *(const GAS u32x4*)(bl + (size_t)16 * ct * D); }
            f32x4 acc[2][3];
#pragma unroll
            for (int tt = 0; tt < 2; ++tt)
#pragma unroll
                for (int ct = 0; ct < 3; ++ct) acc[tt][ct] = (f32x4){0.f, 0.f, 0.f, 0.f};
#pragma unroll
            for (int ks = 0; ks < 8; ++ks) {
                if (ks < 7) {
#pragma unroll
                    for (int ct = 0; ct < 3; ++ct) { Bn[ct][0] = *(const GAS u32x4*)(bh + (size_t)16 * ct * D + 32 * (ks + 1)); Bn[ct][1] = *(const GAS u32x4*)(bl + (size_t)16 * ct * D + 32 * (ks + 1)); } }
#pragma unroll
                for (int tt = 0; tt < 2; ++tt)
#pragma unroll
                    for (int ct = 0; ct < 3; ++ct) {
                        acc[tt][ct] = __builtin_amdgcn_mfma_f32_16x16x32_bf16(__builtin_bit_cast(bf16x8, A[hf][tt][ks]), __builtin_bit_cast(bf16x8, Bc[ct][0]), acc[tt][ct], 0, 0, 0);
                        acc[tt][ct] = __builtin_amdgcn_mfma_f32_16x16x32_bf16(__builtin_bit_cast(bf16x8, A[hf][tt][ks]), __builtin_bit_cast(bf16x8, Bc[ct][1]), acc[tt][ct], 0, 0, 0); }
                if (ks < 7) {
#pragma unroll
                    for (int ct = 0; ct < 3; ++ct) { Bc[ct][0] = Bn[ct][0]; Bc[ct][1] = Bn[ct][1]; } }
                __builtin_amdgcn_sched_barrier(0);
            }
#pragma unroll
            for (int tt = 0; tt < 2; ++tt)
#pragma unroll
                for (int ct = 0; ct < 3; ++ct)
#pragma unroll
                    for (int i = 0; i < 4; ++i) part[(w * 64 + 32 * hf + 16 * tt + 4 * q + i) * R2_PLD + 16 * ct + r] = acc[tt][ct][i];
#pragma unroll
            for (int tt = 0; tt < 2; ++tt) { float s1 = 0.f, s2 = 0.f;
#pragma unroll
                for (int ks = 0; ks < 8; ++ks)
#pragma unroll
                    for (int e = 0; e < 4; ++e) { const u32x4 av = A[hf][tt][ks]; const unsigned u = e == 0 ? av.x : (e == 1 ? av.y : (e == 2 ? av.z : av.w)); const bf16x2_t pv = __builtin_bit_cast(bf16x2_t, u);
                        s1 = __builtin_amdgcn_fdot2_f32_bf16(pv, __builtin_bit_cast(bf16x2_t, 0x3f803f80u), s1, false); s2 = __builtin_amdgcn_fdot2_f32_bf16(pv, pv, s2, false); }
                s1 += __shfl_xor(s1, 16); s1 += __shfl_xor(s1, 32); s2 += __shfl_xor(s2, 16); s2 += __shfl_xor(s2, 32);
                if (q == 0) { stat[(w * 64 + 32 * hf + 16 * tt + r) * 2] = s1; stat[(w * 64 + 32 * hf + 16 * tt + r) * 2 + 1] = s2; } }
            __builtin_amdgcn_sched_barrier(0);
            if (hf == 0) {
#pragma unroll
                for (int tt = 0; tt < 2; ++tt)
#pragma unroll
                    for (int ks = 0; ks < 8; ++ks) A[1][tt][ks] = *(const GAS u32x4*)(hp + (size_t)(32 + 16 * tt) * D + 32 * ks); }
            __builtin_amdgcn_sched_barrier(0);
            __syncthreads();
            { float mu[2], rs[2];
#pragma unroll
              for (int tt = 0; tt < 2; ++tt) { float S1 = 0.f, S2 = 0.f;
#pragma unroll
                  for (int ww = 0; ww < 8; ++ww) { S1 += stat[(ww * 64 + 32 * hf + 16 * tt + r) * 2]; S2 += stat[(ww * 64 + 32 * hf + 16 * tt + r) * 2 + 1]; }
                  mu[tt] = S1 * (1.0f / D); rs[tt] = 1.0f / sqrtf(fmaxf(S2 * (1.0f / D) - mu[tt] * mu[tt], 0.f) + LN_EPS); }
              GAS bf16_t* xp = x1b + (size_t)(row0 + 32 * hf + r) * D + coff;
              f32x4 gc[4], gn[4];
              gc[0] = *(const GAS f32x4*)(g1 + coff); gc[1] = *(const GAS f32x4*)(g1 + coff + 4); gc[2] = *(const GAS f32x4*)(b1 + coff); gc[3] = *(const GAS f32x4*)(b1 + coff + 4);
#pragma unroll
              for (int ks = 0; ks < 8; ++ks) {
                  if (ks < 7) { gn[0] = *(const GAS f32x4*)(g1 + coff + 32 * (ks + 1)); gn[1] = *(const GAS f32x4*)(g1 + coff + 32 * (ks + 1) + 4); gn[2] = *(const GAS f32x4*)(b1 + coff + 32 * (ks + 1)); gn[3] = *(const GAS f32x4*)(b1 + coff + 32 * (ks + 1) + 4); }
#pragma unroll
                  for (int tt = 0; tt < 2; ++tt) { u32x4 h = A[hf][tt][ks]; asm volatile("" : "+v"(h)); const float m = mu[tt], sc = rs[tt]; u32x4 o;
                      o.x = pk2((bf_lo(h.x) - m) * sc * gc[0][0] + gc[2][0], (bf_hi(h.x) - m) * sc * gc[0][1] + gc[2][1]); o.y = pk2((bf_lo(h.y) - m) * sc * gc[0][2] + gc[2][2], (bf_hi(h.y) - m) * sc * gc[0][3] + gc[2][3]);
                      o.z = pk2((bf_lo(h.z) - m) * sc * gc[1][0] + gc[3][0], (bf_hi(h.z) - m) * sc * gc[1][1] + gc[3][1]); o.w = pk2((bf_lo(h.w) - m) * sc * gc[1][2] + gc[3][2], (bf_hi(h.w) - m) * sc * gc[1][3] + gc[3][3]);
                      *(GAS u32x4*)(xp + (size_t)(16 * tt) * D + 32 * ks) = o; }
                  if (ks < 7) { gc[0] = gn[0]; gc[1] = gn[1]; gc[2] = gn[2]; gc[3] = gn[3]; }
                  __builtin_amdgcn_sched_barrier(0); } }
            { const int row = 32 * hf + (tid & 31), cg = tid >> 5; float S1 = 0.f, S2 = 0.f;
#pragma unroll
              for (int ww = 0; ww < 8; ++ww) { S1 += stat[(ww * 64 + row) * 2]; S2 += stat[(ww * 64 + row) * 2 + 1]; }
              const float m = S1 * (1.0f / D), sc = 1.0f / sqrtf(fmaxf(S2 * (1.0f / D) - m * m, 0.f) + LN_EPS);
#pragma unroll
              for (int j = 0; j < 3; ++j) { const int c = cg * 3 + j;
                  if (c < 36) { float raw = 0.f;
#pragma unroll
                      for (int ww = 7; ww >= 0; --ww) raw += part[(ww * 64 + row) * R2_PLD + c];
                      lgt[row * R2_LGLD + c] = sc * (raw - m * csp[c]) + c0p[c]; } } }
        }
        __syncthreads();
        if (tid < 64) { const int rl = tid, row = row0 + rl; float lg[36];
#pragma unroll
            for (int cc = 0; cc < 36; ++cc) lg[cc] = lgt[rl * R2_LGLD + cc];
            int gs = 0; float gm = lg[0];
#pragma unroll
            for (int cc = 1; cc < 4; ++cc) if (lg[cc] > gm) { gm = lg[cc]; gs = cc; }
            float den = 0.f;
#pragma unroll
            for (int cc = 0; cc < 4; ++cc) den += __expf(lg[cc] - gm);
            const float pg = 1.0f / den;
            float ev[8];
#pragma unroll
            for (int j = 0; j < 8; ++j) ev[j] = gs == 0 ? lg[4 + j] : (gs == 1 ? lg[12 + j] : (gs == 2 ? lg[20 + j] : lg[28 + j]));
            int i0 = 0; float v0 = ev[0];
#pragma unroll
            for (int j = 1; j < 8; ++j) if (ev[j] > v0) { v0 = ev[j]; i0 = j; }
            int i1 = -1; float v1 = -3.0e38f;
#pragma unroll
            for (int j = 0; j < 8; ++j) if (j != i0 && ev[j] > v1) { v1 = ev[j]; i1 = j; }
            const float ex = __expf(v1 - v0), w0 = pg / (1.0f + ex), w1 = pg * ex / (1.0f + ex);
            const int e0 = gs * 8 + i0, e1 = gs * 8 + i1; int p0 = 0, p1 = 0;
            tokw[(size_t)row * 2] = w0; tokw[(size_t)row * 2 + 1] = w1;
            if (commit) { p0 = __hip_atomic_fetch_add(&lcnt[e0], 1, __ATOMIC_RELAXED, __HIP_MEMORY_SCOPE_WORKGROUP); p1 = __hip_atomic_fetch_add(&lcnt[e1], 1, __ATOMIC_RELAXED, __HIP_MEMORY_SCOPE_WORKGROUP); }
            sel[rl * 4] = e0; sel[rl * 4 + 1] = e1; sel[rl * 4 + 2] = p0; sel[rl * 4 + 3] = p1; }
        __syncthreads();
        if (tid < 32 && commit) lbase[tid] = (int)__hip_atomic_fetch_add(gcnt + 64 * tid, (unsigned)lcnt[tid], __ATOMIC_RELAXED, __HIP_MEMORY_SCOPE_AGENT);
        __syncthreads();
        if (tid < 64 && commit) { const int row = row0 + tid; const int e0 = sel[tid * 4], e1 = sel[tid * 4 + 1], p0 = sel[tid * 4 + 2], p1 = sel[tid * 4 + 3];
            list[(size_t)e0 * T + lbase[e0] + p0] = row * 2; list[(size_t)e1 * T + lbase[e1] + p1] = row * 2 + 1; }
        __syncthreads();
    }
}
__device__ __forceinline__ void phase_ln2(Frame& F, int l) {
    GAS unsigned char* ws = KWS(); const int gw = F.vcu * NWAVES + F.wave, NGW = F.G * NWAVES;
    const GAS float* g2 = KIN(16) + (size_t)l * D; const GAS float* b2 = KIN(17) + (size_t)l * D;
    const GAS bf16_t* x1 = (const GAS bf16_t*)(ws + WS_X1B); const GAS bf16_t* yasg = (const GAS bf16_t*)(ws + WS_YASG); const GAS float* tokw = (const GAS float*)(ws + WS_TOKW);
    GAS float* outf = KOUT(); GAS bf16_t* xb = (GAS bf16_t*)(ws + WS_XB);
    for (int row = gw; row < T; row += NGW) {
        const float w0 = tokw[(size_t)row * 2], w1 = tokw[(size_t)row * 2 + 1]; f32x4 v[8];
#pragma unroll
        for (int j = 0; j < 8; ++j) { const size_t c = 4 * F.lane + 256 * j; const u32x2 xw = *(const GAS u32x2*)(x1 + (size_t)row * D + c); const f32x4 xv = {bf_lo(xw.x), bf_hi(xw.x), bf_lo(xw.y), bf_hi(xw.y)};
            const u32x2 y0 = *(const GAS u32x2*)(yasg + (size_t)(2 * row) * D + c), y1 = *(const GAS u32x2*)(yasg + (size_t)(2 * row + 1) * D + c);
            f32x4 t; t[0] = w0 * bf_lo(y0.x) + w1 * bf_lo(y1.x); t[1] = w0 * bf_hi(y0.x) + w1 * bf_hi(y1.x); t[2] = w0 * bf_lo(y0.y) + w1 * bf_lo(y1.y); t[3] = w0 * bf_hi(y0.y) + w1 * bf_hi(y1.y);
            v[j] = xv * DN_ALPHA + t; }
        ln_row(v, g2, b2, F.lane);
        float q8 = 0.f;
        if (l != DEPTH - 1) { float mx = 0.f;
#pragma unroll
            for (int j = 0; j < 8; ++j) mx = fmaxf(fmaxf(mx, fmaxf(fabsf(v[j][0]), fabsf(v[j][1]))), fmaxf(fabsf(v[j][2]), fabsf(v[j][3])));
            mx = fmaxf(wave_max(mx), 1e-30f); q8 = 127.0f / mx; if (F.lane == 0) ((GAS float*)(ws + WS_XS))[row] = mx * (1.0f / 127.0f); }
#pragma unroll
        for (int j = 0; j < 8; ++j) { const size_t c = 4 * F.lane + 256 * j; if (l == DEPTH - 1) *(GAS f32x4*)(outf + (size_t)row * D + c) = v[j];
            else { u32x2 wv; wv.x = pk2(v[j][0], v[j][1]); wv.y = pk2(v[j][2], v[j][3]); *(GAS u32x2*)(xb + (size_t)row * D + c) = wv;
                *(GAS unsigned*)(ws + WS_XB8 + (size_t)row * D + c) = pk_i8(v[j][0], v[j][1], v[j][2], v[j][3], q8); } }
    }
}

constexpr int PH_PER_LAYER = 10, N_PHASES = DEPTH * PH_PER_LAYER;
#ifndef ONLY_PHASE
#define ONLY_PHASE -1
#endif
#define IN(k) ((ONLY_PHASE < 0 || ONLY_PHASE == ((k) % PH_PER_LAYER)) && lo <= (k) && (k) < hi)
#define SEAM(k) do { if (!MK_PER_PHASE && ((((k) % PH_PER_LAYER) == 2) ? IN((k) + 2) : IN((k) + 1))) xcd_barrier(bar); } while (0)
#define PF Frame F = phase_frame(F0)
#ifndef DUP_MASK
#define DUP_MASK 0
#endif
#define NREP(k) ((((DUP_MASK) >> (k)) & 1) ? 2 : 1)
__device__ __forceinline__ void phase_w_kv(const Frame& F0, int l) {
    { Frame F = phase_frame(F0); GAS unsigned char* ws = KWS();
      SchedKv S{(const GAS char*)(ws + WS_MEMB), (const GAS char*)(ws + WS_WKV) + (size_t)l * 2048 * D * 2, F.vcu};
      EpiProj E{ws, (const GAS float*)(ws + WS_ROPE), (const GAS float*)(ws + WS_ROPE) + 2048 * 128};
      pg8::gemm_phase<EpiProj, SchedKv, false>(F.lds, S, E); }
    __syncthreads();
    { Frame F = phase_frame(F0); phase_w(F, l); }
}
template <int l> __device__ __forceinline__ void run_layer(const Frame& F0, const XcdBarrier& bar, int lo, int hi) {
        constexpr int pb = l * PH_PER_LAYER;
        if (l == 0) {
            if (lo <= -1 && -1 < hi) { { PF; phase_w0a(F); } if (!MK_PER_PHASE && IN(pb + 0)) xcd_barrier(bar); }
            if (IN(pb + 0)) { for (int rep_ = 0; rep_ < NREP(0); ++rep_) phase_w_kv(F0, 0); SEAM(pb + 0); } }
        if (IN(pb + 1)) { for (int rep_ = 0; rep_ < NREP(1); ++rep_) {
            { PF; GAS unsigned char* ws = KWS();
              const float wdq = fmaxf(WQ_RANGE * __uint_as_float(xb_ld((GAS unsigned*)(ws + WS_CTL) + CW_WMAX + l)), 1e-30f) * (1.0f / 127.0f);
              SchedProj S{(const GAS char*)(ws + WS_XB8), (const GAS char*)(ws + WS_WIN8), F.G, F.bx, 0};
              EpiProjQ E{EpiProj{ws, (const GAS float*)(ws + WS_ROPE), (const GAS float*)(ws + WS_ROPE) + 2048 * 128}, (const GAS float*)(ws + WS_XS), wdq};
              pg8::gemm_phase<EpiProjQ, SchedProj, false>(F.lds, S, E); }
            { PF; GAS unsigned char* ws = KWS();
              const float wdq = fmaxf(WQ_RANGE * __uint_as_float(xb_ld((GAS unsigned*)(ws + WS_CTL) + CW_WMAX + l)), 1e-30f) * (1.0f / 127.0f);
              SchedProj S{(const GAS char*)(ws + WS_XB8), (const GAS char*)(ws + WS_WIN8), F.G, F.bx, 1};
              EpiProjT E{ws, wdq, (const GAS float*)(ws + WS_XS)};
              pg8::gemm_phase<EpiProjT, SchedProj, true>(F.lds, S, E); } }
            SEAM(pb + 1);
        }
        if (IN(pb + 2)) { for (int rep_ = 0; rep_ < NREP(2); ++rep_) { PF; phase_mixers(F); } SEAM(pb + 2); }
        if (IN(pb + 4)) { for (int rep_ = 0; rep_ < NREP(4); ++rep_) {
            PF; GAS unsigned char* ws = KWS();
            SchedMerge S{(const GAS char*)(ws + WS_YA), (const GAS char*)(ws + WS_YR), (const GAS char*)(ws + WS_YM), (const GAS char*)(ws + WS_WPM), (const GAS char*)(ws + WS_WPR), (const GAS char*)(ws + WS_WPE), F.G, F.bx};
            static_assert(WS_SGR == WS_SGA + 64 * MiB && WS_SGM == WS_SGR + 64 * MiB, "gate arrays");
            EpiMerge E{(const GAS unsigned char*)(ws + WS_SGA), (GAS bf16_t*)(ws + WS_MERGED)};
            pg8::gemm_phase<EpiMerge, SchedMerge, false>(F.lds, S, E); }
            SEAM(pb + 4);
        }
        if (IN(pb + 5)) { for (int rep_ = 0; rep_ < NREP(5); ++rep_) {
            PF; GAS unsigned char* ws = KWS();
            SchedPlain S{(const GAS char*)(ws + WS_MERGED), (const GAS char*)(ws + WS_WO), 64, 8, F.G, F.bx};
            EpiResid E{(const GAS bf16_t*)(ws + WS_XB), (GAS bf16_t*)(ws + WS_HPRE)};
            pg8::gemm_phase<EpiResid, SchedPlain, false>(F.lds, S, E); }
            SEAM(pb + 5);
        }
        if (IN(pb + 6)) { for (int rep_ = 0; rep_ < NREP(6); ++rep_) { PF; phase_ln1_router(F, l, rep_ == NREP(6) - 1); } SEAM(pb + 6); }
        if (IN(pb + 7)) { for (int rep_ = 0; rep_ < NREP(7); ++rep_) {
            PF; GAS unsigned char* ws = KWS();
            build_moe_tab(F, (GAS unsigned*)(ws + WS_CTL) + CW_CNT + l * 64 * NEXP);
            SchedMoe1 S{(const GAS char*)(ws + WS_X1B), (const GAS char*)(ws + WS_WGU), (const GAS int*)(ws + WS_LIST), (LAS int*)(F.lds + LDS_TAB), F.G, F.vcu};
            EpiSwiglu E{(GAS bf16_t*)(ws + WS_HBUF), (GAS unsigned*)(ws + WS_CTL) + CW_FLAG + l * 4096};
            pg8::gemm_phase<EpiSwiglu, SchedMoe1, false>(F.lds, S, E); }
        }
        if (IN(pb + 8)) { for (int rep_ = 0; rep_ < NREP(8); ++rep_) {
            PF; GAS unsigned char* ws = KWS();
            build_moe_tab(F, (GAS unsigned*)(ws + WS_CTL) + CW_CNT + l * 64 * NEXP);
            SchedMoe2 S{(const GAS char*)(ws + WS_HBUF), (const GAS char*)(ws + WS_WDN), (const GAS int*)(ws + WS_LIST), (LAS int*)(F.lds + LDS_TAB), F.G, F.vcu, (GAS unsigned*)(ws + WS_CTL) + CW_FLAG + l * 4096};
            EpiScatter E{(GAS bf16_t*)(ws + WS_YASG)};
            pg8::gemm_phase<EpiScatter, SchedMoe2, false>(F.lds, S, E); }
            SEAM(pb + 8);
        }
        if (IN(pb + 9)) { for (int rep_ = 0; rep_ < NREP(9); ++rep_) { PF; phase_ln2(F, l); }
            if (l + 1 < DEPTH) { phase_w_kv(F0, l + 1); if (!MK_PER_PHASE && IN(pb + 11)) xcd_barrier(bar); } }
}
#undef IN
#undef SEAM
#undef PF
#undef NREP
__global__ void __launch_bounds__(NWAVES * 64, 2) hybrid_fwd(Args args) {
    extern __shared__ __attribute__((aligned(16))) unsigned char lds_raw[];
    Frame F0;
    F0.lds = (LAS unsigned char*)lds_raw; F0.MISC = (volatile LAS unsigned*)(F0.lds + MISC_OFF);
    F0.tid = threadIdx.x; F0.lane = F0.tid & 63; F0.wave = __builtin_amdgcn_readfirstlane(F0.tid >> 6);
    F0.G = gridDim.x; { const int bx = blockIdx.x; F0.bx = bx; F0.vcu = (F0.G % 8 == 0) ? (bx % 8) * (F0.G / 8) + bx / 8 : bx; }
    for (int u = F0.tid; u < (LDS_BYTES - LDSCTL_OFF) / 4; u += NWAVES * 64) ((LAS unsigned*)(F0.lds + LDSCTL_OFF))[u] = 0u;
    __syncthreads();
    XcdBarrier bar; bar.bar = (GAS unsigned*)(KWS() + WS_CTL) + CW_BAR; bar.x = 0; bar.st = nullptr;
    if (!MK_PER_PHASE) bar = xcd_barrier_post((GAS unsigned*)(KWS() + WS_CTL) + CW_BAR, F0.MISC + 8);
    const int lo = args.ph_lo, hi = args.ph_hi;
    run_layer<0>(F0, bar, lo, hi);
    run_layer<1>(F0, bar, lo, hi);
}

extern "C" void kernel_launch(void* const* d_in, const int* in_sizes, int n_in, void* d_out, int out_size, void* d_ws, size_t ws_size, hipStream_t stream) {
    static int grid = 0;
    if (grid == 0) {
        if (n_in != 18 || out_size != T * D || ws_size < WS_END) { fprintf(stderr, "kernel_launch: unexpected shapes (n_in %d, out %d, ws %zu < %zu)\n", n_in, out_size, ws_size, (size_t)WS_END); grid = -1; return; }
        int dev = 0, cus = 0, per_cu = 0;
        if (hipGetDevice(&dev) != hipSuccess || hipDeviceGetAttribute(&cus, hipDeviceAttributeMultiprocessorCount, dev) != hipSuccess) { grid = -1; return; }
        if (hipFuncSetAttribute((const void*)hybrid_fwd, hipFuncAttributeMaxDynamicSharedMemorySize, LDS_BYTES) != hipSuccess) { fprintf(stderr, "kernel_launch: hipFuncSetAttribute failed\n"); grid = -1; return; }
        if (hipOccupancyMaxActiveBlocksPerMultiprocessor(&per_cu, (const void*)hybrid_fwd, NWAVES * 64, LDS_BYTES) != hipSuccess || per_cu < 1) { fprintf(stderr, "kernel_launch: occupancy query says %d\n", per_cu); per_cu = 1; }
        (void)hipGetLastError();
        grid = cus;
    }
    if (grid < 0) return;
    (void)hipMemsetAsync((char*)d_ws + WS_CTL, 0, CTL_ZERO_BYTES, stream);
    Args a{};
    for (int i = 0; i < 18; ++i) a.in[i] = (const float*)d_in[i];
    a.out = (float*)d_out; a.ws = (unsigned char*)d_ws;
#if MK_PER_PHASE
    for (int p = -1; p < N_PHASES; ++p) { a.ph_lo = p; a.ph_hi = p + 1; hipLaunchKernelGGL(hybrid_fwd, dim3(grid), dim3(NWAVES * 64), LDS_BYTES, stream, a); }
#else
    a.ph_lo = -1; a.ph_hi = N_PHASES;
    hipLaunchKernelGGL(hybrid_fwd, dim3(grid), dim3(NWAVES * 64), LDS_BYTES, stream, a);
#endif
}
```

```cpp
#include <hip/hip_runtime.h>
#include <cstdio>
#include <cstdint>
#include <cstddef>

#ifndef MK_PER_PHASE
#define MK_PER_PHASE 0
#endif

#define LAS __attribute__((address_space(3)))
#define GAS __attribute__((address_space(1)))
typedef unsigned short bf16_t;
typedef short bf16x8 __attribute__((ext_vector_type(8)));
typedef short s16x4 __attribute__((ext_vector_type(4)));
typedef float f32x2 __attribute__((ext_vector_type(2)));
typedef float f32x4 __attribute__((ext_vector_type(4)));
typedef float f32x16 __attribute__((ext_vector_type(16)));
typedef unsigned u32x2 __attribute__((ext_vector_type(2)));
typedef unsigned u32x4 __attribute__((ext_vector_type(4)));
typedef int v4i32 __attribute__((ext_vector_type(4)));
typedef int v8i32 __attribute__((ext_vector_type(8)));
typedef __bf16 bf16x2_t __attribute__((ext_vector_type(2)));
typedef GAS unsigned gu32;

constexpr int D = 2048, BATCH = 8, SEQ = 2048, T = BATCH * SEQ, DEPTH = 2;
constexpr int INW = 16384;
constexpr int NEXP = 32, EFF = 512;
constexpr float DN_ALPHA = 1.41421356237309515f;
constexpr float LN_EPS = 1e-5f, GN_EPS = 1e-6f;
constexpr float LOG2E = 1.44269504088896341f;

constexpr size_t MiB = 1u << 20;
constexpr size_t WS_CTL = 0, CTL_ZERO_BYTES = 1 * MiB;
constexpr size_t WS_ROPE = 1 * MiB;
constexpr size_t WS_WRT = 3 * MiB;
constexpr size_t WRT_GL = 196608, WRT_CS = 393216, WRT_C0 = WRT_CS + 256;
constexpr size_t WS_WIN = 4 * MiB;
constexpr size_t WS_WPM = 68 * MiB;
constexpr size_t WS_WPR = 72 * MiB;
constexpr size_t WS_WPE = 80 * MiB;
constexpr size_t WS_WO = 84 * MiB;
constexpr size_t WS_WKV = 372 * MiB;
constexpr size_t WS_WGU = 100 * MiB;
constexpr size_t WS_WDN = 228 * MiB;
constexpr size_t WS_MEMB = 292 * MiB;
constexpr size_t WS_KM = 300 * MiB;
constexpr size_t WS_VMT = 304 * MiB;
constexpr size_t WS_XB = 308 * MiB;
constexpr size_t WS_X1 = 372 * MiB;
constexpr size_t WS_X1B = 500 * MiB;
constexpr size_t WS_XN = 564 * MiB;
constexpr size_t WS_XB8 = WS_XN, WS_WIN8 = WS_XN + 32 * MiB, WS_XS = WS_XN + 96 * MiB;
constexpr float WQ_RANGE = 1.0f;
constexpr int CW_WMAX = 49152;
#ifndef F8_QK
#define F8_QK 1
#endif
constexpr int NF8X = F8_QK ? 12 : 4;
constexpr float GATE_WSCALE = 64.0f;
constexpr float MG8_SCALE = 16.0f;
constexpr float Y8_SCALE = 4.0f;
constexpr size_t WS_HPRE = 692 * MiB;
constexpr size_t WS_MACC = 820 * MiB;
constexpr size_t WS_MERGED = 948 * MiB;
constexpr size_t WS_YA = 1012 * MiB;
constexpr size_t WS_YR = 1044 * MiB;
constexpr size_t WS_YM = 1108 * MiB;
constexpr size_t WS_RO = 1140 * MiB;
constexpr size_t WS_RSTAT = 1204 * MiB;
constexpr size_t WS_PROJ = 1208 * MiB;
constexpr size_t WS_AQ = WS_PROJ, WS_AK = WS_AQ + 32 * MiB, WS_AVT = WS_AK + 32 * MiB, WS_RQ = WS_AVT + 32 * MiB, WS_RK = WS_RQ + 32 * MiB;
constexpr size_t WS_RVT = WS_RK + 32 * MiB, WS_RGS = WS_RVT + 64 * MiB, WS_MQ = WS_RGS + 64 * MiB, WS_SGA = WS_MQ + 32 * MiB, WS_SGR = WS_SGA + 64 * MiB, WS_SGM = WS_SGR + 64 * MiB;
constexpr size_t WS_PROJ_END = WS_SGM + 64 * MiB;
constexpr size_t WS_LIST = WS_PROJ;
constexpr size_t WS_TOKW = WS_PROJ + 2 * MiB;
constexpr size_t WS_HBUF = WS_PROJ + 4 * MiB;
constexpr size_t WS_YASG = WS_PROJ + 44 * MiB;
constexpr size_t WS_END = WS_PROJ_END;
static_assert(WS_PROJ_END == (1208 + 512) * MiB && WS_YASG + 128 * MiB <= WS_PROJ_END, "ws map");
constexpr int CW_BAR = 4096;
constexpr int CW_CNT = 16384;
constexpr int CW_FLAG = 32768;

constexpr int RING_BYTES = 131072;
constexpr int LDS_TAB = 158720;
constexpr int LDSCTL_OFF = LDS_TAB + 4096, MISC_OFF = LDSCTL_OFF + 320;
constexpr int LDS_BYTES = 163840;
constexpr int NWAVES = 8;

__device__ __forceinline__ unsigned pk2(float lo, float hi) { f32x2 v = {lo, hi}; bf16x2_t b = __builtin_convertvector(v, bf16x2_t); return __builtin_bit_cast(unsigned, b); }
__device__ __forceinline__ float bf_lo(unsigned w) { return __uint_as_float(w << 16); }
__device__ __forceinline__ float bf_hi(unsigned w) { return __uint_as_float(w & 0xffff0000u); }
__device__ __forceinline__ float wave_sum(float v) {
#pragma unroll
    for (int o = 1; o < 64; o <<= 1) v += __shfl_xor(v, o);
    return v;
}
__device__ __forceinline__ float wave_max(float v) {
#pragma unroll
    for (int o = 1; o < 64; o <<= 1) v = fmaxf(v, __shfl_xor(v, o));
    return v;
}
__device__ __forceinline__ unsigned pk_i8(float a, float b, float c, float d, float q) {
    unsigned w = 0;
    w = __builtin_amdgcn_cvt_pk_u8_f32(fminf(fmaxf(__builtin_rintf(a * q), -127.0f), 127.0f) + 128.0f, 0, w); w = __builtin_amdgcn_cvt_pk_u8_f32(fminf(fmaxf(__builtin_rintf(b * q), -127.0f), 127.0f) + 128.0f, 1, w);
    w = __builtin_amdgcn_cvt_pk_u8_f32(fminf(fmaxf(__builtin_rintf(c * q), -127.0f), 127.0f) + 128.0f, 2, w); w = __builtin_amdgcn_cvt_pk_u8_f32(fminf(fmaxf(__builtin_rintf(d * q), -127.0f), 127.0f) + 128.0f, 3, w);
    return w ^ 0x80808080u;
}
__device__ __forceinline__ float f8c(float x) { return __builtin_amdgcn_fmed3f(x, -440.0f, 440.0f); }
__device__ __forceinline__ float fast_exp2(float x) { return __builtin_amdgcn_exp2f(x); }
__device__ __forceinline__ float max3f(float a, float b, float c) { float r; asm("v_max3_f32 %0, %1, %2, %3" : "=v"(r) : "v"(a), "v"(b), "v"(c)); return r; }
__device__ __forceinline__ float sigmoidf_(float x) { return __builtin_amdgcn_rcpf(1.0f + __builtin_amdgcn_exp2f(-LOG2E * x)); }
#define LDS_WAIT() asm volatile("s_waitcnt lgkmcnt(0)" ::: "memory")
#define VM_WAIT() asm volatile("s_waitcnt vmcnt(0)" ::: "memory")

#define XB_TMO      128
#define XB_XCNT(j)  (256  + 64 * (j))
#define XB_XSUB(j)  (1280 + 64 * (j))
#define XB_XGEN(j)  (2304 + 64 * (j))
#define XB_TOP      3328
#define XB_TOPGEN   3392
#define XCD_BAR_WORDS 3456
#define XB_SPIN_CAP (1u << 18)
__device__ __forceinline__ unsigned xb_ld(GAS unsigned* p)              { return __hip_atomic_load(p, __ATOMIC_RELAXED, __HIP_MEMORY_SCOPE_AGENT); }
__device__ __forceinline__ unsigned xb_add(GAS unsigned* p, unsigned v) { return __hip_atomic_fetch_add(p, v, __ATOMIC_RELAXED, __HIP_MEMORY_SCOPE_AGENT); }
__device__ __forceinline__ unsigned xb_xcc_id() { return (unsigned)__builtin_amdgcn_s_getreg((3 << 11) | 20) & 0xFu; }
#define XB_SPIN(cond, bar) do { unsigned _sp = 0; while (cond) { __builtin_amdgcn_s_sleep(1); \
    if ((++_sp & 255u) == 0u) { if (xb_ld(&(bar)[XB_TMO])) break; if (_sp > XB_SPIN_CAP) { (void)xb_add(&(bar)[XB_TMO], 1u); break; } } } } while (0)
struct XcdBarrier { GAS unsigned* bar; unsigned x; volatile LAS unsigned* st; };
__device__ __forceinline__ XcdBarrier xcd_barrier_post(GAS unsigned* bar, volatile LAS unsigned* st) {
    XcdBarrier b; b.bar = bar; b.x = xb_xcc_id(); b.st = st;
    if (threadIdx.x == 0) (void)xb_add(&bar[XB_XCNT(b.x)], 1u);
    return b;
}
__device__ __forceinline__ void xcd_barrier_complete(GAS unsigned* bar, unsigned x, unsigned& nloc, unsigned& nx) {
    const unsigned G = gridDim.x * gridDim.y * gridDim.z;
    unsigned sum, cnt, mine, sp = 0u;
    for (;;) {
        sum = 0u; cnt = 0u; mine = 0u;
#pragma unroll
        for (unsigned j = 0; j < 16; ++j) { const unsigned c = xb_ld(&bar[XB_XCNT(j)]); sum += c; cnt += (c > 0u) ? 1u : 0u; mine = (j == x) ? c : mine; }
        if (sum == G) break;
        __builtin_amdgcn_s_sleep(1);
        if ((++sp & 255u) == 0u) { if (xb_ld(&bar[XB_TMO])) break; if (sp > XB_SPIN_CAP) { (void)xb_add(&bar[XB_TMO], 1u); break; } }
    }
    nloc = mine > 0u ? mine : 1u; nx = cnt > 0u ? cnt : 1u;
}
__device__ __forceinline__ void xcd_barrier(const XcdBarrier& b) {
    asm volatile("s_waitcnt vmcnt(0)" ::: "memory");
    __syncthreads();
    if (threadIdx.x == 0) {
        GAS unsigned* bar = b.bar; asm volatile("" : "+s"(bar));
        __builtin_amdgcn_s_waitcnt(0);
        unsigned nloc = b.st[0], nx = b.st[1];
        if (nloc == 0u) { xcd_barrier_complete(bar, b.x, nloc, nx); b.st[0] = nloc; b.st[1] = nx; }
        const unsigned old = xb_add(&bar[XB_XSUB(b.x)], 1u);
        const unsigned gen = old / nloc;
        if (old + 1u == (gen + 1u) * nloc) {
            __builtin_amdgcn_fence(__ATOMIC_RELEASE, "agent");
            asm volatile("s_waitcnt vmcnt(0)" ::: "memory");
            const unsigned og = xb_add(&bar[XB_TOP], 1u);
            const unsigned tg = og / nx;
            if (og + 1u == (tg + 1u) * nx) xb_add(&bar[XB_TOPGEN], 1u);
            else XB_SPIN(xb_ld(&bar[XB_TOPGEN]) == tg, bar);
            __builtin_amdgcn_fence(__ATOMIC_ACQUIRE, "agent");
            xb_add(&bar[XB_XGEN(b.x)], 1u);
            asm volatile("s_waitcnt vmcnt(0)" ::: "memory");
        } else {
            XB_SPIN(xb_ld(&bar[XB_XGEN(b.x)]) == gen, bar);
            __builtin_amdgcn_fence(__ATOMIC_ACQUIRE, "agent");
            asm volatile("s_waitcnt vmcnt(0)" ::: "memory");
        }
    }
    __syncthreads();
}

namespace pg8 {
constexpr int BM = 256, BK = 64, HALF = 128, HTB = HALF * BK * 2, STAGE_BYTES = 8 * HTB, NXCD = 8, WGM = 8;
__host__ __device__ __forceinline__ int lds_byte(int r, int c) { const int st = (r >> 4) * 2 + (c >> 5), rr = r & 15, cc = c & 31, ob = rr * 64 + cc * 2; return st * 1024 + (ob ^ (((ob >> 9) & 1) << 5)); }
__host__ __device__ __forceinline__ void stage_rc(int b, int& R, int& C) { const int st = b / 1024, sb = b % 1024, swz = sb ^ (((sb >> 9) & 1) << 5); R = (st >> 1) * 16 + swz / 64; C = (st & 1) * 32 + (swz % 64) / 2; }
__host__ __device__ __forceinline__ int perm32(int rho) { const int n = rho >> 4, i = rho & 15; return 8 * (i >> 2) + 4 * n + (i & 3); }

struct Unit {
    const GAS char* A; const GAS char* B; int pm, pn; int aux, nvalid; const GAS int* gather;
    unsigned lda, ldb; int K;
};
__device__ __forceinline__ void static_tile(int L, int nM, int nN, int& pm, int& pn) {
    const int nwg = nM * nN; int wgid = L;
    { const int q = nwg / NXCD, r = nwg % NXCD, xcd = wgid % NXCD, off = wgid / NXCD; wgid = (xcd < r ? xcd * (q + 1) : r * (q + 1) + (xcd - r) * q) + off; }
    const int nig = WGM * nN, gid = wgid / nig, fm = gid * WGM, gsz = (nM - fm) < WGM ? (nM - fm) : WGM;
    pm = fm + ((wgid % nig) % gsz); pn = (wgid % nig) / gsz;
}

template <int QM_> struct Frag { using T = bf16x8; static constexpr int NK = 2;
    static __device__ __forceinline__ T ld(const LAS unsigned char* p, int k) { return *(const LAS bf16x8*)(p + k * 1024); } };
template <> struct Frag<2> { using T = v4i32; static constexpr int NK = 2;
    static __device__ __forceinline__ T ld(const LAS unsigned char* p, int k) { return *(const LAS v4i32*)(p + k * 1024); } };
__device__ __forceinline__ f32x4 mma_frag(v4i32 a, v4i32 b, f32x4 c) { return __builtin_bit_cast(f32x4, __builtin_amdgcn_mfma_i32_16x16x64_i8(a, b, __builtin_bit_cast(v4i32, c), 0, 0, 0)); }
template <> struct Frag<1> { using T = v8i32; static constexpr int NK = 1;
    static __device__ __forceinline__ T ld(const LAS unsigned char* p, int) { return __builtin_shufflevector(*(const LAS v4i32*)(p), *(const LAS v4i32*)(p + 1024), 0, 1, 2, 3, 4, 5, 6, 7); } };
__device__ __forceinline__ f32x4 mma_frag(bf16x8 a, bf16x8 b, f32x4 c) { return __builtin_amdgcn_mfma_f32_16x16x32_bf16(a, b, c, 0, 0, 0); }
__device__ __forceinline__ f32x4 mma_frag(v8i32 a, v8i32 b, f32x4 c) { const unsigned sc_ = 0x7F7F7F7Fu;
    asm volatile("v_mfma_scale_f32_16x16x128_f8f6f4 %0, %1, %2, %0, %3, %3 op_sel_hi:[0,0,0]" : "+v"(c) : "v"(a), "v"(b), "v"(sc_)); return c; }
template <class S, bool Dp = S::DEP> struct DepWait { static __device__ __forceinline__ void go(const S&, const Unit&) {} };
template <class S> struct DepWait<S, true> { static __device__ __forceinline__ void go(const S& s, const Unit& u) { s.acquire(u); } };
template <class E_, bool Kp = E_::KEEP> struct EpiCall { static __device__ __forceinline__ bool go(const E_& e, f32x4 (&acc)[2][2][4][2], const Unit& u, int wr, int wc, int fr, int fq) { e(acc, u, wr, wc, fr, fq); return false; } };
template <class E_> struct EpiCall<E_, true> { static __device__ __forceinline__ bool go(const E_& e, f32x4 (&acc)[2][2][4][2], const Unit& u, int wr, int wc, int fr, int fq) { return e.merge(acc, u, wr, wc, fr, fq); } };
template <class Epi, class Sched, bool SWAP>
__device__ __forceinline__ void gemm_phase(LAS unsigned char* lds, const Sched& S, const Epi& E) {
    constexpr bool VARLD = Sched::VARLD, GATHER = Sched::GATHER, DYN = VARLD || GATHER;
    int tid = threadIdx.x; asm volatile("" : "+v"(tid));
    const int wid = __builtin_amdgcn_readfirstlane(tid >> 6), lane = tid & 63, wr = wid >> 2, wc = wid & 3, fr = lane & 15, fq = lane >> 4;
    int RA[2], CA[2], RB[2];
#pragma unroll
    for (int i = 0; i < 2; ++i) { int R, C; stage_rc(tid * 16 + i * 8192, R, C); RA[i] = R; CA[i] = C * 2; RB[i] = Epi::PERM ? ((R & ~31) + perm32(R & 31)) : R; }
    const unsigned ldsw = (unsigned)wid * 1024u;
    const int aoff = lds_byte(wr * 64 + fr, fq * 8), boff = lds_byte(wc * 32 + fr, fq * 8);
    constexpr size_t kstep = (size_t)(BK * 2);
#define PG8_SA(b, h) (((b) * 2 + (h)) * HTB)
#define PG8_SB(b, h) ((4 + (b) * 2 + (h)) * HTB)
#define PG8_GL(bufoff, gptr, i) __builtin_amdgcn_global_load_lds((const GAS unsigned*)(gptr), (LAS unsigned*)(lds + (bufoff) + ldsw + (i) * 8192), 16, 0, 0)
#define PG8_STAGE2(bufoff, p, oa, ob) do { PG8_GL(bufoff, (p) + (oa), 0); PG8_GL(bufoff, (p) + (ob), 1); } while (0)
#define PG8_LDA(dst, b, h) do { _Pragma("unroll") for (int m = 0; m < 4; ++m) _Pragma("unroll") for (int k = 0; k < NK; ++k) dst[m][k] = FR::ld(lds + PG8_SA(b, h) + aoff + m * 2048, k); } while (0)
#define PG8_LDB(dst, b, h) do { _Pragma("unroll") for (int n = 0; n < 2; ++n) _Pragma("unroll") for (int k = 0; k < NK; ++k) dst[n][k] = FR::ld(lds + PG8_SB(b, h) + boff + n * 2048, k); } while (0)
#define PG8_MM(ai, bj, At, Bt) do { __builtin_amdgcn_s_setprio(1); _Pragma("unroll") for (int m = 0; m < 4; ++m) _Pragma("unroll") for (int n = 0; n < 2; ++n) _Pragma("unroll") for (int k = 0; k < NK; ++k) \
        acc[ai][bj][m][n] = SWAP ? mma_frag(At[m][k], Bt[n][k], acc[ai][bj][m][n]) : mma_frag(Bt[n][k], At[m][k], acc[ai][bj][m][n]); __builtin_amdgcn_s_setprio(0); } while (0)
#define PG8_WAIT_V(n) asm volatile("s_waitcnt vmcnt(" #n ")" ::: "memory")
#define PG8_WAIT_L(n) asm volatile("s_waitcnt lgkmcnt(" #n ")" ::: "memory")
#define PG8_BAR __builtin_amdgcn_s_barrier()
#define PG8_SCHED __builtin_amdgcn_sched_barrier(0)
#define PG8_UCOPY(d, s_) do { (d).A = (s_).A; (d).B = (s_).B; (d).pm = (s_).pm; (d).pn = (s_).pn; (d).aux = (s_).aux; (d).nvalid = (s_).nvalid; (d).gather = (s_).gather; (d).lda = (s_).lda; (d).ldb = (s_).ldb; (d).K = (s_).K; } while (0)
#define PG8_UINIT(d) do { (d).A = nullptr; (d).B = nullptr; (d).pm = 0; (d).pn = 0; (d).aux = 0; (d).nvalid = 256; (d).gather = nullptr; (d).lda = 0; (d).ldb = 0; (d).K = 256; } while (0)
    Unit cur, nxt, tmp; int ui = 0;
    PG8_UINIT(cur); PG8_UINIT(nxt);
    if (!S.next(0, cur)) return;
    f32x4 acc[2][2][4][2];
#pragma unroll
    for (int a = 0; a < 2; ++a)
#pragma unroll
        for (int b = 0; b < 2; ++b)
#pragma unroll
            for (int m = 0; m < 4; ++m)
#pragma unroll
                for (int n = 0; n < 2; ++n) acc[a][b][m][n] = (f32x4){0.f, 0.f, 0.f, 0.f};
    using FR = Frag<Sched::F8 ? 1 : (Sched::I8 ? 2 : 0)>; constexpr int NK = FR::NK;
    typename FR::T At[4][NK], B0[2][NK], B1[2][NK];
    unsigned cA0, cA1, cA2 = 0, cA3 = 0, cB0, cB1, nA0 = 0, nA1 = 0, nA2 = 0, nA3 = 0, nB0 = 0, nB1 = 0;
    size_t chA, chB, nhA = 0, nhB = 0;
#define PG8_OFFS(u, a0, a1, a2, a3, b0, b1, hA_, hB_) do { \
        const unsigned lda_ = VARLD ? (u).lda : Sched::LDA, ldb_ = VARLD ? (u).ldb : Sched::LDB; \
        if (GATHER) { const int r0 = RA[0], r1 = RA[1]; \
            const int i0 = r0 < (u).nvalid ? ((u).gather[r0] >> 1) : 0, i1 = r1 < (u).nvalid ? ((u).gather[r1] >> 1) : 0; \
            const int i2 = (r0 + 128) < (u).nvalid ? ((u).gather[r0 + 128] >> 1) : 0, i3 = (r1 + 128) < (u).nvalid ? ((u).gather[r1 + 128] >> 1) : 0; \
            a0 = (unsigned)i0 * lda_ + CA[0]; a1 = (unsigned)i1 * lda_ + CA[1]; a2 = (unsigned)i2 * lda_ + CA[0]; a3 = (unsigned)i3 * lda_ + CA[1]; hA_ = 0; } \
        else { a0 = (unsigned)RA[0] * lda_ + CA[0]; a1 = (unsigned)RA[1] * lda_ + CA[1]; hA_ = (size_t)128 * lda_; } \
        b0 = (unsigned)RB[0] * ldb_ + CA[0]; b1 = (unsigned)RB[1] * ldb_ + CA[1]; hB_ = (size_t)128 * ldb_; } while (0)
    PG8_OFFS(cur, cA0, cA1, cA2, cA3, cB0, cB1, chA, chB);
    const GAS char* cA = cur.A; const GAS char* cB = cur.B;
    DepWait<Sched>::go(S, cur);
#define PG8_A0(buf, p, X) PG8_STAGE2(buf, p, X##A0, X##A1)
#define PG8_A1(buf, p, X) do { if (GATHER) PG8_STAGE2(buf, p, X##A2, X##A3); else PG8_STAGE2(buf, (p) + X##hA, X##A0, X##A1); } while (0)
#define PG8_B0(buf, p, X) PG8_STAGE2(buf, p, X##B0, X##B1)
#define PG8_B1(buf, p, X) PG8_STAGE2(buf, (p) + X##hB, X##B0, X##B1)
    PG8_B0(PG8_SB(0, 0), cB, c); PG8_B1(PG8_SB(0, 1), cB, c); PG8_A0(PG8_SA(0, 0), cA, c); PG8_A1(PG8_SA(0, 1), cA, c);
    if (wr == 1) PG8_BAR;
    PG8_WAIT_V(2); PG8_BAR;
    PG8_B0(PG8_SB(1, 0), cB + kstep, c); PG8_A0(PG8_SA(1, 0), cA + kstep, c); PG8_B1(PG8_SB(1, 1), cB + kstep, c);
    PG8_WAIT_V(6); PG8_BAR;
    for (;;) {
        PG8_UINIT(tmp); const bool has_next = S.next(ui + 1, tmp);
        if (has_next) { PG8_UCOPY(nxt, tmp); } else { PG8_UCOPY(nxt, cur); }
        if (DYN) { if (has_next) { PG8_OFFS(nxt, nA0, nA1, nA2, nA3, nB0, nB1, nhA, nhB); } else { nA0 = cA0; nA1 = cA1; nA2 = cA2; nA3 = cA3; nB0 = cB0; nB1 = cB1; nhA = chA; nhB = chB; } }
        const GAS char* nA = nxt.A; const GAS char* nB = nxt.B;
        const int nt = (VARLD ? cur.K : Sched::KK) / BK;
        for (int t = 0; t < nt; t += 2) {
            const bool last = (t == nt - 2);
            if (Sched::DEP && last && has_next) DepWait<Sched>::go(S, nxt);
            const GAS char* a1 = cA + (size_t)(t + 1) * kstep;
            const GAS char* a2 = last ? nA : cA + (size_t)(t + 2) * kstep; const GAS char* b2 = last ? nB : cB + (size_t)(t + 2) * kstep;
            const GAS char* a3 = a2 + kstep; const GAS char* b3 = b2 + kstep;
            const unsigned sA0 = DYN ? (last ? nA0 : cA0) : cA0, sA1 = DYN ? (last ? nA1 : cA1) : cA1, sA2 = GATHER ? (last ? nA2 : cA2) : 0u, sA3 = GATHER ? (last ? nA3 : cA3) : 0u;
            const unsigned sB0 = VARLD ? (last ? nB0 : cB0) : cB0, sB1 = VARLD ? (last ? nB1 : cB1) : cB1;
            const size_t shA = VARLD ? (last ? nhA : chA) : chA, shB = VARLD ? (last ? nhB : chB) : chB;
            (void)sA2; (void)sA3;
            PG8_LDB(B0, 0, 0); PG8_LDB(B1, 0, 1); PG8_SCHED; PG8_LDA(At, 0, 0); PG8_A1(PG8_SA(1, 1), a1, c);
            PG8_WAIT_V(8); PG8_WAIT_L(0); PG8_BAR; PG8_MM(0, 0, At, B0); PG8_MM(0, 1, At, B1); PG8_BAR; PG8_SCHED;
            PG8_LDA(At, 0, 1); PG8_B0(PG8_SB(0, 0), b2, s); PG8_B1(PG8_SB(0, 1), b2, s); PG8_A0(PG8_SA(0, 0), a2, s);
            PG8_WAIT_V(8); PG8_WAIT_L(0); PG8_BAR; PG8_MM(1, 0, At, B0); PG8_MM(1, 1, At, B1); PG8_BAR; PG8_SCHED;
            PG8_LDB(B0, 1, 0); PG8_LDB(B1, 1, 1); PG8_SCHED; PG8_LDA(At, 1, 0); PG8_A1(PG8_SA(0, 1), a2, s);
            PG8_WAIT_V(8); PG8_WAIT_L(0); PG8_BAR; PG8_MM(0, 0, At, B0); PG8_MM(0, 1, At, B1); PG8_BAR; PG8_SCHED;
            PG8_LDA(At, 1, 1); PG8_B0(PG8_SB(1, 0), b3, s); PG8_B1(PG8_SB(1, 1), b3, s); PG8_A0(PG8_SA(1, 0), a3, s);
            PG8_WAIT_V(8); PG8_WAIT_L(0); PG8_BAR; PG8_MM(1, 0, At, B0); PG8_MM(1, 1, At, B1); PG8_BAR; PG8_SCHED;
        }
        if (wr == 0) PG8_BAR;
        const bool keep = EpiCall<Epi>::go(E, acc, cur, wr, wc, fr, fq);
        if (!has_next) break;
        if (!keep) {
#pragma unroll
        for (int a = 0; a < 2; ++a)
#pragma unroll
            for (int b = 0; b < 2; ++b)
#pragma unroll
                for (int m = 0; m < 4; ++m)
#pragma unroll
                    for (int n = 0; n < 2; ++n) acc[a][b][m][n] = (f32x4){0.f, 0.f, 0.f, 0.f}; }
        PG8_UCOPY(cur, nxt); cA = nA; cB = nB; ++ui;
        if (DYN) { cA0 = nA0; cA1 = nA1; cA2 = nA2; cA3 = nA3; cB0 = nB0; cB1 = nB1; chA = nhA; chB = nhB; }
        if (wr == 1) PG8_BAR;
    }
    PG8_WAIT_V(0);
    PG8_BAR;
#undef PG8_SA
#undef PG8_SB
#undef PG8_GL
#undef PG8_STAGE2
#undef PG8_A0
#undef PG8_A1
#undef PG8_B0
#undef PG8_B1
#undef PG8_LDA
#undef PG8_LDB
#undef PG8_MM
#undef PG8_WAIT_V
#undef PG8_WAIT_L
#undef PG8_BAR
#undef PG8_SCHED
#undef PG8_OFFS
#undef PG8_UCOPY
#undef PG8_UINIT
}
}

struct Args {
    const float* in[18]; float* out; unsigned char* ws; int ph_lo, ph_hi;
};
struct Frame {
    LAS unsigned char* lds; volatile LAS unsigned* MISC;
    int tid, lane, wave, vcu, G, bx;
};
__device__ __forceinline__ Frame phase_frame(const Frame& F0) {
    Frame F = F0; int t = F0.tid, v = F0.vcu, g = F0.G, b = (int)blockIdx.x;
    asm volatile("" : "+v"(t)); asm volatile("" : "+s"(v)); asm volatile("" : "+s"(g)); asm volatile("" : "+s"(b));
    F.tid = t; F.lane = t & 63; F.wave = __builtin_amdgcn_readfirstlane(t >> 6); F.vcu = v; F.G = g; F.bx = b; return F;
}
template <int OFF> __device__ __forceinline__ const void* karg_ptr() {
    const void* p; auto ka = __builtin_amdgcn_kernarg_segment_ptr();
    asm volatile("s_load_dwordx2 %0, %1, %2\n\ts_waitcnt lgkmcnt(0)" : "=s"(p) : "s"(ka), "i"(OFF) : "memory");
#if defined(__HIP_DEVICE_COMPILE__)
    __builtin_assume(!__builtin_amdgcn_is_shared(p)); __builtin_assume(!__builtin_amdgcn_is_private(p));
#endif
    return p;
}
#define KIN(i) ((const GAS float*)karg_ptr<8 * (i)>())
#define KOUT() ((GAS float*)karg_ptr<144>())
#define KWS() ((GAS unsigned char*)karg_ptr<152>())
static_assert(offsetof(Args, out) == 144 && offsetof(Args, ws) == 152 && offsetof(Args, ph_lo) == 160, "Args layout");

__device__ __forceinline__ void transpose_item(const GAS float* W, int K, int N, GAS bf16_t* WT, int drow0, LAS float* scr, int kb, int nb, int lane, int f8 = 0, float wq = 0.f) {
    const int k0 = 64 * kb, n0 = 32 * nb;
    { const int n4 = lane & 7, kr = lane >> 3; const GAS float* src = W + (size_t)(k0 + kr) * N + n0 + 4 * n4; f32x4 v[8];
#pragma unroll
      for (int i = 0; i < 8; ++i) v[i] = __builtin_nontemporal_load((const GAS f32x4*)(src + (size_t)(8 * i) * N));
#pragma unroll
      for (int i = 0; i < 8; ++i) { LAS float* d = scr + (8 * i + kr) * 33 + 4 * n4; d[0] = v[i][0]; d[1] = v[i][1]; d[2] = v[i][2]; d[3] = v[i][3]; } }
    LDS_WAIT(); asm volatile("" ::: "memory");
    const int c = lane & 7;
#pragma unroll
    for (int j = 0; j < 4; ++j) { const int n = (lane >> 3) + 8 * j; const LAS float* s = scr + (8 * c) * 33 + n;
        if (f8 == 2) {
            unsigned lo_ = 0, hi_ = 0;
            lo_ = __builtin_amdgcn_cvt_pk_fp8_f32(f8c(s[0 * 33] * wq), f8c(s[1 * 33] * wq), lo_, false); lo_ = __builtin_amdgcn_cvt_pk_fp8_f32(f8c(s[2 * 33] * wq), f8c(s[3 * 33] * wq), lo_, true);
            hi_ = __builtin_amdgcn_cvt_pk_fp8_f32(f8c(s[4 * 33] * wq), f8c(s[5 * 33] * wq), hi_, false); hi_ = __builtin_amdgcn_cvt_pk_fp8_f32(f8c(s[6 * 33] * wq), f8c(s[7 * 33] * wq), hi_, true);
            *(GAS u32x2*)((GAS unsigned char*)WT + (size_t)(drow0 + n) * K + k0 + 8 * c) = (u32x2){lo_, hi_}; continue; }
        if (f8) {
            const unsigned lo_ = pk_i8(s[0 * 33], s[1 * 33], s[2 * 33], s[3 * 33], wq), hi_ = pk_i8(s[4 * 33], s[5 * 33], s[6 * 33], s[7 * 33], wq);
            *(GAS u32x2*)((GAS unsigned char*)WT + (size_t)(drow0 + n) * K + k0 + 8 * c) = (u32x2){lo_, hi_}; continue; }
        u32x4 o; o.x = pk2(s[0 * 33], s[1 * 33]); o.y = pk2(s[2 * 33], s[3 * 33]); o.z = pk2(s[4 * 33], s[5 * 33]); o.w = pk2(s[6 * 33], s[7 * 33]);
        *(GAS u32x4*)(WT + (size_t)(drow0 + n) * K + k0 + 8 * c) = o; }
    LDS_WAIT(); asm volatile("" ::: "memory");
}
__device__ __forceinline__ void sincos_d(double a, float& sn, float& cs) {
    const double kf = __builtin_rint(a * 0.63661977236758134308);
    const double r = (a - kf * 1.57079632679489655800) - kf * 6.123233995736766036e-17;
    const double r2 = r * r;
    double s = r * (1.0 + r2 * (-1.0 / 6 + r2 * (1.0 / 120 + r2 * (-1.0 / 5040 + r2 * (1.0 / 362880 + r2 * (-1.0 / 39916800 + r2 * (1.0 / 6227020800.0)))))));
    double c = 1.0 + r2 * (-0.5 + r2 * (1.0 / 24 + r2 * (-1.0 / 720 + r2 * (1.0 / 40320 + r2 * (-1.0 / 3628800 + r2 * (1.0 / 479001600.0 + r2 * (-1.0 / 87178291200.0)))))));
    const int q = ((int)kf) & 3;
    const double ss = (q == 0) ? s : (q == 1) ? c : (q == 2) ? -s : -c;
    const double cc = (q == 0) ? c : (q == 1) ? -s : (q == 2) ? -c : s;
    sn = (float)ss; cs = (float)cc;
}
__device__ __forceinline__ void phase_w0a(Frame& F) {
    LAS float* scr = (LAS float*)(F.lds + F.wave * 16384); GAS unsigned char* ws = KWS();
    const int gw = F.vcu * NWAVES + F.wave, NGW = F.G * NWAVES; constexpr int I_KV = (D / 64) * (2048 / 32);
    for (int it = gw; it < DEPTH * I_KV; it += NGW) { const int l = it / I_KV, r = it % I_KV, nblk = 2048 / 32;
        transpose_item(KIN(6) + (size_t)l * D * 2048, D, 2048, (GAS bf16_t*)(ws + WS_WKV) + (size_t)l * 2048 * D, 32 * (r % nblk), scr, r / nblk, r % nblk, F.lane); }
    const size_t gt = (size_t)F.vcu * 512 + F.tid, GT = (size_t)F.G * 512;
    { static_assert(DEPTH == 2, "two layers sampled together"); constexpr size_t NW = (size_t)D * INW / 64;
      const GAS f32x4* wv0 = (const GAS f32x4*)KIN(2); const GAS f32x4* wv1 = wv0 + (size_t)D * INW / 4; float mx0 = 0.f, mx1 = 0.f;
      for (size_t i = gt; i < NW; i += 4 * GT) { f32x4 v[8];
#pragma unroll
          for (int k = 0; k < 4; ++k) { const size_t j = i + (size_t)k * GT, jj = (j < NW) ? j : gt; const size_t jv = ((jj >> 3) << 7) + (jj & 7); v[k] = __builtin_nontemporal_load(wv0 + jv); v[4 + k] = __builtin_nontemporal_load(wv1 + jv); }
#pragma unroll
          for (int k = 0; k < 4; ++k) { mx0 = fmaxf(fmaxf(mx0, fmaxf(fabsf(v[k].x), fabsf(v[k].y))), fmaxf(fabsf(v[k].z), fabsf(v[k].w)));
              mx1 = fmaxf(fmaxf(mx1, fmaxf(fabsf(v[4 + k].x), fabsf(v[4 + k].y))), fmaxf(fabsf(v[4 + k].z), fabsf(v[4 + k].w))); } }
      mx0 = wave_max(mx0); mx1 = wave_max(mx1);
      if (F.lane == 0) { (void)__hip_atomic_fetch_max((GAS unsigned*)(ws + WS_CTL) + CW_WMAX, __float_as_uint(mx0), __ATOMIC_RELAXED, __HIP_MEMORY_SCOPE_AGENT);
          (void)__hip_atomic_fetch_max((GAS unsigned*)(ws + WS_CTL) + CW_WMAX + 1, __float_as_uint(mx1), __ATOMIC_RELAXED, __HIP_MEMORY_SCOPE_AGENT); } }
    { const GAS f32x4* x = (const GAS f32x4*)KIN(1); GAS u32x4* xb = (GAS u32x4*)(ws + WS_MEMB); constexpr size_t NM = (size_t)2048 * D / 8;
      for (size_t i = gt; i < NM; i += 4 * GT) { f32x4 a[4], b[4];
#pragma unroll
          for (int k = 0; k < 4; ++k) { const size_t j = i + (size_t)k * GT, jj = (j < NM) ? j : gt; a[k] = x[2 * jj]; b[k] = x[2 * jj + 1]; }
#pragma unroll
          for (int k = 0; k < 4; ++k) { const size_t j = i + (size_t)k * GT; u32x4 o; o.x = pk2(a[k].x, a[k].y); o.y = pk2(a[k].z, a[k].w); o.z = pk2(b[k].x, b[k].y); o.w = pk2(b[k].z, b[k].w); if (j < NM) xb[j] = o; } } }
}
constexpr int KV_WGS = 64;
__device__ __forceinline__ void phase_w(Frame& F, int l) {
    LAS float* scr = (LAS float*)(F.lds + F.wave * 16384);
    GAS unsigned char* ws = KWS();
    const GAS float* w_in = KIN(2) + (size_t)l * D * INW; const GAS float* p_moba = KIN(3) + (size_t)l * 1024 * D; const GAS float* p_ret = KIN(4) + (size_t)l * 2048 * D;
    const GAS float* p_mem = KIN(5) + (size_t)l * 1024 * D; const GAS float* w_o = KIN(7) + (size_t)l * D * D;
    const GAS float* w_gu = KIN(14) + (size_t)l * NEXP * D * 1024; const GAS float* w_dn = KIN(15) + (size_t)l * NEXP * EFF * D;
    constexpr int I_IN = (D / 64) * (INW / 32), I_PM = (1024 / 64) * (D / 32), I_PR = (2048 / 64) * (D / 32), I_PE = I_PM, I_WO = (D / 64) * (D / 32);
    constexpr int I_GU1 = (D / 64) * (1024 / 32), I_GU = NEXP * I_GU1, I_DN1 = (EFF / 64) * (D / 32), I_DN = NEXP * I_DN1;
    constexpr int NITEMS = I_IN + I_PM + I_PR + I_PE + I_WO + I_GU + I_DN;
    const float wmax_in = fmaxf(WQ_RANGE * __uint_as_float(xb_ld((GAS unsigned*)(ws + WS_CTL) + CW_WMAX + l)), 1e-30f), wq_in = 127.0f / wmax_in;
    const bool skew = (F.G > KV_WGS); const int NA = skew ? (int)(0.77f * NITEMS) : NITEMS;
    const int nA = (NA - (F.vcu * NWAVES + F.wave) + F.G * NWAVES - 1) / (F.G * NWAVES);
    const int gwB = (F.vcu - KV_WGS) * NWAVES + F.wave, NGWB = (F.G - KV_WGS) * NWAVES;
    const int nB = (skew && F.vcu >= KV_WGS) ? (NITEMS - NA - gwB + NGWB - 1) / NGWB : 0;
    for (int ii = 0; ii < nA + nB; ++ii) {
        int r = ii < nA ? (F.vcu * NWAVES + F.wave) + ii * (F.G * NWAVES) : NA + gwB + (ii - nA) * NGWB;
        if (r < I_IN) { const int nblk = INW / 32;
            const int NGW_ = F.G * NWAVES; int kb_ = r / nblk, nb_ = r % nblk;
            if (I_IN % (2 * NGW_) == 0 && NGW_ % nblk == 0) { const int w_ = r % NGW_, q_ = w_ + NGW_ * (ii >> 1); nb_ = q_ % nblk; kb_ = 2 * (q_ / nblk) + (ii & 1); }
            transpose_item(w_in, D, INW, (GAS bf16_t*)(ws + WS_WIN8), 32 * nb_, scr, kb_, nb_, F.lane, 1, wq_in); continue; } r -= I_IN;
        if (r < I_PM) { const int nblk = D / 32; transpose_item(p_moba, 1024, D, (GAS bf16_t*)(ws + WS_WPM), 32 * (r % nblk), scr, r / nblk, r % nblk, F.lane, 2, GATE_WSCALE); continue; } r -= I_PM;
        if (r < I_PR) { const int nblk = D / 32; transpose_item(p_ret, 2048, D, (GAS bf16_t*)(ws + WS_WPR), 32 * (r % nblk), scr, r / nblk, r % nblk, F.lane, 2, GATE_WSCALE); continue; } r -= I_PR;
        if (r < I_PE) { const int nblk = D / 32; transpose_item(p_mem, 1024, D, (GAS bf16_t*)(ws + WS_WPE), 32 * (r % nblk), scr, r / nblk, r % nblk, F.lane, 2, GATE_WSCALE); continue; } r -= I_PE;
        if (r < I_WO) { const int nblk = D / 32; transpose_item(w_o, D, D, (GAS bf16_t*)(ws + WS_WO), 32 * (r % nblk), scr, r / nblk, r % nblk, F.lane, 2, GATE_WSCALE); continue; } r -= I_WO;
        if (r < I_GU) { const int e = r / I_GU1, q = r % I_GU1, nblk = 1024 / 32, nb = q % nblk, kb = q / nblk; const int n0 = 32 * nb;
            const int f = n0 & 511, drow = 256 * (f >> 7) + (f & 127) + ((n0 >= 512) ? 128 : 0);
            transpose_item(w_gu + (size_t)e * D * 1024, D, 1024, (GAS bf16_t*)(ws + WS_WGU) + (size_t)e * 1024 * D, drow, scr, kb, nb, F.lane); continue; } r -= I_GU;
        { const int e = r / I_DN1, q = r % I_DN1, nblk = D / 32; transpose_item(w_dn + (size_t)e * EFF * D, EFF, D, (GAS bf16_t*)(ws + WS_WDN + (size_t)e * D * EFF), 32 * (q % nblk), scr, q / nblk, q % nblk, F.lane, 2, GATE_WSCALE); }
    }
    { const GAS float* wg = KIN(10) + (size_t)l * D * 4; const GAS float* we = KIN(12) + (size_t)l * D * NEXP;
      const GAS float* g1 = KIN(8) + (size_t)l * D; const GAS float* b1 = KIN(9) + (size_t)l * D; const GAS float* bg = KIN(11) + (size_t)l * 4; const GAS float* be = KIN(13) + (size_t)l * NEXP;
      GAS bf16_t* wgh = (GAS bf16_t*)(ws + WS_WRT); GAS bf16_t* wgl = (GAS bf16_t*)(ws + WS_WRT + WRT_GL); GAS float* csp = (GAS float*)(ws + WS_WRT + WRT_CS); GAS float* c0p = (GAS float*)(ws + WS_WRT + WRT_C0);
      const int c = F.G * NWAVES - 1 - (F.vcu * NWAVES + F.wave);
      if (c < 48) { float s_cs = 0.f, s_c0 = 0.f;
          float wv[D / 64], gv[D / 64], bv[D / 64];
          const GAS float* wp = c < 4 ? wg + c : we + (c < 36 ? c - 4 : 0); const int wst = c < 4 ? 4 : NEXP; const float wz = c < 36 ? 1.0f : 0.0f;
#pragma unroll
          for (int i = 0; i < D / 64; ++i) { const int k = F.lane + 64 * i; wv[i] = wp[(size_t)k * wst] * wz; gv[i] = g1[k]; bv[i] = b1[k]; }
#pragma unroll
          for (int i = 0; i < D / 64; ++i) { const int k = F.lane + 64 * i; const float w = wv[i];
              const float v = gv[i] * w; const unsigned hi = pk2(v, 0.f) & 0xffffu; const float hf = bf_lo(hi); const unsigned lo = pk2(v - hf, 0.f) & 0xffffu;
              wgh[(size_t)c * D + k] = (bf16_t)hi; wgl[(size_t)c * D + k] = (bf16_t)lo; s_cs += hf + bf_lo(lo); s_c0 += bv[i] * w; }
          s_cs = wave_sum(s_cs); s_c0 = wave_sum(s_c0);
          if (F.lane == 0) { csp[c] = s_cs; c0p[c] = s_c0 + (c < 4 ? bg[c] : (c < 36 ? be[c - 4] : 0.f)); } } }
    if (l == 0) {
        const size_t gt = (size_t)F.vcu * 512 + F.tid, GT = (size_t)F.G * 512;
        { const GAS float* x = KIN(0); GAS bf16_t* xb = (GAS bf16_t*)(ws + WS_XB); GAS unsigned char* xb8 = (GAS unsigned char*)(ws + WS_XB8); GAS float* xs = (GAS float*)(ws + WS_XS);
          const int NGW_ = F.G * NWAVES;
          for (int rowA = F.vcu * NWAVES + F.wave; rowA < T; rowA += 2 * NGW_) { const int rowB = (rowA + NGW_ < T) ? rowA + NGW_ : rowA; f32x4 va[8], vb[8];
#pragma unroll
              for (int j = 0; j < 4; ++j) { const size_t c = 8 * F.lane + 512 * j;
                  va[2 * j] = __builtin_nontemporal_load((const GAS f32x4*)(x + (size_t)rowA * D + c)); va[2 * j + 1] = __builtin_nontemporal_load((const GAS f32x4*)(x + (size_t)rowA * D + c + 4));
                  vb[2 * j] = __builtin_nontemporal_load((const GAS f32x4*)(x + (size_t)rowB * D + c)); vb[2 * j + 1] = __builtin_nontemporal_load((const GAS f32x4*)(x + (size_t)rowB * D + c + 4)); }
#pragma unroll
              for (int rr = 0; rr < 2; ++rr) { const int row = rr ? rowB : rowA; float mx = 0.f; f32x4 v[8];
#pragma unroll
                  for (int j = 0; j < 8; ++j) { v[j] = rr ? vb[j] : va[j]; mx = fmaxf(fmaxf(mx, fmaxf(fabsf(v[j][0]), fabsf(v[j][1]))), fmaxf(fabsf(v[j][2]), fabsf(v[j][3]))); }
                  mx = fmaxf(wave_max(mx), 1e-30f); const float q = 127.0f / mx; if (F.lane == 0) xs[row] = mx * (1.0f / 127.0f);
#pragma unroll
                  for (int j = 0; j < 4; ++j) { const size_t c = 8 * F.lane + 512 * j; u32x4 wv; wv.x = pk2(v[2 * j][0], v[2 * j][1]); wv.y = pk2(v[2 * j][2], v[2 * j][3]); wv.z = pk2(v[2 * j + 1][0], v[2 * j + 1][1]); wv.w = pk2(v[2 * j + 1][2], v[2 * j + 1][3]);
                      *(GAS u32x4*)(xb + (size_t)row * D + c) = wv;
                      *(GAS u32x2*)(xb8 + (size_t)row * D + c) = (u32x2){pk_i8(v[2 * j][0], v[2 * j][1], v[2 * j][2], v[2 * j][3], q), pk_i8(v[2 * j + 1][0], v[2 * j + 1][1], v[2 * j + 1][2], v[2 * j + 1][3], q)}; } } } }
        { GAS float* ct = (GAS float*)(ws + WS_ROPE); GAS float* st = ct + 2048 * 128;
          for (size_t i = gt; i < (size_t)2048 * 128; i += GT) { const int pos = (int)(i >> 7), j = (int)(i & 127);
              double inv = 1.0, rp = 0.9300449458481392; int e = j;
#pragma unroll
              for (int b = 0; b < 7; ++b) { if (e & 1) inv *= rp; rp *= rp; e >>= 1; }
              float sn, cs; sincos_d((double)pos * inv, sn, cs); ct[i] = cs; st[i] = sn; } }
    }
}

using pg8::Unit;
struct SchedProj {
    static constexpr bool VARLD = false, GATHER = false, DEP = false, F8 = false, I8 = true; static constexpr unsigned LDA = 2048, LDB = 2048; static constexpr int KK = 1024;
    const GAS char* xb; const GAS char* win; int G, c, mode;
    __device__ __forceinline__ bool next(int i, Unit& u) const {
        const int L = i * G + c; const int nN = mode ? 12 : 52, nmain = 64 * nN;
        u.gather = nullptr; u.nvalid = 256; u.aux = 0;
        if (L < nmain) { int pm, j; pg8::static_tile(L, 64, nN, pm, j);
            int pn; if (mode) pn = j < 4 ? 8 + j : 16 + j; else pn = j < 8 ? j : (j < 16 ? j + 4 : j + 12);
            u.pm = pm; u.pn = pn; u.A = xb + (size_t)pm * 256 * 2048; u.B = win + (size_t)pn * 256 * 2048; return true; }
        return false;
    }
};
struct SchedGate {
    static constexpr bool VARLD = false, GATHER = false, DEP = false, F8 = true, I8 = false; static constexpr unsigned LDA = 2048, LDB = 2048; static constexpr int KK = 1024;
    const GAS char* xb8; const GAS char* win8; int G, c;
    __device__ __forceinline__ bool next(int i, Unit& u) const {
        const int L = i * G + c; if (L >= 64 * (24 + NF8X)) return false;
        int pm, j; pg8::static_tile(L, 64, 24 + NF8X, pm, j);
        u.gather = nullptr; u.nvalid = 256; u.aux = 0; u.pm = pm; u.pn = j < 24 ? 40 + j : (j < 28 ? 12 + j : j - 28); u.A = xb8 + (size_t)pm * 256 * 2048;
        u.B = win8 + (size_t)(j < 24 ? 256 * j : 9216 + 256 * (j - 24)) * 2048; return true;
    }
};
struct SchedVT8 {
    static constexpr bool VARLD = false, GATHER = false, DEP = false, F8 = true, I8 = false; static constexpr unsigned LDA = 2048, LDB = 2048; static constexpr int KK = 1024;
    const GAS char* xb8; const GAS char* win8; int G, c;
    __device__ __forceinline__ bool next(int i, Unit& u) const {
        const int L = i * G + c; if (L >= 64 * 12) return false;
        int pm, j; pg8::static_tile(L, 64, 12, pm, j);
        u.gather = nullptr; u.nvalid = 256; u.aux = 0; u.pm = pm; u.pn = j < 4 ? 8 + j : 16 + j; u.A = xb8 + (size_t)pm * 256 * 2048; u.B = win8 + (size_t)(6144 + 256 * j) * 2048; return true;
    }
};
struct SchedKv {
    static constexpr bool VARLD = false, GATHER = false, DEP = false, F8 = false, I8 = false; static constexpr unsigned LDA = 4096, LDB = 4096; static constexpr int KK = 2048;
    const GAS char* memb; const GAS char* wkv; int c;
    __device__ __forceinline__ bool next(int i, Unit& u) const {
        if (i > 0 || c >= 64) return false; const int q = c;
        u.gather = nullptr; u.nvalid = 256;
        if (q < 32) { u.aux = 1; u.pm = q >> 2; u.pn = q & 3; u.A = memb + (size_t)u.pm * 256 * 4096; u.B = wkv + (size_t)u.pn * 256 * 4096; }
        else { const int r = q - 32; u.aux = 2; u.pm = r >> 3; u.pn = r & 7; u.A = wkv + (size_t)(1024 + u.pm * 256) * 4096; u.B = memb + (size_t)u.pn * 256 * 4096; }
        return true;
    }
};
struct EpiProj {
    static constexpr bool PERM = true, KEEP = false;
    GAS unsigned char* ws; const GAS float* ropec; const GAS float* ropes;
    template <int MODE, bool I8 = false> __device__ __forceinline__ void store(const f32x4 (&acc)[2][2][4][2], GAS bf16_t* O, int ldc, int row0, int col0, float sc, int head, int wr, int wc, int fr, int fq, const GAS float* xs = nullptr, float wdq = 1.0f) const {
        const int r0 = row0 + wr * 64 + fr, c0 = col0 + wc * 32 + 8 * fq;
        float rq[2][4];
#pragma unroll
        for (int ai = 0; ai < 2; ++ai)
#pragma unroll
            for (int m = 0; m < 4; ++m) rq[ai][m] = I8 ? xs[r0 + ai * 128 + m * 16] * wdq : 1.0f;
#define ACCV(ai_, bj_, m_, n_) (I8 ? __builtin_convertvector(__builtin_bit_cast(v4i32, acc[ai_][bj_][m_][n_]), f32x4) * rq[ai_][m_] : acc[ai_][bj_][m_][n_])
        float lg = 0.f; if ((MODE == 3 || MODE == 4)) lg = log2f(1.0f - exp2f(-5.0f - (float)head));
#pragma unroll
        for (int ai = 0; ai < 2; ++ai) {
            if ((MODE == 3 || MODE == 4)) {
#pragma unroll
                for (int mh = 0; mh < 2; ++mh) {
                f32x4 cA[2], cB[2], sA[2], sB[2];
#pragma unroll
                for (int m2 = 0; m2 < 2; ++m2) { const int m = 2 * mh + m2; const int pos = (r0 + ai * 128 + m * 16) & (SEQ - 1); const GAS float* cp = ropec + pos * 128 + wc * 32 + 8 * fq; const GAS float* sp = ropes + pos * 128 + wc * 32 + 8 * fq;
                    cA[m2] = *(const GAS f32x4*)(cp); cB[m2] = *(const GAS f32x4*)(cp + 4); sA[m2] = *(const GAS f32x4*)(sp); sB[m2] = *(const GAS f32x4*)(sp + 4); }
#pragma unroll
                for (int m2 = 0; m2 < 2; ++m2) { const int m = 2 * mh + m2; const int row = r0 + ai * 128 + m * 16; GAS bf16_t* rowp = O + (size_t)row * ldc + c0;
                    const int pos = row & (SEQ - 1); const float e = (float)(pos & 255) * lg;
                    const float rs = (MODE == 3) ? fast_exp2(e) : 0.0625f * fast_exp2(-e);
                    const f32x4 x1a = ACCV(ai, 0, m, 0), x1b = ACCV(ai, 0, m, 1), x2a = ACCV(ai, 1, m, 0), x2b = ACCV(ai, 1, m, 1);
                    const f32x4 o1a = (x1a * cA[m2] - x2a * sA[m2]) * rs, o1b = (x1b * cB[m2] - x2b * sB[m2]) * rs, o2a = (x1a * sA[m2] + x2a * cA[m2]) * rs, o2b = (x1b * sB[m2] + x2b * cB[m2]) * rs;
                    u32x4 w; w.x = pk2(o1a[0], o1a[1]); w.y = pk2(o1a[2], o1a[3]); w.z = pk2(o1b[0], o1b[1]); w.w = pk2(o1b[2], o1b[3]); *(GAS u32x4*)(rowp) = w;
                    w.x = pk2(o2a[0], o2a[1]); w.y = pk2(o2a[2], o2a[3]); w.z = pk2(o2b[0], o2b[1]); w.w = pk2(o2b[2], o2b[3]); *(GAS u32x4*)(rowp + 128) = w; }
                asm volatile("" ::: "memory"); }
                asm volatile("" ::: "memory");
            } else {
#pragma unroll
                for (int m = 0; m < 4; ++m) { const int row = r0 + ai * 128 + m * 16; GAS bf16_t* rowp = O + (size_t)row * ldc + c0;
                    if (MODE == 5) {
                        u32x2 wq[2];
#pragma unroll
                        for (int bj = 0; bj < 2; ++bj) { const f32x4 v0 = ACCV(ai, bj, m, 0), v1 = ACCV(ai, bj, m, 1); wq[bj] = (u32x2){0u, 0u};
#pragma unroll
                            for (int jj = 0; jj < 4; ++jj) { wq[bj].x = __builtin_amdgcn_cvt_pk_u8_f32(fminf(__builtin_truncf(sigmoidf_(v0[jj] * sc) * 256.0f), 255.0f), jj, wq[bj].x); wq[bj].y = __builtin_amdgcn_cvt_pk_u8_f32(fminf(__builtin_truncf(sigmoidf_(v1[jj] * sc) * 256.0f), 255.0f), jj, wq[bj].y); } }
                        const auto sx_ = __builtin_amdgcn_permlane16_swap(wq[0].x, wq[1].x, false, false), sy_ = __builtin_amdgcn_permlane16_swap(wq[0].y, wq[1].y, false, false);
                        const int ce_ = (fq & 1) ? c0 - 8 + 128 : c0;
                        *(GAS u32x4*)((GAS unsigned char*)O + (size_t)row * ldc + ce_) = (u32x4){sx_[0], sy_[0], sx_[1], sy_[1]}; continue; }
#pragma unroll
                    for (int bj = 0; bj < 2; ++bj) { f32x4 v0 = ACCV(ai, bj, m, 0), v1 = ACCV(ai, bj, m, 1);
                        if (MODE == 0) { v0 = v0 * sc; v1 = v1 * sc; }
                        if (MODE == 1) {
#pragma unroll
                            for (int j = 0; j < 4; ++j) { v0[j] = v0[j] * sigmoidf_(v0[j]); v1[j] = v1[j] * sigmoidf_(v1[j]); } }
                        if (MODE == 2) {
#pragma unroll
                            for (int j = 0; j < 4; ++j) { v0[j] = sigmoidf_(v0[j]); v1[j] = sigmoidf_(v1[j]); } }
                        if (MODE == 5) {
                            u32x2 wq = {0u, 0u};
#pragma unroll
                            for (int j = 0; j < 4; ++j) { wq.x = __builtin_amdgcn_cvt_pk_u8_f32(fminf(__builtin_truncf(sigmoidf_(v0[j] * sc) * 256.0f), 255.0f), j, wq.x); wq.y = __builtin_amdgcn_cvt_pk_u8_f32(fminf(__builtin_truncf(sigmoidf_(v1[j] * sc) * 256.0f), 255.0f), j, wq.y); }
                            *(GAS u32x2*)((GAS unsigned char*)O + (size_t)row * ldc + c0 + bj * 128) = wq; continue; }
                        u32x4 w; w.x = pk2(v0[0], v0[1]); w.y = pk2(v0[2], v0[3]); w.z = pk2(v1[0], v1[1]); w.w = pk2(v1[2], v1[3]);
                        if (MODE == 6) {
                            GAS bf16_t* gp = rowp + bj * 128 - 8 * (fq & 1) + 4 * (fq & 1); *(GAS u32x2*)(gp) = (u32x2){w.x, w.y}; *(GAS u32x2*)(gp + 8) = (u32x2){w.z, w.w}; continue; }
                        *(GAS u32x4*)(rowp + bj * 128) = w; } } } }
#undef ACCV
    }
    __device__ __forceinline__ void operator()(const f32x4 (&acc)[2][2][4][2], const Unit& u, int wr, int wc, int fr, int fq) const {
        const int row0 = u.pm * 256, pn = u.pn;
        if (u.aux == 1) { store<0>(acc, (GAS bf16_t*)(ws + WS_KM), 1024, row0, pn * 256, 1.0f, 0, wr, wc, fr, fq); return; }
        if (u.aux == 2) { store<6>(acc, (GAS bf16_t*)(ws + WS_VMT), 2048, row0, pn * 256, 1.0f, 0, wr, wc, fr, fq); return; }
        if (pn < 4) store<0>(acc, (GAS bf16_t*)(ws + WS_AQ), 1024, row0, pn * 256, 0.08838834764831845f * LOG2E, 0, wr, wc, fr, fq);
        else if (pn < 8) store<0>(acc, (GAS bf16_t*)(ws + WS_AK), 1024, row0, (pn - 4) * 256, 1.0f, 0, wr, wc, fr, fq);
        else if (pn < 16) store<3>(acc, (GAS bf16_t*)(ws + WS_RQ), 1024, row0, (pn - 12) * 256, 1.0f, pn - 12, wr, wc, fr, fq);
        else if (pn < 20) store<4>(acc, (GAS bf16_t*)(ws + WS_RK), 1024, row0, (pn - 16) * 256, 1.0f, pn - 16, wr, wc, fr, fq);
        else if (pn < 36) store<1>(acc, (GAS bf16_t*)(ws + WS_RGS), 2048, row0, (pn - 28) * 256, 1.0f, 0, wr, wc, fr, fq);
        else if (pn < 40) store<0>(acc, (GAS bf16_t*)(ws + WS_MQ), 1024, row0, (pn - 36) * 256, 0.0625f * LOG2E, 0, wr, wc, fr, fq);
        else if (pn < 48) store<5>(acc, (GAS bf16_t*)(ws + WS_SGA), 2048, row0, (pn - 40) * 256, 1.0f / GATE_WSCALE, 0, wr, wc, fr, fq);
        else if (pn < 56) store<5>(acc, (GAS bf16_t*)(ws + WS_SGR), 2048, row0, (pn - 48) * 256, 1.0f / GATE_WSCALE, 0, wr, wc, fr, fq);
        else store<5>(acc, (GAS bf16_t*)(ws + WS_SGM), 2048, row0, (pn - 56) * 256, 1.0f / GATE_WSCALE, 0, wr, wc, fr, fq);
    }
};
struct EpiProjQ {
    static constexpr bool PERM = true, KEEP = false;
    EpiProj P; const GAS float* xs; float wdq;
    __device__ __forceinline__ void operator()(const f32x4 (&acc)[2][2][4][2], const Unit& u, int wr, int wc, int fr, int fq) const {
        const int row0 = u.pm * 256, pn = u.pn; GAS unsigned char* ws = P.ws;
        if (pn < 4) P.template store<0, true>(acc, (GAS bf16_t*)(ws + WS_AQ), 1024, row0, pn * 256, 0.08838834764831845f * LOG2E, 0, wr, wc, fr, fq, xs, wdq);
        else if (pn < 8) P.template store<0, true>(acc, (GAS bf16_t*)(ws + WS_AK), 1024, row0, (pn - 4) * 256, 1.0f, 0, wr, wc, fr, fq, xs, wdq);
        else if (pn < 16) P.template store<3, true>(acc, (GAS bf16_t*)(ws + WS_RQ), 1024, row0, (pn - 12) * 256, 1.0f, pn - 12, wr, wc, fr, fq, xs, wdq);
        else if (pn < 20) P.template store<4, true>(acc, (GAS bf16_t*)(ws + WS_RK), 1024, row0, (pn - 16) * 256, 1.0f, pn - 16, wr, wc, fr, fq, xs, wdq);
        else if (pn < 36) P.template store<1, true>(acc, (GAS bf16_t*)(ws + WS_RGS), 2048, row0, (pn - 28) * 256, 1.0f, 0, wr, wc, fr, fq, xs, wdq);
        else if (pn < 40) P.template store<0, true>(acc, (GAS bf16_t*)(ws + WS_MQ), 1024, row0, (pn - 36) * 256, 0.0625f * LOG2E, 0, wr, wc, fr, fq, xs, wdq);
        else { const int g = pn - 40; P.template store<5, true>(acc, (GAS bf16_t*)(ws + WS_SGA + (size_t)(g >> 3) * (64 * MiB)), 2048, row0, (g & 7) * 256, 1.0f, 0, wr, wc, fr, fq, xs, wdq); }
    }
};
struct EpiGate {
    static constexpr bool PERM = true, KEEP = false;
    EpiProj P;
    __device__ __forceinline__ void operator()(const f32x4 (&acc)[2][2][4][2], const Unit& u, int wr, int wc, int fr, int fq) const {
        if (u.pn < 4) { P.template store<0>(acc, (GAS bf16_t*)(P.ws + WS_AQ), 1024, u.pm * 256, u.pn * 256, 0.08838834764831845f * LOG2E / GATE_WSCALE, 0, wr, wc, fr, fq); return; }
        if (u.pn < 8) { P.template store<0>(acc, (GAS bf16_t*)(P.ws + WS_AK), 1024, u.pm * 256, (u.pn - 4) * 256, 1.0f / GATE_WSCALE, 0, wr, wc, fr, fq); return; }
        if (u.pn < 40) { P.template store<0>(acc, (GAS bf16_t*)(P.ws + WS_MQ), 1024, u.pm * 256, (u.pn - 36) * 256, 0.0625f * LOG2E / GATE_WSCALE, 0, wr, wc, fr, fq); return; }
        const int g = u.pn - 40;
        P.template store<5>(acc, (GAS bf16_t*)(P.ws + WS_SGA + (size_t)(g >> 3) * (64 * MiB)), 2048, u.pm * 256, (g & 7) * 256, 1.0f / GATE_WSCALE, 0, wr, wc, fr, fq);
    }
};
struct EpiProjT {
    static constexpr bool PERM = false, KEEP = false;
    GAS unsigned char* ws; float sc; const GAS float* xs;
    __device__ __forceinline__ void operator()(const f32x4 (&acc)[2][2][4][2], const Unit& u, int wr, int wc, int fr, int fq) const {
        const int pn = u.pn; const bool isav = pn < 12; const int ncols = isav ? 1024 : 2048; const int colt = isav ? (pn - 8) * 256 : (pn - 20) * 256;
        GAS bf16_t* base = (GAS bf16_t*)(ws + (isav ? WS_AVT : WS_RVT)) + (size_t)(u.pm >> 3) * ncols * SEQ;
        const int fqp = isav ? ((fq == 1) ? 2 : ((fq == 2) ? 1 : fq)) : fq;
        const int sbase = (u.pm & 7) * 256 + wr * 64, c0 = colt + wc * 32 + fr; (void)fqp;
#pragma unroll
        for (int ai = 0; ai < 2; ++ai)
#pragma unroll
            for (int bj = 0; bj < 2; ++bj)
#pragma unroll
                for (int m = 0; m < 4; ++m) { u32x2 w[2];
                    const f32x4 rs4 = *(const GAS f32x4*)(xs + u.pm * 256 + wr * 64 + 4 * fq + ai * 128 + m * 16);
#pragma unroll
                    for (int n = 0; n < 2; ++n) { const f32x4 v = __builtin_convertvector(__builtin_bit_cast(v4i32, acc[ai][bj][m][n]), f32x4) * rs4 * sc; w[n].x = pk2(v[0], v[1]); w[n].y = pk2(v[2], v[3]); }
                    u32x4 ww; int nsel, sb;
                    if (isav) { const auto sx_ = __builtin_amdgcn_permlane32_swap(w[0].x, w[1].x, false, false), sy_ = __builtin_amdgcn_permlane32_swap(w[0].y, w[1].y, false, false);
                        ww = (u32x4){sx_[0], sy_[0], sx_[1], sy_[1]}; nsel = fq >> 1; sb = 8 * (fq & 1); }
                    else { const auto sx_ = __builtin_amdgcn_permlane16_swap(w[0].x, w[1].x, false, false), sy_ = __builtin_amdgcn_permlane16_swap(w[0].y, w[1].y, false, false);
                        ww = (u32x4){sx_[0], sy_[0], sx_[1], sy_[1]}; nsel = fq & 1; sb = 4 * (fq & ~1); }
                    *(GAS u32x4*)(base + (size_t)(c0 + bj * 128 + nsel * 16) * SEQ + sbase + sb + ai * 128 + m * 16) = ww; }
    }
};
struct SchedMerge {
    static constexpr bool VARLD = true, GATHER = false, DEP = false, F8 = true, I8 = false; static constexpr unsigned LDA = 0, LDB = 0; static constexpr int KK = 0;
    const GAS char* ya; const GAS char* yr; const GAS char* ym; const GAS char* wpm; const GAS char* wpr; const GAS char* wpe; int G, c;
    __device__ __forceinline__ bool next(int i, Unit& u) const {
        const int ti = i / 3, ord = i - 3 * ti;
        const int br = (c & 1) ? (ord == 0 ? 0 : (ord == 1 ? 2 : 1)) : (ord == 0 ? 1 : (ord == 1 ? 0 : 2));
        const int L = ti * G + c; if (L >= 512) return false;
        int pm, pn; pg8::static_tile(L, 64, 8, pm, pn); u.pm = pm; u.pn = pn; const int ordn = ord + 1, brn = (c & 1) ? (ordn == 1 ? 2 : 1) : (ordn == 1 ? 0 : 2); u.aux = br + 4 * ord + 16 * brn; u.gather = nullptr; u.nvalid = 256;
        if (br == 0) { u.K = 512; u.lda = 1024; u.ldb = 1024; u.A = ya + (size_t)pm * 256 * 1024; u.B = wpm + (size_t)pn * 256 * 1024; }
        else if (br == 1) { u.K = 1024; u.lda = 2048; u.ldb = 2048; u.A = yr + (size_t)pm * 256 * 2048; u.B = wpr + (size_t)pn * 256 * 2048; }
        else { u.K = 512; u.lda = 1024; u.ldb = 1024; u.A = ym + (size_t)pm * 256 * 1024; u.B = wpe + (size_t)pn * 256 * 1024; }
        return true;
    }
};
struct EpiMerge {
    static constexpr bool PERM = true, KEEP = true;
    const GAS unsigned char* sga; GAS bf16_t* merged;
    __device__ __forceinline__ bool merge(f32x4 (&acc)[2][2][4][2], const Unit& u, int wr, int wc, int fr, int fq) const {
        const int br = u.aux & 3, ord = (u.aux >> 2) & 3, brn = u.aux >> 4;
        const GAS unsigned char* sg = sga + (size_t)br * (64 * MiB); const GAS unsigned char* sn = sga + (size_t)brn * (64 * MiB);
        const int r0 = u.pm * 256 + wr * 64 + fr, c0 = u.pn * 256 + wc * 32 + 8 * fq;
        if (ord < 2) {
#pragma unroll
            for (int ai = 0; ai < 2; ++ai) {
                u32x2 g[4][2], h[4][2];
#pragma unroll
                for (int m = 0; m < 4; ++m)
#pragma unroll
                    for (int bj = 0; bj < 2; ++bj) { const size_t off = (size_t)(r0 + ai * 128 + m * 16) * D + c0 + bj * 128; g[m][bj] = *(const GAS u32x2*)(sg + off); h[m][bj] = *(const GAS u32x2*)(sn + off); }
#pragma unroll
                for (int m = 0; m < 4; ++m)
#pragma unroll
                    for (int bj = 0; bj < 2; ++bj) { const u32x2 gg = g[m][bj], hh = h[m][bj];
#pragma unroll
                        for (int j = 0; j < 4; ++j) {
                            acc[ai][bj][m][0][j] *= ((float)((gg.x >> (8 * j)) & 0xffu) + 0.5f) * __builtin_amdgcn_rcpf((float)((hh.x >> (8 * j)) & 0xffu) + 0.5f);
                            acc[ai][bj][m][1][j] *= ((float)((gg.y >> (8 * j)) & 0xffu) + 0.5f) * __builtin_amdgcn_rcpf((float)((hh.y >> (8 * j)) & 0xffu) + 0.5f); } }
                asm volatile("" ::: "memory"); }
            return true;
        }
#pragma unroll
        for (int ai = 0; ai < 2; ++ai) {
            u32x2 g[4][2], m8[4][2];
#pragma unroll
            for (int m = 0; m < 4; ++m)
#pragma unroll
                for (int bj = 0; bj < 2; ++bj) { const size_t off = (size_t)(r0 + ai * 128 + m * 16) * D + c0 + bj * 128; g[m][bj] = *(const GAS u32x2*)(sg + off); }
#pragma unroll
            for (int m = 0; m < 4; ++m)
#pragma unroll
                for (int bj = 0; bj < 2; ++bj) { const u32x2 gg = g[m][bj];
                    f32x4 v0 = acc[ai][bj][m][0] * (MG8_SCALE / (256.0f * GATE_WSCALE * Y8_SCALE)), v1 = acc[ai][bj][m][1] * (MG8_SCALE / (256.0f * GATE_WSCALE * Y8_SCALE));
#pragma unroll
                    for (int j = 0; j < 4; ++j) { v0[j] *= (float)((gg.x >> (8 * j)) & 0xffu) + 0.5f; v1[j] *= (float)((gg.y >> (8 * j)) & 0xffu) + 0.5f; }
                    unsigned lo_ = 0, hi_ = 0; lo_ = __builtin_amdgcn_cvt_pk_fp8_f32(f8c(v0[0]), f8c(v0[1]), lo_, false); lo_ = __builtin_amdgcn_cvt_pk_fp8_f32(f8c(v0[2]), f8c(v0[3]), lo_, true);
                    hi_ = __builtin_amdgcn_cvt_pk_fp8_f32(f8c(v1[0]), f8c(v1[1]), hi_, false); hi_ = __builtin_amdgcn_cvt_pk_fp8_f32(f8c(v1[2]), f8c(v1[3]), hi_, true); m8[m][bj] = (u32x2){lo_, hi_}; }
#pragma unroll
            for (int m = 0; m < 4; ++m) { const auto sx_ = __builtin_amdgcn_permlane16_swap(m8[m][0].x, m8[m][1].x, false, false), sy_ = __builtin_amdgcn_permlane16_swap(m8[m][0].y, m8[m][1].y, false, false);
                const int ce_ = (fq & 1) ? c0 - 8 + 128 : c0;
                *(GAS u32x4*)((GAS unsigned char*)merged + (size_t)(r0 + ai * 128 + m * 16) * D + ce_) = (u32x4){sx_[0], sy_[0], sx_[1], sy_[1]}; }
            asm volatile("" ::: "memory"); }
        return false;
    }
};
struct SchedPlain {
    static constexpr bool VARLD = false, GATHER = false, DEP = false, F8 = false, I8 = false; static constexpr unsigned LDA = 4096, LDB = 4096; static constexpr int KK = 2048;
    const GAS char* A; const GAS char* B; int nM, nN, G, c;
    __device__ __forceinline__ bool next(int i, Unit& u) const {
        const int L = i * G + c; if (L >= nM * nN) return false;
        int pm, pn; pg8::static_tile(L, nM, nN, pm, pn); u.pm = pm; u.pn = pn; u.aux = 0; u.gather = nullptr; u.nvalid = 256;
        u.A = A + (size_t)pm * 256 * LDA; u.B = B + (size_t)pn * 256 * LDB; return true;
    }
};
struct SchedPlain8 {
    static constexpr bool VARLD = false, GATHER = false, DEP = false, F8 = true, I8 = false; static constexpr unsigned LDA = 2048, LDB = 2048; static constexpr int KK = 1024;
    const GAS char* A; const GAS char* B; int nM, nN, G, c;
    __device__ __forceinline__ bool next(int i, Unit& u) const {
        const int L = i * G + c; if (L >= nM * nN) return false;
        int pm, pn; pg8::static_tile(L, nM, nN, pm, pn); u.pm = pm; u.pn = pn; u.aux = 0; u.gather = nullptr; u.nvalid = 256;
        u.A = A + (size_t)pm * 256 * LDA; u.B = B + (size_t)pn * 256 * LDB; return true;
    }
};
struct EpiResid {
    static constexpr bool PERM = true, KEEP = false;
    const GAS bf16_t* xres; GAS bf16_t* out;
    __device__ __forceinline__ void operator()(const f32x4 (&acc)[2][2][4][2], const Unit& u, int wr, int wc, int fr, int fq) const {
        const int r0 = u.pm * 256 + wr * 64 + fr, c0 = u.pn * 256 + wc * 32 + 8 * fq;
#pragma unroll
        for (int ai = 0; ai < 2; ++ai) {
            u32x4 xv[4][2];
#pragma unroll
            for (int m = 0; m < 4; ++m)
#pragma unroll
                for (int bj = 0; bj < 2; ++bj) xv[m][bj] = *(const GAS u32x4*)(xres + (size_t)(r0 + ai * 128 + m * 16) * D + c0 + bj * 128);
#pragma unroll
            for (int m = 0; m < 4; ++m)
#pragma unroll
                for (int bj = 0; bj < 2; ++bj) { const size_t off = (size_t)(r0 + ai * 128 + m * 16) * D + c0 + bj * 128; const u32x4 x = xv[m][bj]; const f32x4 v0 = acc[ai][bj][m][0] * (1.0f / (GATE_WSCALE * MG8_SCALE)), v1 = acc[ai][bj][m][1] * (1.0f / (GATE_WSCALE * MG8_SCALE));
                    u32x4 w; w.x = pk2(DN_ALPHA * bf_lo(x.x) + v0[0], DN_ALPHA * bf_hi(x.x) + v0[1]); w.y = pk2(DN_ALPHA * bf_lo(x.y) + v0[2], DN_ALPHA * bf_hi(x.y) + v0[3]);
                    w.z = pk2(DN_ALPHA * bf_lo(x.z) + v1[0], DN_ALPHA * bf_hi(x.z) + v1[1]); w.w = pk2(DN_ALPHA * bf_lo(x.w) + v1[2], DN_ALPHA * bf_hi(x.w) + v1[3]);
                    *(GAS u32x4*)(out + off) = w; }
            asm volatile("" ::: "memory"); }
    }
};
struct MoeTab { int ntiles; };
__device__ __forceinline__ void build_moe_tab(Frame& F, const GAS unsigned* cnt) {
    volatile LAS int* tab = (volatile LAS int*)(F.lds + LDS_TAB);
    if (F.tid < 32) { const int e = F.tid; const int c = (int)cnt[64 * e]; tab[576 + e] = c; const int nt = (c + 255) >> 8;
        int incl = nt;
#pragma unroll
        for (int o = 1; o < 32; o <<= 1) { const int v = __shfl_up(incl, o); if (e >= o) incl += v; }
        const int base = incl - nt;
        for (int j = 0; j < nt; ++j) { const int rt = base + j; if (rt < 192) { tab[64 + rt] = e; tab[320 + rt] = 256 * j; } }
        if (e == 31) tab[0] = incl < 192 ? incl : 192; }
    __syncthreads();
}
struct SchedMoe1 {
    static constexpr bool VARLD = false, GATHER = true, DEP = false, F8 = false, I8 = false; static constexpr unsigned LDA = 4096, LDB = 4096; static constexpr int KK = 2048;
    const GAS char* x1b; const GAS char* wgu; const GAS int* list; LAS int* tab; int G, c;
    __device__ __forceinline__ bool next(int i, Unit& u) const {
        const int L = i * G + c; const int RT = __builtin_amdgcn_readfirstlane(tab[0]); if (L >= RT * 4) return false;
        const int rt = L >> 2, pn = L & 3; const int e = __builtin_amdgcn_readfirstlane(tab[64 + rt]), r0 = __builtin_amdgcn_readfirstlane(tab[320 + rt]), cnt = __builtin_amdgcn_readfirstlane(tab[576 + e]);
        u.pm = rt; u.pn = pn; u.aux = e; u.A = x1b; u.B = wgu + ((size_t)e * 1024 + (size_t)pn * 256) * 4096;
        u.gather = list + (size_t)e * T + r0; u.nvalid = (cnt - r0) < 256 ? (cnt - r0) : 256; return true;
    }
};
struct EpiSwiglu {
    static constexpr bool PERM = true, KEEP = false;
    GAS bf16_t* hbuf; GAS unsigned* flag;
    __device__ __forceinline__ void operator()(const f32x4 (&acc)[2][2][4][2], const Unit& u, int wr, int wc, int fr, int fq) const {
        const int r0 = u.pm * 256 + wr * 64 + fr, c0 = u.pn * 128 + wc * 32 + 8 * fq;
#pragma unroll
        for (int ai = 0; ai < 2; ++ai)
#pragma unroll
            for (int m = 0; m < 4; ++m) { const f32x4 g0 = acc[ai][0][m][0], g1 = acc[ai][0][m][1], u0 = acc[ai][1][m][0], u1 = acc[ai][1][m][1]; float h[8];
#pragma unroll
                for (int j = 0; j < 4; ++j) { h[j] = g0[j] * sigmoidf_(g0[j]) * u0[j]; h[4 + j] = g1[j] * sigmoidf_(g1[j]) * u1[j]; }
                unsigned lo_ = 0, hi_ = 0; lo_ = __builtin_amdgcn_cvt_pk_fp8_f32(f8c(h[0]), f8c(h[1]), lo_, false); lo_ = __builtin_amdgcn_cvt_pk_fp8_f32(f8c(h[2]), f8c(h[3]), lo_, true); hi_ = __builtin_amdgcn_cvt_pk_fp8_f32(f8c(h[4]), f8c(h[5]), hi_, false); hi_ = __builtin_amdgcn_cvt_pk_fp8_f32(f8c(h[6]), f8c(h[7]), hi_, true);
                { GAS unsigned long long* hp_ = (GAS unsigned long long*)((GAS unsigned char*)hbuf + (size_t)(r0 + ai * 128 + m * 16) * EFF + c0);
                  __hip_atomic_store(hp_, ((unsigned long long)hi_ << 32) | lo_, __ATOMIC_RELAXED, __HIP_MEMORY_SCOPE_AGENT); } }
        asm volatile("s_waitcnt vmcnt(0)" ::: "memory");
        if ((threadIdx.x & 63) == 0) (void)xb_add(flag + 16 * u.pm, 1u);
    }
};
constexpr int MOE_ADV = 5;
struct SchedMoe2 {
    static constexpr bool VARLD = false, GATHER = false, DEP = true, F8 = true, I8 = false; static constexpr unsigned LDA = 512, LDB = 512; static constexpr int KK = 256;
    const GAS char* hbuf; const GAS char* wdn; const GAS int* list; LAS int* tab; int G, c; GAS unsigned* flag;
    __device__ __forceinline__ bool next(int i, Unit& u) const {
        const int RT = __builtin_amdgcn_readfirstlane(tab[0]); const int n6 = RT * 4, n7 = RT * 8, h = n6 % G, nlow = G - h;
        int L;
        if (h == 0) L = i * G + c;
        else if (c >= h) L = (i < MOE_ADV) ? i * nlow + (c - h) : MOE_ADV * nlow + (i - MOE_ADV) * G + c;
        else L = MOE_ADV * nlow + i * G + c;
        if (L >= n7) return false;
        const int rt = L >> 3, pn = L & 7; const int e = __builtin_amdgcn_readfirstlane(tab[64 + rt]), r0 = __builtin_amdgcn_readfirstlane(tab[320 + rt]), cnt = __builtin_amdgcn_readfirstlane(tab[576 + e]);
        u.pm = rt; u.pn = pn; u.aux = e; u.A = hbuf + (size_t)rt * 256 * 512; u.B = wdn + ((size_t)e * 2048 + (size_t)pn * 256) * 512;
        u.gather = list + (size_t)e * T + r0; u.nvalid = (cnt - r0) < 256 ? (cnt - r0) : 256; return true;
    }
    __device__ __forceinline__ void acquire(const Unit& u) const {
        GAS unsigned* f = flag + 16 * u.pm; unsigned sp = 0;
        while (xb_ld(f) < 32u) { __builtin_amdgcn_s_sleep(8); if (++sp > (1u << 21)) break; }
        asm volatile("" ::: "memory");
    }
};
struct EpiScatter {
    static constexpr bool PERM = true, KEEP = false;
    GAS bf16_t* yasg;
    __device__ __forceinline__ void operator()(const f32x4 (&acc)[2][2][4][2], const Unit& u, int wr, int wc, int fr, int fq) const {
        const int c0 = u.pn * 256 + wc * 32 + 8 * fq;
        int asgs[2][4];
#pragma unroll
        for (int ai = 0; ai < 2; ++ai)
#pragma unroll
            for (int m = 0; m < 4; ++m) { const int r = ai * 128 + wr * 64 + m * 16 + fr; asgs[ai][m] = (r < u.nvalid) ? u.gather[r] : 0; }
#pragma unroll
        for (int ai = 0; ai < 2; ++ai)
#pragma unroll
            for (int m = 0; m < 4; ++m) { const int r = ai * 128 + wr * 64 + m * 16 + fr; u32x2 w8[2];
#pragma unroll
                for (int bj = 0; bj < 2; ++bj) { const f32x4 v0 = acc[ai][bj][m][0] * (Y8_SCALE / GATE_WSCALE), v1 = acc[ai][bj][m][1] * (Y8_SCALE / GATE_WSCALE);
                    unsigned lo_ = 0, hi_ = 0; lo_ = __builtin_amdgcn_cvt_pk_fp8_f32(f8c(v0[0]), f8c(v0[1]), lo_, false); lo_ = __builtin_amdgcn_cvt_pk_fp8_f32(f8c(v0[2]), f8c(v0[3]), lo_, true);
                    hi_ = __builtin_amdgcn_cvt_pk_fp8_f32(f8c(v1[0]), f8c(v1[1]), hi_, false); hi_ = __builtin_amdgcn_cvt_pk_fp8_f32(f8c(v1[2]), f8c(v1[3]), hi_, true); w8[bj] = (u32x2){lo_, hi_}; }
                const auto sx_ = __builtin_amdgcn_permlane16_swap(w8[0].x, w8[1].x, false, false), sy_ = __builtin_amdgcn_permlane16_swap(w8[0].y, w8[1].y, false, false);
                if (r < u.nvalid) { const int asg = asgs[ai][m]; const int ce_ = (fq & 1) ? c0 - 8 + 128 : c0;
                    *(GAS u32x4*)((GAS unsigned char*)yasg + (size_t)asg * D + ce_) = (u32x4){sx_[0], sy_[0], sx_[1], sy_[1]}; } }
    }
};

struct FlashArgs {
    const GAS bf16_t* Q; int ldq; size_t qrow0; int qcol;
    const GAS bf16_t* K; int ldk; size_t krow0; int kcol;
    const GAS bf16_t* VT; size_t ldvt; size_t vrow0; size_t vcol0;
    GAS bf16_t* O; int ldo; int ocol;
    int qblk;
    GAS float* stat; float lg2g;
};
constexpr int FL_KBUF = 0, FL_VBUF = 65536, FL_PART = 98304, FL_KMEAN = 114688;
template <int MODE, int DK, int FABL = 0>
__device__ __forceinline__ void flash_unit(LAS unsigned char* lds, const FlashArgs& a, int tid) {
    asm volatile("" : "+v"(tid));
    const int lane = tid & 63, w = __builtin_amdgcn_readfirstlane(tid >> 6), l31 = lane & 31, h = lane >> 5;
    constexpr int CPR = DK / 8, NKL = (64 * CPR) / 512, KS = DK / 16, KROWB = DK * 2;
    constexpr int NDT = 4;
    const int nt = (MODE == 1) ? 4 : 4 * (a.qblk + 1);
    constexpr int RPP = 1024 / KROWB;
    const int k_rip = (lane * 16) / KROWB, k_cp = ((lane * 16) % KROWB) / 16;
    const int v_rip = lane >> 3, v_cp = lane & 7;
#define FL_TILE_KB(t) ((MODE == 0) ? ((t) < 4 ? 256 * a.qblk + 64 * (t) : 256 * (((t) - 4) >> 2) + 64 * (((t) - 4) & 3)) : 64 * (t))
#define FL_ISSUE(t, buf) do { const int kb_ = FL_TILE_KB(t); \
        _Pragma("unroll") for (int i = 0; i < NKL; ++i) { const int pidx = w + 8 * i, row = pidx * RPP + k_rip, c = k_cp ^ (row & 15); \
            __builtin_amdgcn_global_load_lds((const GAS unsigned*)(a.K + (a.krow0 + kb_ + row) * a.ldk + a.kcol + 8 * c), (LAS unsigned*)(lds + FL_KBUF + (buf) * 32768 + pidx * 1024), 16, 0, 0); } \
        _Pragma("unroll") for (int i = 0; i < 2; ++i) { const int pidx = w + 8 * i, row = pidx * 8 + v_rip, c = v_cp ^ ((row >> 1) & 7); \
            __builtin_amdgcn_global_load_lds((const GAS unsigned*)(a.VT + (a.vrow0 + row) * a.ldvt + a.vcol0 + kb_ + 8 * c), (LAS unsigned*)(lds + FL_VBUF + (buf) * 16384 + pidx * 1024), 16, 0, 0); } } while (0)
    FL_ISSUE(0, 0);
    bf16x8 qf[KS];
    { const GAS bf16_t* qp = a.Q + (a.qrow0 + (size_t)(32 * w + l31)) * a.ldq + a.qcol + 8 * h;
#pragma unroll
      for (int ks = 0; ks < KS; ++ks) qf[ks] = *(const GAS bf16x8*)(qp + 16 * ks); }
    unsigned selmask = 0;
    if (MODE == 0) {
        const int qb = a.qblk;
        if (qb <= 3) selmask = (1u << qb) - 1u;
        else {
            const LAS float* km = (const LAS float*)(lds + FL_KMEAN);
            f32x16 g; for (int i = 0; i < 16; ++i) g[i] = 0.f;
            const int n = l31 & 7; const bool nv = l31 < 8;
#pragma unroll
            for (int ks = 0; ks < KS; ++ks) { const f32x4 x0 = *(const LAS f32x4*)(km + n * 128 + 16 * ks + 8 * h), x1 = *(const LAS f32x4*)(km + n * 128 + 16 * ks + 8 * h + 4);
                float xv[8] = {x0[0], x0[1], x0[2], x0[3], x1[0], x1[1], x1[2], x1[3]}; unsigned hi[4], lo[4];
#pragma unroll
                for (int j = 0; j < 4; ++j) { const float a0 = nv ? xv[2 * j] : 0.f, a1 = nv ? xv[2 * j + 1] : 0.f; hi[j] = pk2(a0, a1); lo[j] = pk2(a0 - bf_lo(hi[j]), a1 - bf_hi(hi[j])); }
                const bf16x8 ah = __builtin_bit_cast(bf16x8, (u32x4){hi[0], hi[1], hi[2], hi[3]}), al = __builtin_bit_cast(bf16x8, (u32x4){lo[0], lo[1], lo[2], lo[3]});
                g = __builtin_amdgcn_mfma_f32_32x32x16_bf16(ah, qf[ks], g, 0, 0, 0); g = __builtin_amdgcn_mfma_f32_32x32x16_bf16(al, qf[ks], g, 0, 0, 0); }
            float gt[8];
#pragma unroll
            for (int r = 0; r < 4; ++r) { const float mine = g[r], other = __shfl_xor(mine, 32); gt[r] = h ? other : mine; gt[4 + r] = h ? mine : other; }
#pragma unroll
            for (int rep = 0; rep < 3; ++rep) { float best = -3.0e38f; int bi = 0;
#pragma unroll
                for (int nn = 0; nn < 7; ++nn) { const bool ok = (nn < qb) && !((selmask >> nn) & 1u) && (gt[nn] > best); best = ok ? gt[nn] : best; bi = ok ? nn : bi; }
                selmask |= 1u << bi; }
        }
    }
    f32x16 o[4];
#pragma unroll
    for (int dt = 0; dt < 4; ++dt)
#pragma unroll
        for (int i = 0; i < 16; ++i) o[dt][i] = 0.f;
    float mrun = -1.0e30f, lsum = 0.f;
    const int qloc = 32 * w + l31;
    int kbase[8], vbase[8], vb4[4];
    { const int x = l31 & 15, xs = (l31 >> 1) & 7;
#pragma unroll
      for (int kl = 0; kl < 8; ++kl) kbase[kl] = l31 * KROWB + (((2 * kl + h) ^ x) * 16);
#pragma unroll
      for (int cc = 0; cc < 8; ++cc) vbase[cc] = l31 * 128 + ((cc ^ xs) * 16) + 8 * h;
#pragma unroll
      for (int st = 0; st < 4; ++st) vb4[st] = l31 * 128 + (((2 * st + h) ^ xs) * 16); }
    VM_WAIT(); __syncthreads();
    for (int t = 0; t < nt; ++t) {
        if (t + 1 < nt && FABL != 4) FL_ISSUE(t + 1, (t + 1) & 1);
        bool need = true; int kind = 0; const int tt = t & 3; float tscale = 1.f; int blk = 0;
        if (MODE == 0) { if (t < 4) { kind = 1; need = (64 * tt <= 32 * w + 31); } else { kind = 2; blk = (t - 4) >> 2; need = __any((int)((selmask >> blk) & 1u)) != 0; } }
        if (MODE == 2) { const int J = t >> 2; if (J == a.qblk) { kind = 1; need = (64 * tt <= 32 * w + 31); } tscale = fast_exp2(a.lg2g * 256.0f * (float)(a.qblk - J)); }
        if (need) {
            const LAS unsigned char* kb = lds + FL_KBUF + (t & 1) * 32768; const LAS unsigned char* vb = lds + FL_VBUF + (t & 1) * 16384;
#define FL_KRD(k2, ks) (*(const LAS bf16x8*)(kb + kbase[(ks) & 7] + (32 * (k2)) * KROWB + ((ks) >> 3) * 256))
#define FL_QK(sv, k2) do { _Pragma("unroll") for (int i = 0; i < 16; ++i) sv[i] = 0.f; \
                bf16x8 f0 = FL_KRD(k2, 0), f1 = FL_KRD(k2, 1), f2 = FL_KRD(k2, 2), f3 = FL_KRD(k2, 3); \
                _Pragma("unroll") for (int ks = 0; ks < KS; ks += 4) { \
                    sv = __builtin_amdgcn_mfma_f32_32x32x16_bf16(f0, qf[ks], sv, 0, 0, 0);     if (ks + 4 < KS) f0 = FL_KRD(k2, ks + 4); \
                    sv = __builtin_amdgcn_mfma_f32_32x32x16_bf16(f1, qf[ks + 1], sv, 0, 0, 0); if (ks + 5 < KS) f1 = FL_KRD(k2, ks + 5); \
                    sv = __builtin_amdgcn_mfma_f32_32x32x16_bf16(f2, qf[ks + 2], sv, 0, 0, 0); if (ks + 6 < KS) f2 = FL_KRD(k2, ks + 6); \
                    sv = __builtin_amdgcn_mfma_f32_32x32x16_bf16(f3, qf[ks + 3], sv, 0, 0, 0); if (ks + 7 < KS) f3 = FL_KRD(k2, ks + 7); } } while (0)
#define FL_VRD(st, dt) (MODE != 2) ? (*(const LAS bf16x8*)(vb + vb4[st] + (dt) * 4096)) : ({ const u32x2 lo_ = *(const LAS u32x2*)(vb + vbase[2 * (st)] + (dt) * 4096), hi_ = *(const LAS u32x2*)(vb + vbase[2 * (st) + 1] + (dt) * 4096); __builtin_bit_cast(bf16x8, (u32x4){lo_.x, lo_.y, hi_.x, hi_.y}); })
#define FL_PACK(sv, sx) ({ u32x4 pw_; pw_.x = pk2(sv[8 * (sx) + 0], sv[8 * (sx) + 1]); pw_.y = pk2(sv[8 * (sx) + 2], sv[8 * (sx) + 3]); pw_.z = pk2(sv[8 * (sx) + 4], sv[8 * (sx) + 5]); pw_.w = pk2(sv[8 * (sx) + 6], sv[8 * (sx) + 7]); __builtin_bit_cast(bf16x8, pw_); })
#define FL_PV(sa, sb, st0, NST) do { bf16x8 va[NDT]; _Pragma("unroll") for (int dt = 0; dt < NDT; ++dt) va[dt] = FL_VRD(st0, dt); \
                _Pragma("unroll") for (int q_ = 0; q_ < (NST); ++q_) { const int st = (st0) + q_; const bf16x8 pb = (q_ < 2) ? FL_PACK(sa, q_ & 1) : FL_PACK(sb, q_ & 1); \
                    _Pragma("unroll") for (int dt = 0; dt < NDT; ++dt) { o[dt] = __builtin_amdgcn_mfma_f32_32x32x16_bf16(va[dt], pb, o[dt], 0, 0, 0); if (q_ + 1 < (NST)) va[dt] = FL_VRD(st + 1, dt); } } } while (0)
            if (MODE == 2) {
#pragma unroll
                for (int k2 = 0; k2 < 2; ++k2) { f32x16 sv; FL_QK(sv, k2);
                    const int thr = (kind == 1) ? (qloc - 64 * tt - 32 * k2 - 4 * h) : 1000;
#pragma unroll
                    for (int r = 0; r < 16; ++r) { const int fr_ = (r & 3) + 8 * (r >> 2); const float v = sv[r] * tscale; sv[r] = (fr_ > thr) ? 0.f : v; }
                    FL_PV(sv, sv, 2 * k2, 2); }
            } else {
                f32x16 s0, s1; if (FABL == 1) { for (int i = 0; i < 16; ++i) { s0[i] = 0.f; s1[i] = 0.f; } } else { FL_QK(s0, 0); FL_QK(s1, 1); }
                bool rowsel = true;
                if (MODE == 0) {
                    if (kind == 1) {
                        const int thr = qloc - 64 * tt - 4 * h;
#pragma unroll
                        for (int r = 0; r < 16; ++r) { const int fr_ = (r & 3) + 8 * (r >> 2); s0[r] = (fr_ <= thr) ? s0[r] : -1.0e30f; s1[r] = (fr_ + 32 <= thr) ? s1[r] : -1.0e30f; }
                    } else rowsel = ((selmask >> blk) & 1u) != 0u;
                }
                if (FABL != 3) {
                float mx = fmaxf(s0[0], s1[0]);
#pragma unroll
                for (int r = 1; r < 16; ++r) mx = fmaxf(mx, fmaxf(s0[r], s1[r]));
                mx = rowsel ? mx : -1.0e30f;
                mx = fmaxf(mx, __shfl_xor(mx, 32));
                if (!__all((int)(mx <= mrun + 8.0f))) {
                    const float mnew = fmaxf(mrun, mx), alpha = fast_exp2(mrun - mnew); mrun = mnew; lsum *= alpha;
#pragma unroll
                    for (int dt = 0; dt < NDT; ++dt) o[dt] = o[dt] * alpha;
                }
                float ps = 0.f;
                const float msub = rowsel ? mrun : 3.0e38f;
#pragma unroll
                for (int r = 0; r < 16; ++r) { const float p0 = fast_exp2(s0[r] - msub), p1 = fast_exp2(s1[r] - msub); s0[r] = p0; s1[r] = p1; ps += p0 + p1; }
                lsum += ps;
                }
                if (FABL != 2) FL_PV(s0, s1, 0, 4);
            }
#undef FL_KRD
#undef FL_QK
#undef FL_VRD
#undef FL_PACK
#undef FL_PV
        }
        VM_WAIT();
        __syncthreads();
    }
#undef FL_ISSUE
#undef FL_TILE_KB
    if (FABL != 0) { _Pragma("unroll") for (int dt = 0; dt < NDT; ++dt) asm volatile("" :: "v"(o[dt])); asm volatile("" :: "v"(lsum), "v"(mrun)); return; }
    const size_t grow = a.qrow0 + (size_t)qloc;
    if (MODE != 2) {
        const float ltot = lsum + __shfl_xor(lsum, 32), inv = 1.0f / ltot;
        GAS unsigned char* op = (GAS unsigned char*)a.O + grow * a.ldo + a.ocol + 4 * h; const float i8_ = inv * Y8_SCALE;
#pragma unroll
        for (int dt = 0; dt < 4; ++dt)
#pragma unroll
            for (int g4 = 0; g4 < 4; ++g4) { unsigned w8 = 0; w8 = __builtin_amdgcn_cvt_pk_fp8_f32(f8c(o[dt][4 * g4] * i8_), f8c(o[dt][4 * g4 + 1] * i8_), w8, false); w8 = __builtin_amdgcn_cvt_pk_fp8_f32(f8c(o[dt][4 * g4 + 2] * i8_), f8c(o[dt][4 * g4 + 3] * i8_), w8, true); *(GAS unsigned*)(op + 32 * dt + 8 * g4) = w8; }
    } else {
        float sm = 0.f, sq = 0.f;
        GAS bf16_t* op = a.O + grow * a.ldo + a.ocol + 4 * h;
#pragma unroll
        for (int dt = 0; dt < 4; ++dt)
#pragma unroll
            for (int g4 = 0; g4 < 4; ++g4) {
#pragma unroll
                for (int j = 0; j < 4; ++j) { const float v = o[dt][4 * g4 + j]; sm += v; sq += v * v; }
                u32x2 wv; wv.x = pk2(o[dt][4 * g4], o[dt][4 * g4 + 1]); wv.y = pk2(o[dt][4 * g4 + 2], o[dt][4 * g4 + 3]); *(GAS u32x2*)(op + 32 * dt + 8 * g4) = wv; }
        sm += __shfl_xor(sm, 32); sq += __shfl_xor(sq, 32);
        if (h == 0) { f32x2 st = {sm, sq}; *(GAS f32x2*)(a.stat + grow * 32) = st; }
    }
}
__device__ __forceinline__ void moba_kmean(LAS unsigned char* lds, const GAS bf16_t* K, size_t krow0, int kcol, int nb, int tid) {
    LAS float* part = (LAS float*)(lds + FL_PART); LAS float* km = (LAS float*)(lds + FL_KMEAN);
    const int c = tid & 15, rg = tid >> 4;
    for (int n0 = 0; n0 < nb; n0 += 4) {
        u32x4 v[4][8];
#pragma unroll
        for (int q = 0; q < 4; ++q) { const int n = (n0 + q < nb) ? n0 + q : nb - 1;
#pragma unroll
            for (int i = 0; i < 8; ++i) v[q][i] = *(const GAS u32x4*)(K + (krow0 + 256 * n + rg + 32 * i) * 1024 + kcol + 8 * c); }
#pragma unroll
        for (int q = 0; q < 4; ++q) { if (n0 + q < nb) {
            float acc[8] = {0, 0, 0, 0, 0, 0, 0, 0};
#pragma unroll
            for (int i = 0; i < 8; ++i) { const u32x4 w = v[q][i];
                acc[0] += bf_lo(w.x); acc[1] += bf_hi(w.x); acc[2] += bf_lo(w.y); acc[3] += bf_hi(w.y); acc[4] += bf_lo(w.z); acc[5] += bf_hi(w.z); acc[6] += bf_lo(w.w); acc[7] += bf_hi(w.w); }
#pragma unroll
            for (int j = 0; j < 8; ++j) part[rg * 128 + 8 * c + j] = acc[j];
            __syncthreads();
            if (tid < 128) { float s = 0.f;
#pragma unroll 8
                for (int r = 0; r < 32; ++r) s += part[r * 128 + tid]; km[(n0 + q) * 128 + tid] = s * (1.0f / 256.0f); }
            __syncthreads(); } }
    }
}
constexpr int RT_KBUF = 0, RT_VSLAB = 65536, RT_PBUF = 131072, RT_STAT = 0;
template <int ABL> __device__ __forceinline__ void retention_unit(LAS unsigned char* lds, GAS unsigned char* ws, int b, int hh, int qc, int tid) {
    asm volatile("" : "+v"(tid));
    const int lane = tid & 63, w = __builtin_amdgcn_readfirstlane(tid >> 6), l15 = lane & 15, kg = lane >> 4, l31 = lane & 31, h = lane >> 5;
    const int nt = 2 * (qc + 1);
    const GAS bf16_t* Q = (const GAS bf16_t*)(ws + WS_RQ); const GAS bf16_t* K = (const GAS bf16_t*)(ws + WS_RK); const GAS bf16_t* VT = (const GAS bf16_t*)(ws + WS_RVT);
    const size_t trow0 = (size_t)b * SEQ + 128 * qc;
    const float lg2g = log2f(1.0f - exp2f(-5.0f - (float)hh));
    const int k_row = lane >> 5, k_cp = lane & 31;
#define RT_ISSUE_K(t, buf) do { \
        _Pragma("unroll") for (int i = 0; i < 4; ++i) { const int pidx = w + 8 * i, row = 2 * pidx + k_row, c = k_cp ^ (row & 15); \
            __builtin_amdgcn_global_load_lds((const GAS unsigned*)(K + ((size_t)b * SEQ + 64 * (t) + row) * 1024 + hh * 256 + 8 * c), (LAS unsigned*)(lds + RT_KBUF + (buf) * 32768 + pidx * 1024), 16, 0, 0); } } while (0)
    const int v_row = lane >> 3, v_cp = lane & 7;
    const GAS bf16_t* vsrc = VT + ((size_t)b * 2048 + hh * 512 + 64 * w) * SEQ;
#define RT_ISSUE_V(t) do { \
        _Pragma("unroll") for (int i = 0; i < 8; ++i) { const int row = 8 * i + v_row, c = v_cp ^ ((row >> 1) & 7); \
            __builtin_amdgcn_global_load_lds((const GAS unsigned*)(vsrc + (size_t)row * SEQ + 64 * (t) + 8 * c), (LAS unsigned*)(lds + RT_VSLAB + w * 8192 + (8 * i) * 128), 16, 0, 0); } } while (0)
    RT_ISSUE_K(0, 0); RT_ISSUE_V(0); RT_ISSUE_K(1, 1);
    bf16x8 qf[8];
    { const GAS bf16_t* qp = Q + (trow0 + 16 * w + l15) * 1024 + hh * 256 + 8 * kg;
#pragma unroll
      for (int ks = 0; ks < 8; ++ks) qf[ks] = *(const GAS bf16x8*)(qp + 32 * ks); }
    f32x16 o[2][4];
#pragma unroll
    for (int a = 0; a < 2; ++a)
#pragma unroll
        for (int c = 0; c < 4; ++c)
#pragma unroll
            for (int i = 0; i < 16; ++i) o[a][c][i] = 0.f;
    const int kbaseS = l15 * 512;
    const int pw_q = 16 * w + l15;
    const int pw_off = pw_q * 128, pw_x = (pw_q >> 1) & 7;
    const int pr_x = (l31 >> 1) & 7;
    const LAS unsigned char* vslab = lds + RT_VSLAB + w * 8192;
    LAS unsigned char* pbuf = lds + RT_PBUF;
    asm volatile("s_waitcnt vmcnt(0)" ::: "memory"); __builtin_amdgcn_s_barrier(); asm volatile("" ::: "memory");
    for (int t = 0; t < nt; ++t) {
        const bool diag = (t >= 2 * qc);
        const int koff = 64 * (t - 2 * qc);
        const LAS unsigned char* kb = lds + RT_KBUF + (t & 1) * 32768;
        const float tsc = fast_exp2(lg2g * 256.0f * (float)((qc >> 1) - (t >> 2)));
        f32x4 sa[4];
#pragma unroll
        for (int kt = 0; kt < 4; ++kt) sa[kt] = (f32x4){0.f, 0.f, 0.f, 0.f};
        if (ABL != 1) {
#define RT_KF(i) (*(const LAS bf16x8*)(kb + kbaseS + ((i) >> 3) * 16 * 512 + (((4 * ((i) & 7) + kg) ^ l15) * 16)))
            bf16x8 kf[4];
#pragma unroll
            for (int i = 0; i < 4; ++i) kf[i] = RT_KF(i);
#pragma unroll
            for (int i = 0; i < 32; ++i) { sa[i >> 3] = __builtin_amdgcn_mfma_f32_16x16x32_bf16(kf[i & 3], qf[i & 7], sa[i >> 3], 0, 0, 0); if (i + 4 < 32) kf[i & 3] = RT_KF(i + 4); }
#undef RT_KF
        }
        asm volatile("s_waitcnt lgkmcnt(0)" ::: "memory"); __builtin_amdgcn_s_barrier(); asm volatile("" ::: "memory");
#pragma unroll
        for (int kt = 0; kt < 4; ++kt) { const int key0 = 16 * kt + 4 * kg;
            float v[4];
#pragma unroll
            for (int r = 0; r < 4; ++r) { v[r] = sa[kt][r] * tsc; if (diag && (koff + key0 + r > pw_q)) v[r] = 0.f; }
            const int c8 = key0 >> 2, c16 = c8 >> 1, half = c8 & 1;
            u32x2 pk; pk.x = pk2(v[0], v[1]); pk.y = pk2(v[2], v[3]);
            *(LAS u32x2*)(pbuf + pw_off + ((c16 ^ pw_x) * 16) + half * 8) = pk; }
        asm volatile("s_waitcnt vmcnt(0) lgkmcnt(0)" ::: "memory"); __builtin_amdgcn_s_barrier(); asm volatile("" ::: "memory");
        if (t + 2 < nt && ABL != 4) RT_ISSUE_K(t + 2, t & 1);
#pragma unroll
        for (int sx = 0; sx < 4; ++sx) { if (ABL == 2) continue;
            bf16x8 pb[4];
#pragma unroll
            for (int qt2 = 0; qt2 < 4; ++qt2) pb[qt2] = *(const LAS bf16x8*)(pbuf + (32 * qt2 + l31) * 128 + (((2 * sx + h) ^ pr_x) * 16));
#pragma unroll
            for (int dvt = 0; dvt < 2; ++dvt) { const bf16x8 va = *(const LAS bf16x8*)(vslab + (32 * dvt + l31) * 128 + (((2 * sx + h) ^ pr_x) * 16));
#pragma unroll
                for (int qt2 = 0; qt2 < 4; ++qt2) o[dvt][qt2] = __builtin_amdgcn_mfma_f32_32x32x16_bf16(va, pb[qt2], o[dvt][qt2], 0, 0, 0); } }
        asm volatile("s_waitcnt lgkmcnt(0)" ::: "memory");
        __builtin_amdgcn_sched_barrier(0);
        if (t + 1 < nt && ABL != 3) RT_ISSUE_V(t + 1);
    }
#undef RT_ISSUE_K
#undef RT_ISSUE_V
    if (ABL != 0) { _Pragma("unroll") for (int a = 0; a < 2; ++a) _Pragma("unroll") for (int c = 0; c < 4; ++c) asm volatile("" :: "v"(o[a][c])); __syncthreads(); return; }
    __syncthreads();
    LAS float* st = (LAS float*)(lds + RT_STAT);
#pragma unroll
    for (int qt2 = 0; qt2 < 4; ++qt2) { float sm = 0.f, sq = 0.f;
#pragma unroll
        for (int dvt = 0; dvt < 2; ++dvt)
#pragma unroll
            for (int r = 0; r < 16; ++r) { const float v = o[dvt][qt2][r]; sm += v; sq += v * v; }
        sm += __shfl_xor(sm, 32); sq += __shfl_xor(sq, 32);
        if (h == 0) { st[(w * 128 + 32 * qt2 + l31) * 2] = sm; st[(w * 128 + 32 * qt2 + l31) * 2 + 1] = sq; } }
    __syncthreads();
    const GAS bf16_t* rgs = (const GAS bf16_t*)(ws + WS_RGS); GAS bf16_t* yr = (GAS bf16_t*)(ws + WS_YR);
#pragma unroll
    for (int qt2 = 0; qt2 < 4; ++qt2) { const int q = 32 * qt2 + l31; float sm = 0.f, sq = 0.f;
#pragma unroll
        for (int ww = 0; ww < 8; ++ww) { sm += st[(ww * 128 + q) * 2]; sq += st[(ww * 128 + q) * 2 + 1]; }
        const float mean = sm * (1.0f / 512.0f), var = fmaxf(sq * (1.0f / 512.0f) - mean * mean, 0.f), rstd = 1.0f / sqrtf(var + GN_EPS);
        const size_t off = (trow0 + q) * 2048 + hh * 512 + 64 * w + 4 * h;
#pragma unroll
        for (int dvt = 0; dvt < 2; ++dvt)
#pragma unroll
            for (int g4 = 0; g4 < 4; ++g4) { const u32x2 gv = *(const GAS u32x2*)(rgs + off + 32 * dvt + 8 * g4);
                const float rs8 = rstd * Y8_SCALE; unsigned w8 = 0;
                w8 = __builtin_amdgcn_cvt_pk_fp8_f32(f8c(bf_lo(gv.x) * (o[dvt][qt2][4 * g4] - mean) * rs8), f8c(bf_hi(gv.x) * (o[dvt][qt2][4 * g4 + 1] - mean) * rs8), w8, false);
                w8 = __builtin_amdgcn_cvt_pk_fp8_f32(f8c(bf_lo(gv.y) * (o[dvt][qt2][4 * g4 + 2] - mean) * rs8), f8c(bf_hi(gv.y) * (o[dvt][qt2][4 * g4 + 3] - mean) * rs8), w8, true);
                *(GAS unsigned*)((GAS unsigned char*)yr + off + 32 * dvt + 8 * g4) = w8; } }
    __syncthreads();
}
__device__ __forceinline__ void phase_mixers(Frame& F) {
    GAS unsigned char* ws = KWS(); const int c = F.vcu; LAS unsigned char* lds = F.lds; int tid = F.tid; asm volatile("" : "+v"(tid));
#ifndef DUP_MASK
#define DUP_MASK 0
#endif
#define NREPM(k) ((((DUP_MASK) >> (k)) & 1) ? 2 : 1)
    for (int rp_ = 0; rp_ < NREPM(10); ++rp_) { const int bh = c >> 2, pi = c & 3, b = bh >> 3, hh = bh & 7;
      const int qb_hi = 7 - pi;
      moba_kmean(lds, (const GAS bf16_t*)(ws + WS_AK), (size_t)b * SEQ, hh * 128, qb_hi, tid);
      for (int rep = 0; rep < 2; ++rep) { const int qb = rep ? pi : qb_hi;
          FlashArgs a; a.Q = (const GAS bf16_t*)(ws + WS_AQ); a.ldq = 1024; a.qrow0 = (size_t)b * SEQ + 256 * qb; a.qcol = hh * 128;
          a.K = (const GAS bf16_t*)(ws + WS_AK); a.ldk = 1024; a.krow0 = (size_t)b * SEQ; a.kcol = hh * 128;
          a.VT = (const GAS bf16_t*)(ws + WS_AVT); a.ldvt = SEQ; a.vrow0 = (size_t)b * 1024 + hh * 128; a.vcol0 = 0;
          a.O = (GAS bf16_t*)(ws + WS_YA); a.ldo = 1024; a.ocol = hh * 128; a.qblk = qb; a.stat = nullptr; a.lg2g = 0.f;
          flash_unit<0, 128>(lds, a, tid);
#ifdef FL_ABL
          flash_unit<0, 128, FL_ABL>(lds, a, tid); flash_unit<0, 128>(lds, a, tid);
#endif
          } }
    for (int j = 0; j < 2 * NREPM(11); ++j) { const int bh = c >> 3, pi = c & 7, b = bh >> 2, hh = bh & 3;
        retention_unit<0>(lds, ws, b, hh, (j & 1) ? pi : 15 - pi, tid); }
#ifdef RT_ABL
    for (int j = 0; j < 2; ++j) { const int bh = c >> 3, pi = c & 7, b = bh >> 2, hh = bh & 3; retention_unit<RT_ABL>(lds, ws, b, hh, (j & 1) ? pi : 15 - pi, tid); }
    for (int j = 0; j < 2; ++j) { const int bh = c >> 3, pi = c & 7, b = bh >> 2, hh = bh & 3; retention_unit<0>(lds, ws, b, hh, (j & 1) ? pi : 15 - pi, tid); }
#endif
    for (int k = 0; k < 2 * NREPM(12); ++k) { const int m = 2 * c + (k & 1), p = m & 1, qb = (m >> 1) & 7, bh = m >> 4, b = bh >> 2, hh = bh & 3;
        FlashArgs a; a.Q = (const GAS bf16_t*)(ws + WS_MQ); a.ldq = 1024; a.qrow0 = (size_t)b * SEQ + 256 * qb; a.qcol = hh * 256;
        a.K = (const GAS bf16_t*)(ws + WS_KM); a.ldk = 1024; a.krow0 = (size_t)b * 256; a.kcol = hh * 256;
        a.VT = (const GAS bf16_t*)(ws + WS_VMT); a.ldvt = 2048; a.vrow0 = (size_t)hh * 256 + p * 128; a.vcol0 = (size_t)b * 256;
        a.O = (GAS bf16_t*)(ws + WS_YM); a.ldo = 1024; a.ocol = hh * 256 + p * 128; a.qblk = 0; a.stat = nullptr; a.lg2g = 0.f;
        flash_unit<1, 256>(lds, a, tid); }
}
__device__ __forceinline__ void phase_retnorm(Frame& F) {
    GAS unsigned char* ws = KWS(); const int gw = F.vcu * NWAVES + F.wave, NGW = F.G * NWAVES;
    const GAS bf16_t* ro = (const GAS bf16_t*)(ws + WS_RO); const GAS bf16_t* rgs = (const GAS bf16_t*)(ws + WS_RGS); const GAS float* st = (const GAS float*)(ws + WS_RSTAT); GAS bf16_t* yr = (GAS bf16_t*)(ws + WS_YR);
    for (int row = gw; row < T; row += NGW) {
#pragma unroll
        for (int hh = 0; hh < 4; ++hh) {
            const f32x4 s01 = *(const GAS f32x4*)(st + (size_t)row * 32 + hh * 8), s23 = *(const GAS f32x4*)(st + (size_t)row * 32 + hh * 8 + 4);
            const float sm = (s01[0] + s01[2]) + (s23[0] + s23[2]), sq = (s01[1] + s01[3]) + (s23[1] + s23[3]);
            const float mean = sm * (1.0f / 512.0f), var = fmaxf(sq * (1.0f / 512.0f) - mean * mean, 0.f), rstd = 1.0f / sqrtf(var + GN_EPS);
            const size_t off = (size_t)row * 2048 + hh * 512 + 8 * F.lane;
            const u32x4 ov = *(const GAS u32x4*)(ro + off), gv = *(const GAS u32x4*)(rgs + off);
            u32x4 w; w.x = pk2(bf_lo(gv.x) * (bf_lo(ov.x) - mean) * rstd, bf_hi(gv.x) * (bf_hi(ov.x) - mean) * rstd); w.y = pk2(bf_lo(gv.y) * (bf_lo(ov.y) - mean) * rstd, bf_hi(gv.y) * (bf_hi(ov.y) - mean) * rstd);
            w.z = pk2(bf_lo(gv.z) * (bf_lo(ov.z) - mean) * rstd, bf_hi(gv.z) * (bf_hi(ov.z) - mean) * rstd); w.w = pk2(bf_lo(gv.w) * (bf_lo(ov.w) - mean) * rstd, bf_hi(gv.w) * (bf_hi(ov.w) - mean) * rstd);
            *(GAS u32x4*)(yr + off) = w; }
    }
}

__device__ __forceinline__ void ln_row(f32x4 (&v)[8], const GAS float* g, const GAS float* bta, int lane) {
    float s = 0.f;
#pragma unroll
    for (int j = 0; j < 8; ++j) s += (v[j][0] + v[j][1]) + (v[j][2] + v[j][3]);
    const float mean = wave_sum(s) * (1.0f / D); float s2 = 0.f;
#pragma unroll
    for (int j = 0; j < 8; ++j) { v[j] = v[j] - mean; s2 += (v[j][0] * v[j][0] + v[j][1] * v[j][1]) + (v[j][2] * v[j][2] + v[j][3] * v[j][3]); }
    const float rstd = 1.0f / sqrtf(wave_sum(s2) * (1.0f / D) + LN_EPS);
#pragma unroll
    for (int j = 0; j < 8; ++j) { const f32x4 gg = *(const GAS f32x4*)(g + 4 * lane + 256 * j), bb = *(const GAS f32x4*)(bta + 4 * lane + 256 * j); v[j] = v[j] * rstd * gg + bb; }
}
constexpr int R2_PLD = 49, R2_PART = 0, R2_STAT = R2_PART + 8 * 64 * R2_PLD * 4, R2_LGLD = 37, R2_LG = R2_STAT + 8 * 64 * 2 * 4, R2_SEL = R2_LG + 64 * R2_LGLD * 4, R2_CNT = R2_SEL + 64 * 4 * 4;
static_assert(R2_CNT + 256 <= LDS_TAB, "LN1/router LDS map");
__device__ __forceinline__ void phase_ln1_router(Frame& F, int l, bool commit) {
    GAS unsigned char* ws = KWS(); LAS unsigned char* lds = F.lds;
    const GAS float* g1 = KIN(8) + (size_t)l * D; const GAS float* b1 = KIN(9) + (size_t)l * D;
    const GAS bf16_t* hpre = (const GAS bf16_t*)(ws + WS_HPRE); GAS bf16_t* x1b = (GAS bf16_t*)(ws + WS_X1B);
    const GAS bf16_t* wgh = (const GAS bf16_t*)(ws + WS_WRT); const GAS bf16_t* wgl = (const GAS bf16_t*)(ws + WS_WRT + WRT_GL);
    const GAS float* csp = (const GAS float*)(ws + WS_WRT + WRT_CS); const GAS float* c0p = (const GAS float*)(ws + WS_WRT + WRT_C0);
    GAS int* list = (GAS int*)(ws + WS_LIST); GAS float* tokw = (GAS float*)(ws + WS_TOKW);
    GAS unsigned* gcnt = (GAS unsigned*)(ws + WS_CTL) + CW_CNT + l * 64 * NEXP;
    LAS float* part = (LAS float*)(lds + R2_PART); LAS float* stat = (LAS float*)(lds + R2_STAT); LAS float* lgt = (LAS float*)(lds + R2_LG); LAS int* sel = (LAS int*)(lds + R2_SEL);
    LAS int* lcnt = (LAS int*)(lds + R2_CNT); LAS int* lbase = lcnt + 32;
    for (int grp = F.vcu; grp < T / 64; grp += F.G) {
        int tid = F.tid; asm volatile("" : "+v"(tid));
        const int lane = tid & 63, r = lane & 15, q = lane >> 4, w = __builtin_amdgcn_readfirstlane(tid >> 6);
        const int row0 = grp * 64;
        if (tid < 32) lcnt[tid] = 0;
        const size_t coff = (size_t)(256 * w + 8 * q);
        const GAS bf16_t* hp = hpre + (size_t)(row0 + r) * D + coff;
        const GAS bf16_t* bh = wgh + (size_t)r * D + coff; const GAS bf16_t* bl = wgl + (size_t)r * D + coff;
        u32x4 A[2][2][8];
#pragma unroll
        for (int tt = 0; tt < 2; ++tt)
#pragma unroll
            for (int ks = 0; ks < 8; ++ks) A[0][tt][ks] = *(const GAS u32x4*)(hp + (size_t)(16 * tt) * D + 32 * ks);
        __builtin_amdgcn_sched_barrier(0);
#pragma unroll
        for (int hf = 0; hf < 2; ++hf) {
            u32x4 Bc[3][2], Bn[3][2];
#pragma unroll
            for (int ct = 0; ct < 3; ++ct) { Bc[ct][0] = *(const GAS u32x4*)(bh + (size_t)16 * ct * D); Bc[ct][1] = *(const GAS u32x4*)(bl + (size_t)16 * ct * D); }
            f32x4 acc[2][3];
#pragma unroll
            for (int tt = 0; tt < 2; ++tt)
#pragma unroll
                for (int ct = 0; ct < 3; ++ct) acc[tt][ct] = (f32x4){0.f, 0.f, 0.f, 0.f};
#pragma unroll
            for (int ks = 0; ks < 8; ++ks) {
                if (ks < 7) {
#pragma unroll
                    for (int ct = 0; ct < 3; ++ct) { Bn[ct][0] = *(const GAS u32x4*)(bh + (size_t)16 * ct * D + 32 * (ks + 1)); Bn[ct][1] = *(const GAS u32x4*)(bl + (size_t)16 * ct * D + 32 * (ks + 1)); } }
#pragma unroll
                for (int tt = 0; tt < 2; ++tt)
#pragma unroll
                    for (int ct = 0; ct < 3; ++ct) {
                        acc[tt][ct] = __builtin_amdgcn_mfma_f32_16x16x32_bf16(__builtin_bit_cast(bf16x8, A[hf][tt][ks]), __builtin_bit_cast(bf16x8, Bc[ct][0]), acc[tt][ct], 0, 0, 0);
                        acc[tt][ct] = __builtin_amdgcn_mfma_f32_16x16x32_bf16(__builtin_bit_cast(bf16x8, A[hf][tt][ks]), __builtin_bit_cast(bf16x8, Bc[ct][1]), acc[tt][ct], 0, 0, 0); }
                if (ks < 7) {
#pragma unroll
                    for (int ct = 0; ct < 3; ++ct) { Bc[ct][0] = Bn[ct][0]; Bc[ct][1] = Bn[ct][1]; } }
                __builtin_amdgcn_sched_barrier(0);
            }
#pragma unroll
            for (int tt = 0; tt < 2; ++tt)
#pragma unroll
                for (int ct = 0; ct < 3; ++ct)
#pragma unroll
                    for (int i = 0; i < 4; ++i) part[(w * 64 + 32 * hf + 16 * tt + 4 * q + i) * R2_PLD + 16 * ct + r] = acc[tt][ct][i];
#pragma unroll
            for (int tt = 0; tt < 2; ++tt) { float s1 = 0.f, s2 = 0.f;
#pragma unroll
                for (int ks = 0; ks < 8; ++ks)
#pragma unroll
                    for (int e = 0; e < 4; ++e) { const u32x4 av = A[hf][tt][ks]; const unsigned u = e == 0 ? av.x : (e == 1 ? av.y : (e == 2 ? av.z : av.w)); const bf16x2_t pv = __builtin_bit_cast(bf16x2_t, u);
                        s1 = __builtin_amdgcn_fdot2_f32_bf16(pv, __builtin_bit_cast(bf16x2_t, 0x3f803f80u), s1, false); s2 = __builtin_amdgcn_fdot2_f32_bf16(pv, pv, s2, false); }
                s1 += __shfl_xor(s1, 16); s1 += __shfl_xor(s1, 32); s2 += __shfl_xor(s2, 16); s2 += __shfl_xor(s2, 32);
                if (q == 0) { stat[(w * 64 + 32 * hf + 16 * tt + r) * 2] = s1; stat[(w * 64 + 32 * hf + 16 * tt + r) * 2 + 1] = s2; } }
            __builtin_amdgcn_sched_barrier(0);
            if (hf == 0) {
#pragma unroll
                for (int tt = 0; tt < 2; ++tt)
#pragma unroll
                    for (int ks = 0; ks < 8; ++ks) A[1][tt][ks] = *(const GAS u32x4*)(hp + (size_t)(32 + 16 * tt) * D + 32 * ks); }
            __builtin_amdgcn_sched_barrier(0);
            __syncthreads();
            { float mu[2], rs[2];
#pragma unroll
              for (int tt = 0; tt < 2; ++tt) { float S1 = 0.f, S2 = 0.f;
#pragma unroll
                  for (int ww = 0; ww < 8; ++ww) { S1 += stat[(ww * 64 + 32 * hf + 16 * tt + r) * 2]; S2 += stat[(ww * 64 + 32 * hf + 16 * tt + r) * 2 + 1]; }
                  mu[tt] = S1 * (1.0f / D); rs[tt] = 1.0f / sqrtf(fmaxf(S2 * (1.0f / D) - mu[tt] * mu[tt], 0.f) + LN_EPS); }
              GAS bf16_t* xp = x1b + (size_t)(row0 + 32 * hf + r) * D + coff;
              f32x4 gc[4], gn[4];
              gc[0] = *(const GAS f32x4*)(g1 + coff); gc[1] = *(const GAS f32x4*)(g1 + coff + 4); gc[2] = *(const GAS f32x4*)(b1 + coff); gc[3] = *(const GAS f32x4*)(b1 + coff + 4);
#pragma unroll
              for (int ks = 0; ks < 8; ++ks) {
                  if (ks < 7) { gn[0] = *(const GAS f32x4*)(g1 + coff + 32 * (ks + 1)); gn[1] = *(const GAS f32x4*)(g1 + coff + 32 * (ks + 1) + 4); gn[2] = *(const GAS f32x4*)(b1 + coff + 32 * (ks + 1)); gn[3] = *(const GAS f32x4*)(b1 + coff + 32 * (ks + 1) + 4); }
#pragma unroll
                  for (int tt = 0; tt < 2; ++tt) { u32x4 h = A[hf][tt][ks]; asm volatile("" : "+v"(h)); const float m = mu[tt], sc = rs[tt]; u32x4 o;
                      o.x = pk2((bf_lo(h.x) - m) * sc * gc[0][0] + gc[2][0], (bf_hi(h.x) - m) * sc * gc[0][1] + gc[2][1]); o.y = pk2((bf_lo(h.y) - m) * sc * gc[0][2] + gc[2][2], (bf_hi(h.y) - m) * sc * gc[0][3] + gc[2][3]);
                      o.z = pk2((bf_lo(h.z) - m) * sc * gc[1][0] + gc[3][0], (bf_hi(h.z) - m) * sc * gc[1][1] + gc[3][1]); o.w = pk2((bf_lo(h.w) - m) * sc * gc[1][2] + gc[3][2], (bf_hi(h.w) - m) * sc * gc[1][3] + gc[3][3]);
                      *(GAS u32x4*)(xp + (size_t)(16 * tt) * D + 32 * ks) = o; }
                  if (ks < 7) { gc[0] = gn[0]; gc[1] = gn[1]; gc[2] = gn[2]; gc[3] = gn[3]; }
                  __builtin_amdgcn_sched_barrier(0); } }
            { const int row = 32 * hf + (tid & 31), cg = tid >> 5; float S1 = 0.f, S2 = 0.f;
#pragma unroll
              for (int ww = 0; ww < 8; ++ww) { S1 += stat[(ww * 64 + row) * 2]; S2 += stat[(ww * 64 + row) * 2 + 1]; }
              const float m = S1 * (1.0f / D), sc = 1.0f / sqrtf(fmaxf(S2 * (1.0f / D) - m * m, 0.f) + LN_EPS);
#pragma unroll
              for (int j = 0; j < 3; ++j) { const int c = cg * 3 + j;
                  if (c < 36) { float raw = 0.f;
#pragma unroll
                      for (int ww = 7; ww >= 0; --ww) raw += part[(ww * 64 + row) * R2_PLD + c];
                      lgt[row * R2_LGLD + c] = sc * (raw - m * csp[c]) + c0p[c]; } } }
        }
        __syncthreads();
        if (tid < 64) { const int rl = tid, row = row0 + rl; float lg[36];
#pragma unroll
            for (int cc = 0; cc < 36; ++cc) lg[cc] = lgt[rl * R2_LGLD + cc];
            int gs = 0; float gm = lg[0];
#pragma unroll
            for (int cc = 1; cc < 4; ++cc) if (lg[cc] > gm) { gm = lg[cc]; gs = cc; }
            float den = 0.f;
#pragma unroll
            for (int cc = 0; cc < 4; ++cc) den += __expf(lg[cc] - gm);
            const float pg = 1.0f / den;
            float ev[8];
#pragma unroll
            for (int j = 0; j < 8; ++j) ev[j] = gs == 0 ? lg[4 + j] : (gs == 1 ? lg[12 + j] : (gs == 2 ? lg[20 + j] : lg[28 + j]));
            int i0 = 0; float v0 = ev[0];
#pragma unroll
            for (int j = 1; j < 8; ++j) if (ev[j] > v0) { v0 = ev[j]; i0 = j; }
            int i1 = -1; float v1 = -3.0e38f;
#pragma unroll
            for (int j = 0; j < 8; ++j) if (j != i0 && ev[j] > v1) { v1 = ev[j]; i1 = j; }
            const float ex = __expf(v1 - v0), w0 = pg / (1.0f + ex), w1 = pg * ex / (1.0f + ex);
            const int e0 = gs * 8 + i0, e1 = gs * 8 + i1; int p0 = 0, p1 = 0;
            tokw[(size_t)row * 2] = w0; tokw[(size_t)row * 2 + 1] = w1;
            if (commit) { p0 = __hip_atomic_fetch_add(&lcnt[e0], 1, __ATOMIC_RELAXED, __HIP_MEMORY_SCOPE_WORKGROUP); p1 = __hip_atomic_fetch_add(&lcnt[e1], 1, __ATOMIC_RELAXED, __HIP_MEMORY_SCOPE_WORKGROUP); }
            sel[rl * 4] = e0; sel[rl * 4 + 1] = e1; sel[rl * 4 + 2] = p0; sel[rl * 4 + 3] = p1; }
        __syncthreads();
        if (tid < 32 && commit) lbase[tid] = (int)__hip_atomic_fetch_add(gcnt + 64 * tid, (unsigned)lcnt[tid], __ATOMIC_RELAXED, __HIP_MEMORY_SCOPE_AGENT);
        __syncthreads();
        if (tid < 64 && commit) { const int row = row0 + tid; const int e0 = sel[tid * 4], e1 = sel[tid * 4 + 1], p0 = sel[tid * 4 + 2], p1 = sel[tid * 4 + 3];
            list[(size_t)e0 * T + lbase[e0] + p0] = row * 2; list[(size_t)e1 * T + lbase[e1] + p1] = row * 2 + 1; }
        __syncthreads();
    }
}
__device__ __forceinline__ void phase_ln2(Frame& F, int l) {
    GAS unsigned char* ws = KWS(); const int gw = F.vcu * NWAVES + F.wave, NGW = F.G * NWAVES;
    const GAS float* g2 = KIN(16) + (size_t)l * D; const GAS float* b2 = KIN(17) + (size_t)l * D;
    const GAS bf16_t* x1 = (const GAS bf16_t*)(ws + WS_X1B); const GAS unsigned char* yasg = (const GAS unsigned char*)(ws + WS_YASG); const GAS float* tokw = (const GAS float*)(ws + WS_TOKW);
    GAS float* outf = KOUT(); GAS bf16_t* xb = (GAS bf16_t*)(ws + WS_XB);
    f32x4 gg[8], bb[8];
#pragma unroll
    for (int j = 0; j < 4; ++j) { gg[2 * j] = *(const GAS f32x4*)(g2 + 8 * F.lane + 512 * j); gg[2 * j + 1] = *(const GAS f32x4*)(g2 + 8 * F.lane + 512 * j + 4);
        bb[2 * j] = *(const GAS f32x4*)(b2 + 8 * F.lane + 512 * j); bb[2 * j + 1] = *(const GAS f32x4*)(b2 + 8 * F.lane + 512 * j + 4); }
#pragma unroll 1
    for (int row = gw; row < T; row += NGW) {
        const f32x2 tw = *(const GAS f32x2*)(tokw + (size_t)row * 2); const float w0 = tw[0] * (1.0f / Y8_SCALE), w1 = tw[1] * (1.0f / Y8_SCALE); f32x4 v[8];
        u32x4 xw[4]; u32x2 y0[4], y1[4];
#pragma unroll
        for (int j = 0; j < 4; ++j) { const size_t c = 8 * F.lane + 512 * j; xw[j] = *(const GAS u32x4*)(x1 + (size_t)row * D + c);
            y0[j] = *(const GAS u32x2*)(yasg + (size_t)(2 * row) * D + c); y1[j] = *(const GAS u32x2*)(yasg + (size_t)(2 * row + 1) * D + c); }
        float s = 0.f;
#pragma unroll
        for (int j = 0; j < 4; ++j) {
            const f32x2 a0 = __builtin_amdgcn_cvt_pk_f32_fp8(y0[j].x, false), a1 = __builtin_amdgcn_cvt_pk_f32_fp8(y0[j].x, true), a2 = __builtin_amdgcn_cvt_pk_f32_fp8(y0[j].y, false), a3 = __builtin_amdgcn_cvt_pk_f32_fp8(y0[j].y, true);
            const f32x2 c0 = __builtin_amdgcn_cvt_pk_f32_fp8(y1[j].x, false), c1 = __builtin_amdgcn_cvt_pk_f32_fp8(y1[j].x, true), c2 = __builtin_amdgcn_cvt_pk_f32_fp8(y1[j].y, false), c3 = __builtin_amdgcn_cvt_pk_f32_fp8(y1[j].y, true);
            v[2 * j] = (f32x4){DN_ALPHA * bf_lo(xw[j].x) + (w0 * a0[0] + w1 * c0[0]), DN_ALPHA * bf_hi(xw[j].x) + (w0 * a0[1] + w1 * c0[1]), DN_ALPHA * bf_lo(xw[j].y) + (w0 * a1[0] + w1 * c1[0]), DN_ALPHA * bf_hi(xw[j].y) + (w0 * a1[1] + w1 * c1[1])};
            v[2 * j + 1] = (f32x4){DN_ALPHA * bf_lo(xw[j].z) + (w0 * a2[0] + w1 * c2[0]), DN_ALPHA * bf_hi(xw[j].z) + (w0 * a2[1] + w1 * c2[1]), DN_ALPHA * bf_lo(xw[j].w) + (w0 * a3[0] + w1 * c3[0]), DN_ALPHA * bf_hi(xw[j].w) + (w0 * a3[1] + w1 * c3[1])};
            s += ((v[2 * j][0] + v[2 * j][1]) + (v[2 * j][2] + v[2 * j][3])) + ((v[2 * j + 1][0] + v[2 * j + 1][1]) + (v[2 * j + 1][2] + v[2 * j + 1][3])); }
        const float mean = wave_sum(s) * (1.0f / D); float s2 = 0.f;
#pragma unroll
        for (int j = 0; j < 8; ++j) { v[j] = v[j] - mean; s2 += (v[j][0] * v[j][0] + v[j][1] * v[j][1]) + (v[j][2] * v[j][2] + v[j][3] * v[j][3]); }
        const float rstd = 1.0f / sqrtf(wave_sum(s2) * (1.0f / D) + LN_EPS);
#pragma unroll
        for (int j = 0; j < 8; ++j) v[j] = v[j] * rstd * gg[j] + bb[j];
        float q8 = 0.f;
        if (l != DEPTH - 1) { float mx = 0.f;
#pragma unroll
            for (int j = 0; j < 8; ++j) mx = fmaxf(fmaxf(mx, fmaxf(fabsf(v[j][0]), fabsf(v[j][1]))), fmaxf(fabsf(v[j][2]), fabsf(v[j][3])));
            mx = fmaxf(wave_max(mx), 1e-30f); q8 = 127.0f / mx; if (F.lane == 0) ((GAS float*)(ws + WS_XS))[row] = mx * (1.0f / 127.0f); }
#pragma unroll
        for (int j = 0; j < 4; ++j) { const size_t c = 8 * F.lane + 512 * j;
            if (l == DEPTH - 1) { *(GAS f32x4*)(outf + (size_t)row * D + c) = v[2 * j]; *(GAS f32x4*)(outf + (size_t)row * D + c + 4) = v[2 * j + 1]; }
            else { u32x4 wv; wv.x = pk2(v[2 * j][0], v[2 * j][1]); wv.y = pk2(v[2 * j][2], v[2 * j][3]); wv.z = pk2(v[2 * j + 1][0], v[2 * j + 1][1]); wv.w = pk2(v[2 * j + 1][2], v[2 * j + 1][3]); *(GAS u32x4*)(xb + (size_t)row * D + c) = wv;
                *(GAS u32x2*)(ws + WS_XB8 + (size_t)row * D + c) = (u32x2){pk_i8(v[2 * j][0], v[2 * j][1], v[2 * j][2], v[2 * j][3], q8), pk_i8(v[2 * j + 1][0], v[2 * j + 1][1], v[2 * j + 1][2], v[2 * j + 1][3], q8)}; } }
    }
}

constexpr int PH_PER_LAYER = 10, N_PHASES = DEPTH * PH_PER_LAYER;
#ifndef ONLY_PHASE
#define ONLY_PHASE -1
#endif
#define IN(k) ((ONLY_PHASE < 0 || ONLY_PHASE == ((k) % PH_PER_LAYER)) && lo <= (k) && (k) < hi)
#define SEAM(k) do { if (!MK_PER_PHASE && ((((k) % PH_PER_LAYER) == 2) ? IN((k) + 2) : IN((k) + 1))) xcd_barrier(bar); } while (0)
#define PF Frame F = phase_frame(F0)
#ifndef DUP_MASK
#define DUP_MASK 0
#endif
#define NREP(k) ((((DUP_MASK) >> (k)) & 1) ? 2 : 1)
__device__ __forceinline__ void phase_w_kv(const Frame& F0, int l) {
    { Frame F = phase_frame(F0); GAS unsigned char* ws = KWS();
      SchedKv S{(const GAS char*)(ws + WS_MEMB), (const GAS char*)(ws + WS_WKV) + (size_t)l * 2048 * D * 2, F.vcu};
      EpiProj E{ws, (const GAS float*)(ws + WS_ROPE), (const GAS float*)(ws + WS_ROPE) + 2048 * 128};
      pg8::gemm_phase<EpiProj, SchedKv, false>(F.lds, S, E); }
    __syncthreads();
    { Frame F = phase_frame(F0); phase_w(F, l); }
}
template <int l> __device__ __forceinline__ void run_layer(const Frame& F0, const XcdBarrier& bar, int lo, int hi) {
        constexpr int pb = l * PH_PER_LAYER;
        if (l == 0) {
            if (lo <= -1 && -1 < hi) { { PF; phase_w0a(F); } if (!MK_PER_PHASE && IN(pb + 0)) xcd_barrier(bar); }
            if (IN(pb + 0)) { for (int rep_ = 0; rep_ < NREP(0); ++rep_) phase_w_kv(F0, 0); SEAM(pb + 0); } }
        if (IN(pb + 1)) { for (int rep_ = 0; rep_ < NREP(1); ++rep_) {
            { PF; GAS unsigned char* ws = KWS();
              const float wdq = fmaxf(WQ_RANGE * __uint_as_float(xb_ld((GAS unsigned*)(ws + WS_CTL) + CW_WMAX + l)), 1e-30f) * (1.0f / 127.0f);
              SchedProj S{(const GAS char*)(ws + WS_XB8), (const GAS char*)(ws + WS_WIN8), F.G, F.bx, 0};
              EpiProjQ E{EpiProj{ws, (const GAS float*)(ws + WS_ROPE), (const GAS float*)(ws + WS_ROPE) + 2048 * 128}, (const GAS float*)(ws + WS_XS), wdq};
              pg8::gemm_phase<EpiProjQ, SchedProj, false>(F.lds, S, E); }
            { PF; GAS unsigned char* ws = KWS();
              const float wdq = fmaxf(WQ_RANGE * __uint_as_float(xb_ld((GAS unsigned*)(ws + WS_CTL) + CW_WMAX + l)), 1e-30f) * (1.0f / 127.0f);
              SchedProj S{(const GAS char*)(ws + WS_XB8), (const GAS char*)(ws + WS_WIN8), F.G, F.bx, 1};
              EpiProjT E{ws, wdq, (const GAS float*)(ws + WS_XS)};
              pg8::gemm_phase<EpiProjT, SchedProj, true>(F.lds, S, E); } }
            SEAM(pb + 1);
        }
        if (IN(pb + 2)) { for (int rep_ = 0; rep_ < NREP(2); ++rep_) { PF; phase_mixers(F); } SEAM(pb + 2); }
        if (IN(pb + 4)) { for (int rep_ = 0; rep_ < NREP(4); ++rep_) {
            PF; GAS unsigned char* ws = KWS();
            SchedMerge S{(const GAS char*)(ws + WS_YA), (const GAS char*)(ws + WS_YR), (const GAS char*)(ws + WS_YM), (const GAS char*)(ws + WS_WPM), (const GAS char*)(ws + WS_WPR), (const GAS char*)(ws + WS_WPE), F.G, F.bx};
            static_assert(WS_SGR == WS_SGA + 64 * MiB && WS_SGM == WS_SGR + 64 * MiB, "gate arrays");
            EpiMerge E{(const GAS unsigned char*)(ws + WS_SGA), (GAS bf16_t*)(ws + WS_MERGED)};
            pg8::gemm_phase<EpiMerge, SchedMerge, false>(F.lds, S, E); }
            SEAM(pb + 4);
        }
        if (IN(pb + 5)) { for (int rep_ = 0; rep_ < NREP(5); ++rep_) {
            PF; GAS unsigned char* ws = KWS();
            SchedPlain8 S{(const GAS char*)(ws + WS_MERGED), (const GAS char*)(ws + WS_WO), 64, 8, F.G, F.bx};
            EpiResid E{(const GAS bf16_t*)(ws + WS_XB), (GAS bf16_t*)(ws + WS_HPRE)};
            pg8::gemm_phase<EpiResid, SchedPlain8, false>(F.lds, S, E); }
            SEAM(pb + 5);
        }
        if (IN(pb + 6)) { for (int rep_ = 0; rep_ < NREP(6); ++rep_) { PF; phase_ln1_router(F, l, rep_ == NREP(6) - 1); } SEAM(pb + 6); }
        if (IN(pb + 7)) { for (int rep_ = 0; rep_ < NREP(7); ++rep_) {
            PF; GAS unsigned char* ws = KWS();
            build_moe_tab(F, (GAS unsigned*)(ws + WS_CTL) + CW_CNT + l * 64 * NEXP);
            SchedMoe1 S{(const GAS char*)(ws + WS_X1B), (const GAS char*)(ws + WS_WGU), (const GAS int*)(ws + WS_LIST), (LAS int*)(F.lds + LDS_TAB), F.G, F.vcu};
            EpiSwiglu E{(GAS bf16_t*)(ws + WS_HBUF), (GAS unsigned*)(ws + WS_CTL) + CW_FLAG + l * 4096};
            pg8::gemm_phase<EpiSwiglu, SchedMoe1, false>(F.lds, S, E); }
        }
        if (IN(pb + 8)) { for (int rep_ = 0; rep_ < NREP(8); ++rep_) {
            PF; GAS unsigned char* ws = KWS();
            build_moe_tab(F, (GAS unsigned*)(ws + WS_CTL) + CW_CNT + l * 64 * NEXP);
            SchedMoe2 S{(const GAS char*)(ws + WS_HBUF), (const GAS char*)(ws + WS_WDN), (const GAS int*)(ws + WS_LIST), (LAS int*)(F.lds + LDS_TAB), F.G, F.vcu, (GAS unsigned*)(ws + WS_CTL) + CW_FLAG + l * 4096};
            EpiScatter E{(GAS bf16_t*)(ws + WS_YASG)};
            pg8::gemm_phase<EpiScatter, SchedMoe2, false>(F.lds, S, E); }
            SEAM(pb + 8);
        }
        if (IN(pb + 9)) { for (int rep_ = 0; rep_ < NREP(9); ++rep_) { PF; phase_ln2(F, l); }
            if (l + 1 < DEPTH) { phase_w_kv(F0, l + 1); if (!MK_PER_PHASE && IN(pb + 11)) xcd_barrier(bar); } }
}
#undef IN
#undef SEAM
#undef PF
#undef NREP
__global__ void __launch_bounds__(NWAVES * 64, 2) hybrid_fwd(Args args) {
    extern __shared__ __attribute__((aligned(16))) unsigned char lds_raw[];
    Frame F0;
    F0.lds = (LAS unsigned char*)lds_raw; F0.MISC = (volatile LAS unsigned*)(F0.lds + MISC_OFF);
    F0.tid = threadIdx.x; F0.lane = F0.tid & 63; F0.wave = __builtin_amdgcn_readfirstlane(F0.tid >> 6);
    F0.G = gridDim.x; { const int bx = blockIdx.x; F0.bx = bx; F0.vcu = (F0.G % 8 == 0) ? (bx % 8) * (F0.G / 8) + bx / 8 : bx; }
    for (int u = F0.tid; u < (LDS_BYTES - LDSCTL_OFF) / 4; u += NWAVES * 64) ((LAS unsigned*)(F0.lds + LDSCTL_OFF))[u] = 0u;
    __syncthreads();
    XcdBarrier bar; bar.bar = (GAS unsigned*)(KWS() + WS_CTL) + CW_BAR; bar.x = 0; bar.st = nullptr;
    if (!MK_PER_PHASE) bar = xcd_barrier_post((GAS unsigned*)(KWS() + WS_CTL) + CW_BAR, F0.MISC + 8);
    const int lo = args.ph_lo, hi = args.ph_hi;
    run_layer<0>(F0, bar, lo, hi);
    run_layer<1>(F0, bar, lo, hi);
}

extern "C" void kernel_launch(void* const* d_in, const int* in_sizes, int n_in, void* d_out, int out_size, void* d_ws, size_t ws_size, hipStream_t stream) {
    static int grid = 0;
    if (grid == 0) {
        if (n_in != 18 || out_size != T * D || ws_size < WS_END) { fprintf(stderr, "kernel_launch: unexpected shapes (n_in %d, out %d, ws %zu < %zu)\n", n_in, out_size, ws_size, (size_t)WS_END); grid = -1; return; }
        int dev = 0, cus = 0, per_cu = 0;
        if (hipGetDevice(&dev) != hipSuccess || hipDeviceGetAttribute(&cus, hipDeviceAttributeMultiprocessorCount, dev) != hipSuccess) { grid = -1; return; }
        if (hipFuncSetAttribute((const void*)hybrid_fwd, hipFuncAttributeMaxDynamicSharedMemorySize, LDS_BYTES) != hipSuccess) { fprintf(stderr, "kernel_launch: hipFuncSetAttribute failed\n"); grid = -1; return; }
        if (hipOccupancyMaxActiveBlocksPerMultiprocessor(&per_cu, (const void*)hybrid_fwd, NWAVES * 64, LDS_BYTES) != hipSuccess || per_cu < 1) { fprintf(stderr, "kernel_launch: occupancy query says %d\n", per_cu); per_cu = 1; }
        (void)hipGetLastError();
        grid = cus;
    }
    if (grid < 0) return;
    (void)hipMemsetAsync((char*)d_ws + WS_CTL, 0, CTL_ZERO_BYTES, stream);
    Args a{};
    for (int i = 0; i < 18; ++i) a.in[i] = (const float*)d_in[i];
    a.out = (float*)d_out; a.ws = (unsigned char*)d_ws;
#if MK_PER_PHASE
    for (int p = -1; p < N_PHASES; ++p) { a.ph_lo = p; a.ph_hi = p + 1; hipLaunchKernelGGL(hybrid_fwd, dim3(grid), dim3(NWAVES * 64), LDS_BYTES, stream, a); }
#else
    a.ph_lo = -1; a.ph_hi = N_PHASES;
    hipLaunchKernelGGL(hybrid_fwd, dim3(grid), dim3(NWAVES * 64), LDS_BYTES, stream, a);
#endif
}
```
